# Optimizing an MI355X kernel written in HIP

```python
import math
import jax, jax.numpy as jnp
from jax import lax
import numpy as np

D_MODEL = 2048
BATCH = 4
SEQ = 4096
DEPTH = 1

A_WIDTH = D_MODEL // 2
A_HEAD_DIM = 128
A_HEADS = A_WIDTH // A_HEAD_DIM
CHUNK = 128
B_WIDTH = D_MODEL - A_WIDTH
B_HEADS = 8
B_V_DIM = B_WIDTH // B_HEADS
B_QK_DIM = B_V_DIM // 2
B_QK_WIDTH = B_HEADS * 2 * B_QK_DIM
ROT_DIM = B_QK_DIM // 4
ROPE_THETA = 500000.0
Q_BLOCK = 128
IN_WIDTH = 2 * A_WIDTH + 2 * B_QK_WIDTH + B_WIDTH
MIX_WIDTH = A_WIDTH + B_WIDTH
N_GROUPS = 4
EXPERTS_PER_GROUP = 8
N_EXPERTS = N_GROUPS * EXPERTS_PER_GROUP
TOP_K = 2
D_EXPERT = D_MODEL // 2
EXPERT_BLOCK = 256
EPS = 1e-6

kernel_name = "hybrid_gmlp_diffattn_hiermoe_encoder"


def rms_norm(x, g, eps=EPS):
    xf = x.astype(jnp.float32)
    y = xf * lax.rsqrt(jnp.mean(xf * xf, axis=-1, keepdims=True) + eps)
    return (y * g.astype(jnp.float32)).astype(x.dtype)


def layer_norm(x, g, b, eps=EPS):
    xf = x.astype(jnp.float32)
    mu = jnp.mean(xf, axis=-1, keepdims=True)
    xc = xf - mu
    y = xc * lax.rsqrt(jnp.mean(xc * xc, axis=-1, keepdims=True) + eps)
    return (y * g.astype(jnp.float32) + b.astype(jnp.float32)).astype(x.dtype)


def rotary_tables(seq_len):
    pos = jnp.arange(seq_len, dtype=jnp.float32)
    inv_freq = 1.0 / (jnp.float32(ROPE_THETA) ** (jnp.arange(0, ROT_DIM, 2, dtype=jnp.float32) / ROT_DIM))
    ang = pos[:, None] * inv_freq[None, :]
    return jnp.cos(ang), jnp.sin(ang)


def partial_rotary(x, cos, sin):
    half = ROT_DIM // 2
    c = cos[None, :, None, None, :].astype(x.dtype)
    s = sin[None, :, None, None, :].astype(x.dtype)
    x1 = x[..., :half]
    x2 = x[..., half:ROT_DIM]
    return jnp.concatenate([x1 * c - x2 * s, x2 * c + x1 * s, x[..., ROT_DIM:]], axis=-1)


def gmlp_spatial_gating(zu, zv, ln_g, ln_b, w_s, b_s):
    bsz, seq, _ = zu.shape
    u = jax.nn.gelu(zu).reshape(bsz, seq, A_HEADS, A_HEAD_DIM)
    v = layer_norm(jax.nn.gelu(zv).reshape(bsz, seq, A_HEADS, A_HEAD_DIM), ln_g, ln_b)
    vc = v.reshape(bsz, seq // CHUNK, CHUNK, A_HEADS, A_HEAD_DIM)
    s = jnp.einsum('hij,bcjhd->bcihd', w_s, vc) + jnp.transpose(b_s)[:, :, None]
    return (u * s.reshape(bsz, seq, A_HEADS, A_HEAD_DIM)).reshape(bsz, seq, A_WIDTH)


def diff_attention_core(q, k, v, lam):
    bsz, seq, nh, _, dk = q.shape
    nqb = seq // Q_BLOCK
    qb = jnp.moveaxis(q.reshape(bsz, nqb, Q_BLOCK, nh, 2, dk), 1, 0)
    scale = 1.0 / math.sqrt(dk)

    def one_block(q_blk):
        s = jnp.einsum('bqhcd,bkhcd->bhcqk', q_blk, k).astype(jnp.float32) * scale
        p = jax.nn.softmax(s, axis=-1)
        a = p[:, :, 0] - lam * p[:, :, 1]
        return jnp.einsum('bhqk,bkhe->bqhe', a.astype(v.dtype), v)

    o = lax.map(one_block, qb)
    return jnp.moveaxis(o, 0, 1).reshape(bsz, seq, nh, -1)


def hierarchical_moe(h, w_group, b_group, w_router, b_router, w_gate, w_up, w_down):
    bsz, seq, d = h.shape
    T = bsz * seq
    hf = h.reshape(T, d)
    g_prob = jax.nn.softmax((hf @ w_group).astype(jnp.float32) + b_group.astype(jnp.float32), axis=-1)
    g_w, g_idx = lax.top_k(g_prob, 1)
    e_logits = ((hf @ w_router).astype(jnp.float32) + b_router.astype(jnp.float32)).reshape(T, N_GROUPS, EXPERTS_PER_GROUP)
    sel = jnp.take_along_axis(e_logits, g_idx[:, :, None], axis=1)[:, 0]
    e_w, e_loc = lax.top_k(jax.nn.softmax(sel, axis=-1), TOP_K)
    e_w = e_w / jnp.sum(e_w, axis=-1, keepdims=True)
    combine = g_w * e_w
    expert_id = g_idx * EXPERTS_PER_GROUP + e_loc

    A = T * TOP_K
    flat_e = expert_id.reshape(A)
    flat_t = jnp.repeat(jnp.arange(T, dtype=jnp.int32), TOP_K)
    flat_w = combine.reshape(A)
    order = jnp.argsort(flat_e)
    e_s = flat_e[order]
    counts = jnp.bincount(flat_e, length=N_EXPERTS)
    starts = jnp.cumsum(counts) - counts
    padded = (counts + EXPERT_BLOCK - 1) // EXPERT_BLOCK * EXPERT_BLOCK
    pend = jnp.cumsum(padded)
    pstart = pend - padded
    dest = pstart[e_s] + (jnp.arange(A) - starts[e_s])
    n_blocks = -(-A // EXPERT_BLOCK) + N_EXPERTS
    R = n_blocks * EXPERT_BLOCK
    row_tok = jnp.zeros((R,), jnp.int32).at[dest].set(flat_t[order])
    row_w = jnp.zeros((R,), jnp.float32).at[dest].set(flat_w[order])
    block_e = jnp.minimum(jnp.searchsorted(pend, jnp.arange(n_blocks) * EXPERT_BLOCK, side='right'), N_EXPERTS - 1)

    def expert_block(args):
        tok, e = args
        xb = hf[tok]
        return (jax.nn.silu(xb @ w_gate[e]) * (xb @ w_up[e])) @ w_down[e]

    y = lax.map(expert_block, (row_tok.reshape(n_blocks, EXPERT_BLOCK), block_e))
    y = y.reshape(R, d) * row_w[:, None].astype(y.dtype)
    out = jnp.zeros((T, d), h.dtype).at[row_tok].add(y)
    return out.reshape(bsz, seq, d)


def setup_inputs(seed: int = 0) -> dict:
    key = jax.random.key(seed)
    ks = jax.random.split(key, 24)
    f32 = jnp.float32
    L = DEPTH
    nrm = lambda k, shape, scale: jax.random.normal(k, shape, f32) * scale
    return {
        "x": jax.random.normal(ks[0], (BATCH, SEQ, D_MODEL), f32),
        "attn_norm_g": 1.0 + nrm(ks[1], (L, D_MODEL), 0.02),
        "w_in": nrm(ks[2], (L, D_MODEL, IN_WIDTH), D_MODEL ** -0.5),
        "gmlp_ln_g": 1.0 + nrm(ks[3], (L, A_HEADS, A_HEAD_DIM), 0.02),
        "gmlp_ln_b": nrm(ks[4], (L, A_HEADS, A_HEAD_DIM), 0.02),
        "gmlp_ws": nrm(ks[5], (L, A_HEADS, CHUNK, CHUNK), CHUNK ** -0.5),
        "gmlp_bs": 1.0 + nrm(ks[6], (L, A_HEADS, CHUNK), 0.02),
        "q_norm_g": 1.0 + nrm(ks[7], (L, B_QK_DIM), 0.02),
        "k_norm_g": 1.0 + nrm(ks[8], (L, B_QK_DIM), 0.02),
        "lambda_q1": nrm(ks[9], (L, B_QK_DIM), 0.1),
        "lambda_k1": nrm(ks[10], (L, B_QK_DIM), 0.1),
        "lambda_q2": nrm(ks[11], (L, B_QK_DIM), 0.1),
        "lambda_k2": nrm(ks[12], (L, B_QK_DIM), 0.1),
        "subln_g": 1.0 + nrm(ks[13], (L, B_V_DIM), 0.02),
        "w_out": nrm(ks[14], (L, MIX_WIDTH, D_MODEL), MIX_WIDTH ** -0.5),
        "ffn_norm_g": 1.0 + nrm(ks[15], (L, D_MODEL), 0.02),
        "w_group": nrm(ks[16], (L, D_MODEL, N_GROUPS), D_MODEL ** -0.5),
        "b_group": nrm(ks[17], (L, N_GROUPS), 0.01),
        "w_router": nrm(ks[18], (L, D_MODEL, N_EXPERTS), D_MODEL ** -0.5),
        "b_router": nrm(ks[19], (L, N_EXPERTS), 0.01),
        "w_gate": nrm(ks[20], (L, N_EXPERTS, D_MODEL, D_EXPERT), D_MODEL ** -0.5),
        "w_up": nrm(ks[21], (L, N_EXPERTS, D_MODEL, D_EXPERT), D_MODEL ** -0.5),
        "w_down": nrm(ks[22], (L, N_EXPERTS, D_EXPERT, D_MODEL), D_EXPERT ** -0.5),
    }


def reference(x, attn_norm_g, w_in, gmlp_ln_g, gmlp_ln_b, gmlp_ws, gmlp_bs, q_norm_g, k_norm_g,
              lambda_q1, lambda_k1, lambda_q2, lambda_k2, subln_g, w_out, ffn_norm_g,
              w_group, b_group, w_router, b_router, w_gate, w_up, w_down):
    bsz, seq, _ = x.shape
    cos, sin = rotary_tables(seq)
    splits = [A_WIDTH, 2 * A_WIDTH, 2 * A_WIDTH + B_QK_WIDTH, 2 * A_WIDTH + 2 * B_QK_WIDTH]
    for l in range(DEPTH):
        lambda_init = 0.8 - 0.6 * math.exp(-0.3 * l)
        h = rms_norm(x, attn_norm_g[l])
        z = h @ w_in[l]
        zu, zv, zq, zk, zvb = jnp.split(z, splits, axis=-1)
        out_a = gmlp_spatial_gating(zu, zv, gmlp_ln_g[l], gmlp_ln_b[l], gmlp_ws[l], gmlp_bs[l])
        q = rms_norm(zq.reshape(bsz, seq, B_HEADS, 2, B_QK_DIM), q_norm_g[l])
        k = rms_norm(zk.reshape(bsz, seq, B_HEADS, 2, B_QK_DIM), k_norm_g[l])
        q = partial_rotary(q, cos, sin)
        k = partial_rotary(k, cos, sin)
        v = zvb.reshape(bsz, seq, B_HEADS, B_V_DIM)
        lam = (jnp.exp(jnp.sum(lambda_q1[l].astype(jnp.float32) * lambda_k1[l].astype(jnp.float32)))
               - jnp.exp(jnp.sum(lambda_q2[l].astype(jnp.float32) * lambda_k2[l].astype(jnp.float32)))
               + lambda_init)
        o = diff_attention_core(q, k, v, lam)
        out_b = (rms_norm(o, subln_g[l]) * (1.0 - lambda_init)).reshape(bsz, seq, B_WIDTH)
        x = x + jnp.concatenate([out_a, out_b], axis=-1) @ w_out[l]
        hm = rms_norm(x, ffn_norm_g[l])
        x = x + hierarchical_moe(hm, w_group[l], b_group[l], w_router[l], b_router[l],
                                 w_gate[l], w_up[l], w_down[l])
    return x
```

```cpp
#include <hip/hip_runtime.h>
#include <cstdio>
#include <cstdint>

typedef unsigned short bf16_t;
typedef short bf16x8 __attribute__((ext_vector_type(8)));
typedef float f32x4 __attribute__((ext_vector_type(4)));

constexpr int NB = 4, SEQ = 4096, T = NB * SEQ, DM = 2048, INW = 5120;
constexpr int NE = 32, DE = 1024, SLOTS = 40960;
constexpr float EPS = 1e-6f;
constexpr float C2 = 0.125f * 1.4426950408889634f;

constexpr size_t MiB = 1u << 20;
constexpr size_t WS_CTL = 0;
constexpr size_t WS_ROPE = 1 * MiB;
constexpr size_t WS_WRT = WS_ROPE + 512 * 1024;
constexpr size_t WS_WSB = 2 * MiB;
constexpr size_t WS_LAM = 3 * MiB;
constexpr size_t WS_LIST = 4 * MiB;
constexpr size_t WS_REC = 8 * MiB;
constexpr size_t WS_WIN = 12 * MiB;
constexpr size_t WS_WOUT = 32 * MiB;
constexpr size_t WS_WGU = 40 * MiB;
constexpr size_t WS_WD = 296 * MiB;
constexpr size_t WS_XN = 424 * MiB;
constexpr size_t WS_MIX = 488 * MiB;
constexpr size_t WS_Z = 552 * MiB;
constexpr size_t WS_U = 712 * MiB;
constexpr size_t WS_H = 552 * MiB;
constexpr size_t WS_Y = 632 * MiB;
constexpr size_t WS_END = 872 * MiB;

__device__ __forceinline__ unsigned f2bf(float f) { unsigned u = __builtin_bit_cast(unsigned, f); return (u + 0x7fffu + ((u >> 16) & 1u)) >> 16; }
__device__ __forceinline__ float bf2f(unsigned h) { return __builtin_bit_cast(float, h << 16); }
__device__ __forceinline__ unsigned pk2(float lo, float hi) { return f2bf(lo) | (f2bf(hi) << 16); }
__device__ __forceinline__ float wave_sum(float v) {
#pragma unroll
    for (int o = 1; o < 64; o <<= 1) v += __shfl_xor(v, o);
    return v;
}
__device__ __forceinline__ float gelu_tanh(float x) { const float u = 0.7978845608028654f * (x + 0.044715f * x * x * x); return 0.5f * x * (1.f + tanhf(u)); }
__device__ __forceinline__ void unpack8(uint4 r, float* f) {
    f[0] = bf2f(r.x & 0xffffu); f[1] = bf2f(r.x >> 16); f[2] = bf2f(r.y & 0xffffu); f[3] = bf2f(r.y >> 16);
    f[4] = bf2f(r.z & 0xffffu); f[5] = bf2f(r.z >> 16); f[6] = bf2f(r.w & 0xffffu); f[7] = bf2f(r.w >> 16);
}
__device__ __forceinline__ uint4 pack8(const float* f) { uint4 r; r.x = pk2(f[0], f[1]); r.y = pk2(f[2], f[3]); r.z = pk2(f[4], f[5]); r.w = pk2(f[6], f[7]); return r; }

__device__ __forceinline__ int map_row(int mode, int n) {
    if (mode == 1) { const int pn = n >> 8, r = n & 255, wc = r >> 6, bj = (r >> 5) & 1, j = r & 31; return (pn << 8) + (bj << 7) + (wc << 5) + j; }
    if (mode == 2) return ((n >> 7) << 8) + (n & 127);
    if (mode == 3) return ((n >> 7) << 8) + 128 + (n & 127);
    return n;
}
__device__ __forceinline__ int win_logical(int np) { const int pn = np >> 8, r = np & 255, bj = r >> 7, wc = (r >> 5) & 3, j = r & 31; return (pn << 8) + (wc << 6) + (bj << 5) + j; }

__global__ __launch_bounds__(256) void k_transpose(const float* __restrict__ W, int K, int N, bf16_t* __restrict__ WT, const float* __restrict__ gk, int mode, size_t wes, size_t wtes) {
    __shared__ float t[32][33];
    const int tx = threadIdx.x & 31, ty = threadIdx.x >> 5;
    const int k0 = blockIdx.y * 32, n0 = blockIdx.x * 32; const size_t e = blockIdx.z;
    const float* Wp = W + e * wes; bf16_t* WTp = WT + e * wtes;
#pragma unroll
    for (int i = 0; i < 4; ++i) { const int kk = ty + 8 * i; const float g = gk ? gk[k0 + kk] : 1.f; t[kk][tx] = Wp[(size_t)(k0 + kk) * N + n0 + tx] * g; }
    __syncthreads();
#pragma unroll
    for (int i = 0; i < 4; ++i) { const int nn = ty + 8 * i; const int np = map_row(mode, n0 + nn); WTp[(size_t)np * K + k0 + tx] = (bf16_t)f2bf(t[tx][nn]); }
}

__device__ __forceinline__ float block_sum256(float v, float* red) {
    v = wave_sum(v); const int wid = threadIdx.x >> 6;
    if ((threadIdx.x & 63) == 0) red[wid] = v;
    __syncthreads(); const float r = red[0] + red[1] + red[2] + red[3]; __syncthreads(); return r;
}

__global__ __launch_bounds__(256) void k_xnorm(const float* __restrict__ x, bf16_t* __restrict__ XN) {
    __shared__ float red[4];
    const int t = blockIdx.x, tid = threadIdx.x;
    const float4* xr = (const float4*)(x + (size_t)t * DM) + tid * 2; const float4 a = xr[0], b = xr[1];
    float ss = a.x * a.x + a.y * a.y + a.z * a.z + a.w * a.w + b.x * b.x + b.y * b.y + b.z * b.z + b.w * b.w;
    ss = block_sum256(ss, red);
    const float rs = rsqrtf(ss * (1.f / DM) + EPS);
    uint4 o; o.x = pk2(a.x * rs, a.y * rs); o.y = pk2(a.z * rs, a.w * rs); o.z = pk2(b.x * rs, b.y * rs); o.w = pk2(b.z * rs, b.w * rs);
    *(uint4*)(XN + (size_t)t * DM + tid * 8) = o;
}

__global__ __launch_bounds__(256) void k_tables(float2* rope, float* WrT, bf16_t* WsB, float* lam, const float* wgrp, const float* wrt, const float* fng, const float* ws,
                                                const float* lq1, const float* lk1, const float* lq2, const float* lk2) {
    const int gid = blockIdx.x * 256 + threadIdx.x, gsz = gridDim.x * 256;
    for (int i = gid; i < 4096 * 8; i += gsz) { const int pos = i >> 3, f = i & 7; const float inv = 1.0f / powf(500000.0f, (float)(2 * f) / 16.0f); const float ang = (float)pos * inv; rope[i] = make_float2(cosf(ang), sinf(ang)); }
    for (int i = gid; i < 36 * 2048; i += gsz) { const int c = i / 2048, k = i % 2048; const float w = c < 4 ? wgrp[k * 4 + c] : wrt[k * 32 + (c - 4)]; WrT[i] = w * fng[k]; }
    for (int i = gid; i < 8 * 128 * 128; i += gsz) WsB[i] = (bf16_t)f2bf(ws[i]);
    if (gid == 0) { float a = 0.f, b = 0.f; for (int i = 0; i < 64; ++i) { a += lq1[i] * lk1[i]; b += lq2[i] * lk2[i]; } lam[0] = expf(a) - expf(b) + 0.2f; }
}

struct TileBase { const bf16_t* Bt; int K; };
template <class P> __global__ __launch_bounds__(256, 2) void k_gemm128(P p) {
    extern __shared__ __attribute__((aligned(16))) bf16_t shm[];
    typename P::Tile ti; if (!p.tile(ti)) return;
    const int tid = threadIdx.x, wid = tid >> 6, lane = tid & 63, wr = wid >> 1, wc = wid & 1, fr = lane & 15, fq = lane >> 4;
    bf16_t* SA = shm; bf16_t* SB = shm + 4096;
    const int sr = tid >> 2, scol = (tid & 3) * 8; const int K = ti.K;
    const bf16_t* a0 = p.arow(ti, sr) + scol; const bf16_t* a1 = p.arow(ti, sr + 64) + scol;
    const bf16_t* b0 = ti.Bt + (size_t)sr * K + scol; const bf16_t* b1 = ti.Bt + (size_t)(sr + 64) * K + scol;
    f32x4 acc[4][4];
#pragma unroll
    for (int m = 0; m < 4; ++m)
#pragma unroll
        for (int n = 0; n < 4; ++n) acc[m][n] = (f32x4){0.f, 0.f, 0.f, 0.f};
    bf16x8 At[4], Bl[4];
    for (int t = 0; t < K / 32; ++t) {
        __builtin_amdgcn_global_load_lds((const unsigned*)(a0 + t * 32), (unsigned*)((char*)SA + tid * 16), 16, 0, 0);
        __builtin_amdgcn_global_load_lds((const unsigned*)(a1 + t * 32), (unsigned*)((char*)SA + tid * 16 + 4096), 16, 0, 0);
        __builtin_amdgcn_global_load_lds((const unsigned*)(b0 + t * 32), (unsigned*)((char*)SB + tid * 16), 16, 0, 0);
        __builtin_amdgcn_global_load_lds((const unsigned*)(b1 + t * 32), (unsigned*)((char*)SB + tid * 16 + 4096), 16, 0, 0);
        asm volatile("s_waitcnt vmcnt(0)" ::: "memory"); __syncthreads();
#pragma unroll
        for (int m = 0; m < 4; ++m) At[m] = *reinterpret_cast<const bf16x8*>((char*)SA + (wr * 64 + m * 16 + fr) * 64 + fq * 16);
#pragma unroll
        for (int n = 0; n < 4; ++n) Bl[n] = *reinterpret_cast<const bf16x8*>((char*)SB + (wc * 64 + n * 16 + fr) * 64 + fq * 16);
        asm volatile("s_waitcnt lgkmcnt(0)" ::: "memory"); __builtin_amdgcn_sched_barrier(0);
#pragma unroll
        for (int m = 0; m < 4; ++m)
#pragma unroll
            for (int n = 0; n < 4; ++n) acc[m][n] = __builtin_amdgcn_mfma_f32_16x16x32_bf16(At[m], Bl[n], acc[m][n], 0, 0, 0);
        __syncthreads();
    }
#pragma unroll
    for (int m = 0; m < 4; ++m)
#pragma unroll
        for (int n = 0; n < 4; ++n)
#pragma unroll
            for (int j = 0; j < 4; ++j) p.store(ti, wr * 64 + m * 16 + fq * 4 + j, wc * 64 + n * 16 + fr, acc[m][n][j]);
}

struct P_G1 {
    struct Tile : TileBase { int brow, bcol; };
    const bf16_t* A; const bf16_t* Bt; bf16_t* Z;
    __device__ bool tile(Tile& ti) const { ti.brow = blockIdx.y * 128; ti.bcol = blockIdx.x * 128; ti.Bt = Bt + (size_t)ti.bcol * DM; ti.K = DM; return true; }
    __device__ const bf16_t* arow(const Tile& ti, int r) const { return A + (size_t)(ti.brow + r) * DM; }
    __device__ void store(const Tile& ti, int r, int c, float v) const { Z[(size_t)(ti.brow + r) * INW + win_logical(ti.bcol + c)] = (bf16_t)f2bf(v); }
};
struct P_G2 {
    struct Tile : TileBase { int brow, bcol; };
    const bf16_t* A; const bf16_t* Bt; const float* x; float* out; bf16_t* X1B;
    __device__ bool tile(Tile& ti) const { ti.brow = blockIdx.y * 128; ti.bcol = blockIdx.x * 128; ti.Bt = Bt + (size_t)ti.bcol * DM; ti.K = DM; return true; }
    __device__ const bf16_t* arow(const Tile& ti, int r) const { return A + (size_t)(ti.brow + r) * DM; }
    __device__ void store(const Tile& ti, int r, int c, float v) const { const size_t o = (size_t)(ti.brow + r) * DM + ti.bcol + c; const float x1 = v + x[o]; out[o] = x1; X1B[o] = (bf16_t)f2bf(x1); }
};
__device__ __forceinline__ bool find_expert(const unsigned* cnt, int slot0, int& e, int& pos0, int& ce) {
    int ps = 0;
    for (int i = 0; i < NE; ++i) { const int c = (int)cnt[i]; const int pad = (c + 255) & ~255; if (slot0 < ps + pad) { e = i; pos0 = slot0 - ps; ce = c; return true; } ps += pad; }
    return false;
}
struct P_GU {
    struct Tile : TileBase { int slot0, bcol, e, pos0, ce; };
    const bf16_t* X1B; const bf16_t* Wgu; const unsigned* cnt; const int2* list; bf16_t* GU;
    __device__ bool tile(Tile& ti) const { ti.slot0 = blockIdx.y * 128; ti.bcol = blockIdx.x * 128; if (!find_expert(cnt, ti.slot0, ti.e, ti.pos0, ti.ce)) return false;
        ti.Bt = Wgu + (size_t)ti.e * 2048 * 2048 + (size_t)ti.bcol * DM; ti.K = DM; return true; }
    __device__ const bf16_t* arow(const Tile& ti, int r) const { const int pos = ti.pos0 + r; const int tok = pos < ti.ce ? list[(size_t)ti.e * T + pos].x : 0; return X1B + (size_t)tok * DM; }
    __device__ void store(const Tile& ti, int r, int c, float v) const { GU[(size_t)(ti.slot0 + r) * 2048 + ti.bcol + c] = (bf16_t)f2bf(v); }
};
struct P_DN {
    struct Tile : TileBase { int slot0, bcol, e, pos0, ce; };
    const bf16_t* H; const bf16_t* Wd; const unsigned* cnt; bf16_t* Y;
    __device__ bool tile(Tile& ti) const { ti.slot0 = blockIdx.y * 128; ti.bcol = blockIdx.x * 128; if (!find_expert(cnt, ti.slot0, ti.e, ti.pos0, ti.ce)) return false;
        ti.Bt = Wd + (size_t)ti.e * 2048 * 1024 + (size_t)ti.bcol * DE; ti.K = DE; return true; }
    __device__ const bf16_t* arow(const Tile& ti, int r) const { return H + (size_t)(ti.slot0 + r) * DE; }
    __device__ void store(const Tile& ti, int r, int c, float v) const { Y[(size_t)(ti.slot0 + r) * 2048 + ti.bcol + c] = (bf16_t)f2bf(v); }
};

__global__ __launch_bounds__(256) void k_post(const bf16_t* __restrict__ Z, bf16_t* U, bf16_t* VG, bf16_t* QN, bf16_t* KN, bf16_t* VB, const float* qg, const float* kg, const float2* rope) {
    const int t = blockIdx.x, tid = threadIdx.x, pos = t & (SEQ - 1);
    const bf16_t* z = Z + (size_t)t * INW; float f[8];
    { unpack8(*(const uint4*)(z + tid * 8), f);
#pragma unroll
      for (int i = 0; i < 8; ++i) f[i] = gelu_tanh(f[i]);
      const uint4 o = pack8(f); if (tid < 128) *(uint4*)(U + (size_t)t * 1024 + tid * 8) = o; else *(uint4*)(VG + (size_t)t * 1024 + (tid - 128) * 8) = o; }
    if (tid < 128) *(uint4*)(VB + (size_t)t * 1024 + tid * 8) = *(const uint4*)(z + 4096 + tid * 8);
    { const bool isk = tid >= 128; const int col = (tid * 8) & 1023, d0 = col & 63, sub = d0 >> 3;
      unpack8(*(const uint4*)(z + 2048 + tid * 8), f);
      float ss = 0.f;
#pragma unroll
      for (int i = 0; i < 8; ++i) ss += f[i] * f[i];
      ss += __shfl_xor(ss, 1); ss += __shfl_xor(ss, 2); ss += __shfl_xor(ss, 4);
      const float rs = rsqrtf(ss * (1.f / 64.f) + EPS); const float* g = isk ? kg : qg;
      float y[8], pr[8];
#pragma unroll
      for (int i = 0; i < 8; ++i) y[i] = f[i] * rs * g[d0 + i];
#pragma unroll
      for (int i = 0; i < 8; ++i) pr[i] = __shfl_xor(y[i], 1);
      if (sub < 2) {
#pragma unroll
          for (int i = 0; i < 8; ++i) { const float2 cs = rope[pos * 8 + i]; y[i] = sub == 0 ? y[i] * cs.x - pr[i] * cs.y : y[i] * cs.x + pr[i] * cs.y; } }
      if (!isk) {
#pragma unroll
          for (int i = 0; i < 8; ++i) y[i] *= C2; }
      *(uint4*)((isk ? KN : QN) + (size_t)t * 1024 + col) = pack8(y); }
}

__global__ __launch_bounds__(256) void k_gmlp(const bf16_t* __restrict__ U, const bf16_t* __restrict__ VG, const float* lng, const float* lnb, const float* Ws, const float* bs, bf16_t* MIX) {
    extern __shared__ __attribute__((aligned(16))) float sm[];
    float* vln = sm; float* wsl = sm + 128 * 129;
    const int blk = blockIdx.x, h = blk & 7, c = (blk >> 3) & 31, b = blk >> 8, t0 = b * SEQ + c * 128;
    const int tid = threadIdx.x, wid = tid >> 6, lane = tid & 63;
    for (int i = tid; i < 128 * 128; i += 256) wsl[i] = Ws[(size_t)h * 16384 + i];
    for (int jj = 0; jj < 32; ++jj) { const int j = wid * 32 + jj; const bf16_t* vr = VG + (size_t)(t0 + j) * 1024 + h * 128;
        const float a = bf2f(vr[lane]), b2 = bf2f(vr[lane + 64]); const float mu = wave_sum(a + b2) * (1.f / 128.f); const float da = a - mu, db = b2 - mu;
        const float rs = rsqrtf(wave_sum(da * da + db * db) * (1.f / 128.f) + EPS);
        vln[j * 129 + lane] = da * rs * lng[h * 128 + lane] + lnb[h * 128 + lane]; vln[j * 129 + lane + 64] = db * rs * lng[h * 128 + lane + 64] + lnb[h * 128 + lane + 64]; }
    __syncthreads();
    const int d = tid & 127, ih = tid >> 7; float acc[64];
#pragma unroll
    for (int i = 0; i < 64; ++i) acc[i] = 0.f;
    for (int j = 0; j < 128; ++j) { const float v = vln[j * 129 + d];
#pragma unroll
        for (int i = 0; i < 64; ++i) acc[i] += wsl[(ih * 64 + i) * 128 + j] * v; }
#pragma unroll
    for (int i = 0; i < 64; ++i) { const int row = t0 + ih * 64 + i; const float s = acc[i] + bs[h * 128 + ih * 64 + i];
        const float u = bf2f(U[(size_t)row * 1024 + h * 128 + d]); MIX[(size_t)row * DM + h * 128 + d] = (bf16_t)f2bf(u * s); }
}

__global__ __launch_bounds__(256) void k_attn_simple(const bf16_t* __restrict__ QN, const bf16_t* __restrict__ KN, const bf16_t* __restrict__ VB, const float* subg, const float* lamp, bf16_t* MIX) {
    const int tid = threadIdx.x, part = tid & 15, qr = tid >> 4;
    const int blk = blockIdx.x, qb = blk & 255, h = (blk >> 8) & 7, b = blk >> 11;
    const int t = b * SEQ + qb * 16 + qr;
    float q1[4], q2[4];
    { const uint2 a = *(const uint2*)(QN + (size_t)t * 1024 + h * 128 + part * 4), c = *(const uint2*)(QN + (size_t)t * 1024 + h * 128 + 64 + part * 4);
      q1[0] = bf2f(a.x & 0xffffu); q1[1] = bf2f(a.x >> 16); q1[2] = bf2f(a.y & 0xffffu); q1[3] = bf2f(a.y >> 16);
      q2[0] = bf2f(c.x & 0xffffu); q2[1] = bf2f(c.x >> 16); q2[2] = bf2f(c.y & 0xffffu); q2[3] = bf2f(c.y >> 16); }
    float o1[8], o2[8], l1 = 0.f, l2 = 0.f;
#pragma unroll
    for (int e = 0; e < 8; ++e) { o1[e] = 0.f; o2[e] = 0.f; }
    const bf16_t* Kb = KN + (size_t)(b * SEQ) * 1024 + h * 128; const bf16_t* Vb = VB + (size_t)(b * SEQ) * 1024 + h * 128;
#pragma unroll 4
    for (int j = 0; j < SEQ; ++j) {
        const uint2 ka = *(const uint2*)(Kb + (size_t)j * 1024 + part * 4), kc = *(const uint2*)(Kb + (size_t)j * 1024 + 64 + part * 4); const uint4 vr = *(const uint4*)(Vb + (size_t)j * 1024 + part * 8);
        float s1 = q1[0] * bf2f(ka.x & 0xffffu) + q1[1] * bf2f(ka.x >> 16) + q1[2] * bf2f(ka.y & 0xffffu) + q1[3] * bf2f(ka.y >> 16);
        float s2 = q2[0] * bf2f(kc.x & 0xffffu) + q2[1] * bf2f(kc.x >> 16) + q2[2] * bf2f(kc.y & 0xffffu) + q2[3] * bf2f(kc.y >> 16);
        s1 += __shfl_xor(s1, 1); s2 += __shfl_xor(s2, 1); s1 += __shfl_xor(s1, 2); s2 += __shfl_xor(s2, 2); s1 += __shfl_xor(s1, 4); s2 += __shfl_xor(s2, 4); s1 += __shfl_xor(s1, 8); s2 += __shfl_xor(s2, 8);
        const float p1 = exp2f(s1), p2 = exp2f(s2); l1 += p1; l2 += p2; float v[8]; unpack8(vr, v);
#pragma unroll
        for (int e = 0; e < 8; ++e) { o1[e] += p1 * v[e]; o2[e] += p2 * v[e]; }
    }
    const float lam = lamp[0], i1 = 1.f / l1, i2 = lam / l2; float o[8], ss = 0.f;
#pragma unroll
    for (int e = 0; e < 8; ++e) { o[e] = o1[e] * i1 - o2[e] * i2; ss += o[e] * o[e]; }
    ss += __shfl_xor(ss, 1); ss += __shfl_xor(ss, 2); ss += __shfl_xor(ss, 4); ss += __shfl_xor(ss, 8);
    const float rs = rsqrtf(ss * (1.f / 128.f) + EPS);
#pragma unroll
    for (int e = 0; e < 8; ++e) o[e] = o[e] * rs * subg[part * 8 + e] * 0.8f;
    *(uint4*)(MIX + (size_t)t * DM + 1024 + h * 128 + part * 8) = pack8(o);
}

__global__ __launch_bounds__(256) void k_route(const float* __restrict__ x1, const float* __restrict__ WrT, const float* bg, const float* br, unsigned* cnt, int2* list, int4* rec) {
    __shared__ float red[4][40];
    const int t = blockIdx.x, tid = threadIdx.x, lane = tid & 63, wid = tid >> 6;
    float xv[8]; { const float4* xr = (const float4*)(x1 + (size_t)t * DM) + tid * 2; const float4 a = xr[0], b = xr[1]; xv[0] = a.x; xv[1] = a.y; xv[2] = a.z; xv[3] = a.w; xv[4] = b.x; xv[5] = b.y; xv[6] = b.z; xv[7] = b.w; }
    float ss = 0.f;
#pragma unroll
    for (int i = 0; i < 8; ++i) ss += xv[i] * xv[i];
    ss = wave_sum(ss); if (lane == 0) red[wid][36] = ss;
    for (int c = 0; c < 36; ++c) { const float4* wr = (const float4*)(WrT + (size_t)c * DM) + tid * 2; const float4 a = wr[0], b = wr[1];
        float p = xv[0] * a.x + xv[1] * a.y + xv[2] * a.z + xv[3] * a.w + xv[4] * b.x + xv[5] * b.y + xv[6] * b.z + xv[7] * b.w; p = wave_sum(p); if (lane == 0) red[wid][c] = p; }
    __syncthreads();
    if (tid < 37) red[0][tid] = red[0][tid] + red[1][tid] + red[2][tid] + red[3][tid];
    __syncthreads();
    if (tid == 0) {
        const float* tot = red[0];
        const float rs = rsqrtf(tot[36] * (1.f / DM) + EPS);
        int gi = 0; float lgm = tot[0] * rs + bg[0];
        for (int g = 1; g < 4; ++g) { const float l = tot[g] * rs + bg[g]; if (l > lgm) { lgm = l; gi = g; } }
        float den = 0.f; for (int g = 0; g < 4; ++g) den += expf(tot[g] * rs + bg[g] - lgm); const float gw = 1.f / den;
        float* le = red[1]; for (int j = 0; j < 8; ++j) le[j] = tot[4 + gi * 8 + j] * rs + br[gi * 8 + j];
        int e0 = 0; for (int j = 1; j < 8; ++j) if (le[j] > le[e0]) e0 = j;
        int e1 = e0 == 0 ? 1 : 0; for (int j = 0; j < 8; ++j) if (j != e0 && le[j] > le[e1]) e1 = j;
        const float w0 = 1.f / (1.f + expf(le[e1] - le[e0])), w1 = 1.f - w0;
        const int E0 = gi * 8 + e0, E1 = gi * 8 + e1;
        const unsigned p0 = atomicAdd(&cnt[E0], 1u), p1 = atomicAdd(&cnt[E1], 1u);
        list[(size_t)E0 * T + p0] = make_int2(t, __float_as_int(rs)); list[(size_t)E1 * T + p1] = make_int2(t, __float_as_int(rs));
        rec[t] = make_int4((E0 << 16) | (int)p0, (E1 << 16) | (int)p1, __float_as_int(gw * w0), __float_as_int(gw * w1));
    }
}

__global__ __launch_bounds__(256) void k_glu(const bf16_t* __restrict__ GU, const unsigned* cnt, const int2* list, bf16_t* H) {
    const int slot = blockIdx.x, tid = threadIdx.x; int e, pos, ce; if (!find_expert(cnt, slot, e, pos, ce)) return;
    const float rs = pos < ce ? __int_as_float(list[(size_t)e * T + pos].y) : 0.f;
    const int c = tid * 4, base = ((c >> 7) << 8) + (c & 127);
    const uint2 g = *(const uint2*)(GU + (size_t)slot * 2048 + base), u = *(const uint2*)(GU + (size_t)slot * 2048 + base + 128);
    float gv[4] = {bf2f(g.x & 0xffffu), bf2f(g.x >> 16), bf2f(g.y & 0xffffu), bf2f(g.y >> 16)}, uv[4] = {bf2f(u.x & 0xffffu), bf2f(u.x >> 16), bf2f(u.y & 0xffffu), bf2f(u.y >> 16)}, hv[4];
#pragma unroll
    for (int i = 0; i < 4; ++i) { const float a = gv[i] * rs; hv[i] = a / (1.f + expf(-a)) * (uv[i] * rs); }
    uint2 o; o.x = pk2(hv[0], hv[1]); o.y = pk2(hv[2], hv[3]); *(uint2*)(H + (size_t)slot * DE + c) = o;
}

__global__ __launch_bounds__(256) void k_combine(float* out, const bf16_t* __restrict__ Y, const unsigned* cnt, const int4* rec) {
    __shared__ int ps[NE];
    const int t = blockIdx.x, tid = threadIdx.x;
    if (tid == 0) { int s = 0; for (int i = 0; i < NE; ++i) { ps[i] = s; s += ((int)cnt[i] + 255) & ~255; } }
    __syncthreads();
    const int4 r = rec[t]; const int s0 = ps[r.x >> 16] + (r.x & 0xffff), s1 = ps[r.y >> 16] + (r.y & 0xffff); const float w0 = __int_as_float(r.z), w1 = __int_as_float(r.w);
    float a[8], b[8]; unpack8(*(const uint4*)(Y + (size_t)s0 * 2048 + tid * 8), a); unpack8(*(const uint4*)(Y + (size_t)s1 * 2048 + tid * 8), b);
    float4* o = (float4*)(out + (size_t)t * DM) + tid * 2; float4 x0 = o[0], x1 = o[1];
    x0.x += w0 * a[0] + w1 * b[0]; x0.y += w0 * a[1] + w1 * b[1]; x0.z += w0 * a[2] + w1 * b[2]; x0.w += w0 * a[3] + w1 * b[3];
    x1.x += w0 * a[4] + w1 * b[4]; x1.y += w0 * a[5] + w1 * b[5]; x1.z += w0 * a[6] + w1 * b[6]; x1.w += w0 * a[7] + w1 * b[7];
    o[0] = x0; o[1] = x1;
}

extern "C" void kernel_launch(void* const* d_in, const int* in_sizes, int n_in, void* d_out, int out_size, void* d_ws, size_t ws_size, hipStream_t stream) {
    static int ok = 0;
    if (ok == 0) {
        if (n_in != 23 || in_sizes[0] != T * DM || out_size != T * DM || ws_size < WS_END) { fprintf(stderr, "kernel_launch: unexpected shapes (n_in %d, in0 %d, out %d, ws %zu)\n", n_in, n_in > 0 ? in_sizes[0] : -1, out_size, ws_size); ok = -1; return; }
        if (hipFuncSetAttribute((const void*)k_gmlp, hipFuncAttributeMaxDynamicSharedMemorySize, (128 * 129 + 128 * 128) * 4) != hipSuccess) { fprintf(stderr, "kernel_launch: hipFuncSetAttribute failed\n"); ok = -1; return; }
        ok = 1;
    }
    if (ok < 0) return;
    const float* x = (const float*)d_in[0]; const float* attn_g = (const float*)d_in[1]; const float* w_in = (const float*)d_in[2];
    const float* lng = (const float*)d_in[3]; const float* lnb = (const float*)d_in[4]; const float* gws = (const float*)d_in[5]; const float* gbs = (const float*)d_in[6];
    const float* qg = (const float*)d_in[7]; const float* kg = (const float*)d_in[8];
    const float* lq1 = (const float*)d_in[9]; const float* lk1 = (const float*)d_in[10]; const float* lq2 = (const float*)d_in[11]; const float* lk2 = (const float*)d_in[12];
    const float* subg = (const float*)d_in[13]; const float* w_out = (const float*)d_in[14]; const float* ffn_g = (const float*)d_in[15];
    const float* wgrp = (const float*)d_in[16]; const float* bgrp = (const float*)d_in[17]; const float* wrt = (const float*)d_in[18]; const float* brt = (const float*)d_in[19];
    const float* wgate = (const float*)d_in[20]; const float* wup = (const float*)d_in[21]; const float* wdown = (const float*)d_in[22];
    char* ws = (char*)d_ws; float* out = (float*)d_out;
    unsigned* cnt = (unsigned*)(ws + WS_CTL); float2* rope = (float2*)(ws + WS_ROPE); float* WrT = (float*)(ws + WS_WRT); bf16_t* WsB = (bf16_t*)(ws + WS_WSB); float* lam = (float*)(ws + WS_LAM);
    int2* list = (int2*)(ws + WS_LIST); int4* rec = (int4*)(ws + WS_REC);
    bf16_t* Win = (bf16_t*)(ws + WS_WIN); bf16_t* Wout = (bf16_t*)(ws + WS_WOUT); bf16_t* Wgu = (bf16_t*)(ws + WS_WGU); bf16_t* Wd = (bf16_t*)(ws + WS_WD);
    bf16_t* XN = (bf16_t*)(ws + WS_XN); bf16_t* MIX = (bf16_t*)(ws + WS_MIX); bf16_t* Z = (bf16_t*)(ws + WS_Z);
    bf16_t* U = (bf16_t*)(ws + WS_U); bf16_t* VG = U + (size_t)T * 1024; bf16_t* QN = VG + (size_t)T * 1024; bf16_t* KN = QN + (size_t)T * 1024; bf16_t* VB = KN + (size_t)T * 1024;
    bf16_t* H = (bf16_t*)(ws + WS_H); bf16_t* Y = (bf16_t*)(ws + WS_Y); bf16_t* GU = Y;

    (void)hipMemsetAsync(ws + WS_CTL, 0, 1 * MiB, stream);
    k_transpose<<<dim3(INW / 32, DM / 32, 1), 256, 0, stream>>>(w_in, DM, INW, Win, attn_g, 1, 0, 0);
    k_transpose<<<dim3(DM / 32, DM / 32, 1), 256, 0, stream>>>(w_out, DM, DM, Wout, nullptr, 0, 0, 0);
    k_transpose<<<dim3(DE / 32, DM / 32, NE), 256, 0, stream>>>(wgate, DM, DE, Wgu, ffn_g, 2, (size_t)DM * DE, (size_t)2048 * 2048);
    k_transpose<<<dim3(DE / 32, DM / 32, NE), 256, 0, stream>>>(wup, DM, DE, Wgu, ffn_g, 3, (size_t)DM * DE, (size_t)2048 * 2048);
    k_transpose<<<dim3(DM / 32, DE / 32, NE), 256, 0, stream>>>(wdown, DE, DM, Wd, nullptr, 0, (size_t)DE * DM, (size_t)2048 * 1024);
    k_tables<<<256, 256, 0, stream>>>(rope, WrT, WsB, lam, wgrp, wrt, ffn_g, gws, lq1, lk1, lq2, lk2);
    k_xnorm<<<T, 256, 0, stream>>>(x, XN);
    { P_G1 p{XN, Win, Z}; k_gemm128<P_G1><<<dim3(INW / 128, T / 128), 256, 16384, stream>>>(p); }
    k_post<<<T, 256, 0, stream>>>(Z, U, VG, QN, KN, VB, qg, kg, rope);
    k_gmlp<<<NB * 32 * 8, 256, (128 * 129 + 128 * 128) * 4, stream>>>(U, VG, lng, lnb, gws, gbs, MIX);
    k_attn_simple<<<NB * 8 * 256, 256, 0, stream>>>(QN, KN, VB, subg, lam, MIX);
    { P_G2 p{MIX, Wout, x, out, XN}; k_gemm128<P_G2><<<dim3(DM / 128, T / 128), 256, 16384, stream>>>(p); }
    k_route<<<T, 256, 0, stream>>>(out, WrT, bgrp, brt, cnt, list, rec);
    { P_GU p{XN, Wgu, cnt, list, GU}; k_gemm128<P_GU><<<dim3(2048 / 128, SLOTS / 128), 256, 16384, stream>>>(p); }
    k_glu<<<SLOTS, 256, 0, stream>>>(GU, cnt, list, H);
    { P_DN p{H, Wd, cnt, Y}; k_gemm128<P_DN><<<dim3(2048 / 128, SLOTS / 128), 256, 16384, stream>>>(p); }
    k_combine<<<T, 256, 0, stream>>>(out, Y, cnt, rec);
    const hipError_t le = hipPeekAtLastError();
    if (le != hipSuccess) fprintf(stderr, "kernel_launch: launch failed: %s\n", hipGetErrorName(le));
}
```

```cpp
#include <hip/hip_runtime.h>
#include <cstdio>
#include <cstdint>

typedef unsigned short bf16_t;
typedef short bf16x8 __attribute__((ext_vector_type(8)));
typedef float f32x4 __attribute__((ext_vector_type(4)));

constexpr int NB = 4, SEQ = 4096, T = NB * SEQ, DM = 2048, INW = 5120;
constexpr int NE = 32, DE = 1024, SLOTS = 40960;
constexpr float EPS = 1e-6f;
constexpr float C2 = 0.125f * 1.4426950408889634f;

constexpr size_t MiB = 1u << 20;
constexpr size_t WS_CTL = 0;
constexpr size_t WS_ROPE = 1 * MiB;
constexpr size_t WS_WRT = WS_ROPE + 512 * 1024;
constexpr size_t WS_WSB = 2 * MiB;
constexpr size_t WS_WRH = 2 * MiB + 256 * 1024;
constexpr size_t WS_LAM = 3 * MiB;
constexpr size_t WS_LIST = 4 * MiB;
constexpr size_t WS_REC = 8 * MiB;
constexpr size_t WS_WIN = 12 * MiB;
constexpr size_t WS_WOUT = 32 * MiB;
constexpr size_t WS_WGU = 40 * MiB;
constexpr size_t WS_WD = 296 * MiB;
constexpr size_t WS_XN = 424 * MiB;
constexpr size_t WS_MIX = 488 * MiB;
constexpr size_t WS_Z = 552 * MiB;
constexpr size_t WS_U = 712 * MiB;
constexpr size_t WS_H = 552 * MiB;
constexpr size_t WS_Y = 632 * MiB;
constexpr size_t WS_END = 872 * MiB;

__device__ __forceinline__ unsigned f2bf(float f) { unsigned u = __builtin_bit_cast(unsigned, f); return (u + 0x7fffu + ((u >> 16) & 1u)) >> 16; }
__device__ __forceinline__ float bf2f(unsigned h) { return __builtin_bit_cast(float, h << 16); }
__device__ __forceinline__ unsigned pk2(float lo, float hi) { return f2bf(lo) | (f2bf(hi) << 16); }
__device__ __forceinline__ float wave_sum(float v) {
#pragma unroll
    for (int o = 1; o < 64; o <<= 1) v += __shfl_xor(v, o);
    return v;
}
__device__ __forceinline__ float gelu_tanh(float x) { const float u = 0.7978845608028654f * (x + 0.044715f * x * x * x); return 0.5f * x * (1.f + tanhf(u)); }
__device__ __forceinline__ void unpack8(uint4 r, float* f) {
    f[0] = bf2f(r.x & 0xffffu); f[1] = bf2f(r.x >> 16); f[2] = bf2f(r.y & 0xffffu); f[3] = bf2f(r.y >> 16);
    f[4] = bf2f(r.z & 0xffffu); f[5] = bf2f(r.z >> 16); f[6] = bf2f(r.w & 0xffffu); f[7] = bf2f(r.w >> 16);
}
__device__ __forceinline__ uint4 pack8(const float* f) { uint4 r; r.x = pk2(f[0], f[1]); r.y = pk2(f[2], f[3]); r.z = pk2(f[4], f[5]); r.w = pk2(f[6], f[7]); return r; }

__device__ __forceinline__ int map_row(int mode, int n) {
    if (mode == 1) { const int pn = n >> 8, r = n & 255, wc = r >> 6, bj = (r >> 5) & 1, j = r & 31; return (pn << 8) + (bj << 7) + (wc << 5) + j; }
    if (mode == 2) return ((n >> 7) << 8) + (n & 127);
    if (mode == 3) return ((n >> 7) << 8) + 128 + (n & 127);
    return n;
}
__device__ __forceinline__ int win_logical(int np) { const int pn = np >> 8, r = np & 255, bj = r >> 7, wc = (r >> 5) & 3, j = r & 31; return (pn << 8) + (wc << 6) + (bj << 5) + j; }

__global__ __launch_bounds__(256) void k_transpose(const float* __restrict__ W, int K, int N, bf16_t* __restrict__ WT, const float* __restrict__ gk, int mode, size_t wes, size_t wtes) {
    __shared__ float t[32][33];
    const int tx = threadIdx.x & 31, ty = threadIdx.x >> 5;
    const int k0 = blockIdx.y * 32, n0 = blockIdx.x * 32; const size_t e = blockIdx.z;
    const float* Wp = W + e * wes; bf16_t* WTp = WT + e * wtes;
#pragma unroll
    for (int i = 0; i < 4; ++i) { const int kk = ty + 8 * i; const float g = gk ? gk[k0 + kk] : 1.f; t[kk][tx] = Wp[(size_t)(k0 + kk) * N + n0 + tx] * g; }
    __syncthreads();
#pragma unroll
    for (int i = 0; i < 4; ++i) { const int nn = ty + 8 * i; const int np = map_row(mode, n0 + nn); WTp[(size_t)np * K + k0 + tx] = (bf16_t)f2bf(t[tx][nn]); }
}

__device__ __forceinline__ float block_sum256(float v, float* red) {
    v = wave_sum(v); const int wid = threadIdx.x >> 6;
    if ((threadIdx.x & 63) == 0) red[wid] = v;
    __syncthreads(); const float r = red[0] + red[1] + red[2] + red[3]; __syncthreads(); return r;
}

__global__ __launch_bounds__(256) void k_xnorm(const float* __restrict__ x, bf16_t* __restrict__ XN) {
    __shared__ float red[4];
    const int t = blockIdx.x, tid = threadIdx.x;
    const float4* xr = (const float4*)(x + (size_t)t * DM) + tid * 2; const float4 a = xr[0], b = xr[1];
    float ss = a.x * a.x + a.y * a.y + a.z * a.z + a.w * a.w + b.x * b.x + b.y * b.y + b.z * b.z + b.w * b.w;
    ss = block_sum256(ss, red);
    const float rs = rsqrtf(ss * (1.f / DM) + EPS);
    uint4 o; o.x = pk2(a.x * rs, a.y * rs); o.y = pk2(a.z * rs, a.w * rs); o.z = pk2(b.x * rs, b.y * rs); o.w = pk2(b.z * rs, b.w * rs);
    *(uint4*)(XN + (size_t)t * DM + tid * 8) = o;
}

__global__ __launch_bounds__(256) void k_tables(float2* rope, float* WrT, bf16_t* WsB, float* lam, const float* wgrp, const float* wrt, const float* fng, const float* ws,
                                                const float* lq1, const float* lk1, const float* lq2, const float* lk2) {
    const int gid = blockIdx.x * 256 + threadIdx.x, gsz = gridDim.x * 256;
    for (int i = gid; i < 4096 * 8; i += gsz) { const int pos = i >> 3, f = i & 7; const float inv = 1.0f / powf(500000.0f, (float)(2 * f) / 16.0f); const float ang = (float)pos * inv; rope[i] = make_float2(cosf(ang), sinf(ang)); }
    for (int i = gid; i < 36 * 2048; i += gsz) { const int c = i / 2048, k = i % 2048; const float w = c < 4 ? wgrp[k * 4 + c] : wrt[k * 32 + (c - 4)]; WrT[i] = w * fng[k]; }
    for (int i = gid; i < 8 * 128 * 128; i += gsz) WsB[i] = (bf16_t)f2bf(ws[i]);
    if (gid == 0) { float a = 0.f, b = 0.f; for (int i = 0; i < 64; ++i) { a += lq1[i] * lk1[i]; b += lq2[i] * lk2[i]; } lam[0] = expf(a) - expf(b) + 0.2f; }
}

struct TileBase { const bf16_t* Bt; int K; };
template <class P> __global__ __launch_bounds__(256, 2) void k_gemm128(P p) {
    extern __shared__ __attribute__((aligned(16))) bf16_t shm[];
    typename P::Tile ti; if (!p.tile(ti)) return;
    const int tid = threadIdx.x, wid = tid >> 6, lane = tid & 63, wr = wid >> 1, wc = wid & 1, fr = lane & 15, fq = lane >> 4;
    bf16_t* SA = shm; bf16_t* SB = shm + 4096;
    const int sr = tid >> 2, scol = (tid & 3) * 8; const int K = ti.K;
    const bf16_t* a0 = p.arow(ti, sr) + scol; const bf16_t* a1 = p.arow(ti, sr + 64) + scol;
    const bf16_t* b0 = ti.Bt + (size_t)sr * K + scol; const bf16_t* b1 = ti.Bt + (size_t)(sr + 64) * K + scol;
    f32x4 acc[4][4];
#pragma unroll
    for (int m = 0; m < 4; ++m)
#pragma unroll
        for (int n = 0; n < 4; ++n) acc[m][n] = (f32x4){0.f, 0.f, 0.f, 0.f};
    bf16x8 At[4], Bl[4];
    for (int t = 0; t < K / 32; ++t) {
        __builtin_amdgcn_global_load_lds((const unsigned*)(a0 + t * 32), (unsigned*)((char*)SA + tid * 16), 16, 0, 0);
        __builtin_amdgcn_global_load_lds((const unsigned*)(a1 + t * 32), (unsigned*)((char*)SA + tid * 16 + 4096), 16, 0, 0);
        __builtin_amdgcn_global_load_lds((const unsigned*)(b0 + t * 32), (unsigned*)((char*)SB + tid * 16), 16, 0, 0);
        __builtin_amdgcn_global_load_lds((const unsigned*)(b1 + t * 32), (unsigned*)((char*)SB + tid * 16 + 4096), 16, 0, 0);
        asm volatile("s_waitcnt vmcnt(0)" ::: "memory"); __syncthreads();
#pragma unroll
        for (int m = 0; m < 4; ++m) At[m] = *reinterpret_cast<const bf16x8*>((char*)SA + (wr * 64 + m * 16 + fr) * 64 + fq * 16);
#pragma unroll
        for (int n = 0; n < 4; ++n) Bl[n] = *reinterpret_cast<const bf16x8*>((char*)SB + (wc * 64 + n * 16 + fr) * 64 + fq * 16);
        asm volatile("s_waitcnt lgkmcnt(0)" ::: "memory"); __builtin_amdgcn_sched_barrier(0);
#pragma unroll
        for (int m = 0; m < 4; ++m)
#pragma unroll
            for (int n = 0; n < 4; ++n) acc[m][n] = __builtin_amdgcn_mfma_f32_16x16x32_bf16(At[m], Bl[n], acc[m][n], 0, 0, 0);
        __syncthreads();
    }
#pragma unroll
    for (int m = 0; m < 4; ++m)
#pragma unroll
        for (int n = 0; n < 4; ++n)
#pragma unroll
            for (int j = 0; j < 4; ++j) p.store(ti, wr * 64 + m * 16 + fq * 4 + j, wc * 64 + n * 16 + fr, acc[m][n][j]);
}

struct P_G1 {
    struct Tile : TileBase { int brow, bcol; };
    const bf16_t* A; const bf16_t* Bt; bf16_t* Z;
    __device__ bool tile(Tile& ti) const { ti.brow = blockIdx.y * 128; ti.bcol = blockIdx.x * 128; ti.Bt = Bt + (size_t)ti.bcol * DM; ti.K = DM; return true; }
    __device__ const bf16_t* arow(const Tile& ti, int r) const { return A + (size_t)(ti.brow + r) * DM; }
    __device__ void store(const Tile& ti, int r, int c, float v) const { Z[(size_t)(ti.brow + r) * INW + win_logical(ti.bcol + c)] = (bf16_t)f2bf(v); }
};
struct P_G2 {
    struct Tile : TileBase { int brow, bcol; };
    const bf16_t* A; const bf16_t* Bt; const float* x; float* out; bf16_t* X1B;
    __device__ bool tile(Tile& ti) const { ti.brow = blockIdx.y * 128; ti.bcol = blockIdx.x * 128; ti.Bt = Bt + (size_t)ti.bcol * DM; ti.K = DM; return true; }
    __device__ const bf16_t* arow(const Tile& ti, int r) const { return A + (size_t)(ti.brow + r) * DM; }
    __device__ void store(const Tile& ti, int r, int c, float v) const { const size_t o = (size_t)(ti.brow + r) * DM + ti.bcol + c; const float x1 = v + x[o]; out[o] = x1; X1B[o] = (bf16_t)f2bf(x1); }
};
__device__ __forceinline__ bool find_expert(const unsigned* cnt, int slot0, int& e, int& pos0, int& ce) {
    int ps = 0;
    for (int i = 0; i < NE; ++i) { const int c = (int)cnt[i]; const int pad = (c + 255) & ~255; if (slot0 < ps + pad) { e = i; pos0 = slot0 - ps; ce = c; return true; } ps += pad; }
    return false;
}
struct P_GU {
    struct Tile : TileBase { int slot0, bcol, e, pos0, ce; };
    const bf16_t* X1B; const bf16_t* Wgu; const unsigned* cnt; const int2* list; bf16_t* GU;
    __device__ bool tile(Tile& ti) const { ti.slot0 = blockIdx.y * 128; ti.bcol = blockIdx.x * 128; if (!find_expert(cnt, ti.slot0, ti.e, ti.pos0, ti.ce)) return false;
        ti.Bt = Wgu + (size_t)ti.e * 2048 * 2048 + (size_t)ti.bcol * DM; ti.K = DM; return true; }
    __device__ const bf16_t* arow(const Tile& ti, int r) const { const int pos = ti.pos0 + r; const int tok = pos < ti.ce ? list[(size_t)ti.e * T + pos].x : 0; return X1B + (size_t)tok * DM; }
    __device__ void store(const Tile& ti, int r, int c, float v) const { GU[(size_t)(ti.slot0 + r) * 2048 + ti.bcol + c] = (bf16_t)f2bf(v); }
};
struct P_DN {
    struct Tile : TileBase { int slot0, bcol, e, pos0, ce; };
    const bf16_t* H; const bf16_t* Wd; const unsigned* cnt; bf16_t* Y;
    __device__ bool tile(Tile& ti) const { ti.slot0 = blockIdx.y * 128; ti.bcol = blockIdx.x * 128; if (!find_expert(cnt, ti.slot0, ti.e, ti.pos0, ti.ce)) return false;
        ti.Bt = Wd + (size_t)ti.e * 2048 * 1024 + (size_t)ti.bcol * DE; ti.K = DE; return true; }
    __device__ const bf16_t* arow(const Tile& ti, int r) const { return H + (size_t)(ti.slot0 + r) * DE; }
    __device__ void store(const Tile& ti, int r, int c, float v) const { Y[(size_t)(ti.slot0 + r) * 2048 + ti.bcol + c] = (bf16_t)f2bf(v); }
};

__global__ __launch_bounds__(256) void k_post(const bf16_t* __restrict__ Z, bf16_t* U, bf16_t* VG, bf16_t* QN, bf16_t* KN, bf16_t* VB, const float* qg, const float* kg, const float2* rope) {
    const int t = blockIdx.x, tid = threadIdx.x, pos = t & (SEQ - 1);
    const bf16_t* z = Z + (size_t)t * INW; float f[8];
    { unpack8(*(const uint4*)(z + tid * 8), f);
#pragma unroll
      for (int i = 0; i < 8; ++i) f[i] = gelu_tanh(f[i]);
      const uint4 o = pack8(f); if (tid < 128) *(uint4*)(U + (size_t)t * 1024 + tid * 8) = o; else *(uint4*)(VG + (size_t)t * 1024 + (tid - 128) * 8) = o; }
    if (tid < 128) *(uint4*)(VB + (size_t)t * 1024 + tid * 8) = *(const uint4*)(z + 4096 + tid * 8);
    { const bool isk = tid >= 128; const int col = (tid * 8) & 1023, d0 = col & 63, sub = d0 >> 3;
      unpack8(*(const uint4*)(z + 2048 + tid * 8), f);
      float ss = 0.f;
#pragma unroll
      for (int i = 0; i < 8; ++i) ss += f[i] * f[i];
      ss += __shfl_xor(ss, 1); ss += __shfl_xor(ss, 2); ss += __shfl_xor(ss, 4);
      const float rs = rsqrtf(ss * (1.f / 64.f) + EPS); const float* g = isk ? kg : qg;
      float y[8], pr[8];
#pragma unroll
      for (int i = 0; i < 8; ++i) y[i] = f[i] * rs * g[d0 + i];
#pragma unroll
      for (int i = 0; i < 8; ++i) pr[i] = __shfl_xor(y[i], 1);
      if (sub < 2) {
#pragma unroll
          for (int i = 0; i < 8; ++i) { const float2 cs = rope[pos * 8 + i]; y[i] = sub == 0 ? y[i] * cs.x - pr[i] * cs.y : y[i] * cs.x + pr[i] * cs.y; } }
      if (!isk) {
#pragma unroll
          for (int i = 0; i < 8; ++i) y[i] *= C2; }
      *(uint4*)((isk ? KN : QN) + (size_t)t * 1024 + col) = pack8(y); }
}

__global__ __launch_bounds__(256) void k_gmlp(const bf16_t* __restrict__ U, const bf16_t* __restrict__ VG, const float* lng, const float* lnb, const float* Ws, const float* bs, bf16_t* MIX) {
    extern __shared__ __attribute__((aligned(16))) float sm[];
    float* vln = sm; float* wsl = sm + 128 * 129;
    const int blk = blockIdx.x, h = blk & 7, c = (blk >> 3) & 31, b = blk >> 8, t0 = b * SEQ + c * 128;
    const int tid = threadIdx.x, wid = tid >> 6, lane = tid & 63;
    for (int i = tid; i < 128 * 128; i += 256) wsl[i] = Ws[(size_t)h * 16384 + i];
    for (int jj = 0; jj < 32; ++jj) { const int j = wid * 32 + jj; const bf16_t* vr = VG + (size_t)(t0 + j) * 1024 + h * 128;
        const float a = bf2f(vr[lane]), b2 = bf2f(vr[lane + 64]); const float mu = wave_sum(a + b2) * (1.f / 128.f); const float da = a - mu, db = b2 - mu;
        const float rs = rsqrtf(wave_sum(da * da + db * db) * (1.f / 128.f) + EPS);
        vln[j * 129 + lane] = da * rs * lng[h * 128 + lane] + lnb[h * 128 + lane]; vln[j * 129 + lane + 64] = db * rs * lng[h * 128 + lane + 64] + lnb[h * 128 + lane + 64]; }
    __syncthreads();
    const int d = tid & 127, ih = tid >> 7; float acc[64];
#pragma unroll
    for (int i = 0; i < 64; ++i) acc[i] = 0.f;
    for (int j = 0; j < 128; ++j) { const float v = vln[j * 129 + d];
#pragma unroll
        for (int i = 0; i < 64; ++i) acc[i] += wsl[(ih * 64 + i) * 128 + j] * v; }
#pragma unroll
    for (int i = 0; i < 64; ++i) { const int row = t0 + ih * 64 + i; const float s = acc[i] + bs[h * 128 + ih * 64 + i];
        const float u = bf2f(U[(size_t)row * 1024 + h * 128 + d]); MIX[(size_t)row * DM + h * 128 + d] = (bf16_t)f2bf(u * s); }
}

__global__ __launch_bounds__(256) void k_attn_simple(const bf16_t* __restrict__ QN, const bf16_t* __restrict__ KN, const bf16_t* __restrict__ VB, const float* subg, const float* lamp, bf16_t* MIX) {
    const int tid = threadIdx.x, part = tid & 15, qr = tid >> 4;
    const int blk = blockIdx.x, qb = blk & 255, h = (blk >> 8) & 7, b = blk >> 11;
    const int t = b * SEQ + qb * 16 + qr;
    float q1[4], q2[4];
    { const uint2 a = *(const uint2*)(QN + (size_t)t * 1024 + h * 128 + part * 4), c = *(const uint2*)(QN + (size_t)t * 1024 + h * 128 + 64 + part * 4);
      q1[0] = bf2f(a.x & 0xffffu); q1[1] = bf2f(a.x >> 16); q1[2] = bf2f(a.y & 0xffffu); q1[3] = bf2f(a.y >> 16);
      q2[0] = bf2f(c.x & 0xffffu); q2[1] = bf2f(c.x >> 16); q2[2] = bf2f(c.y & 0xffffu); q2[3] = bf2f(c.y >> 16); }
    float o1[8], o2[8], l1 = 0.f, l2 = 0.f;
#pragma unroll
    for (int e = 0; e < 8; ++e) { o1[e] = 0.f; o2[e] = 0.f; }
    const bf16_t* Kb = KN + (size_t)(b * SEQ) * 1024 + h * 128; const bf16_t* Vb = VB + (size_t)(b * SEQ) * 1024 + h * 128;
#pragma unroll 4
    for (int j = 0; j < SEQ; ++j) {
        const uint2 ka = *(const uint2*)(Kb + (size_t)j * 1024 + part * 4), kc = *(const uint2*)(Kb + (size_t)j * 1024 + 64 + part * 4); const uint4 vr = *(const uint4*)(Vb + (size_t)j * 1024 + part * 8);
        float s1 = q1[0] * bf2f(ka.x & 0xffffu) + q1[1] * bf2f(ka.x >> 16) + q1[2] * bf2f(ka.y & 0xffffu) + q1[3] * bf2f(ka.y >> 16);
        float s2 = q2[0] * bf2f(kc.x & 0xffffu) + q2[1] * bf2f(kc.x >> 16) + q2[2] * bf2f(kc.y & 0xffffu) + q2[3] * bf2f(kc.y >> 16);
        s1 += __shfl_xor(s1, 1); s2 += __shfl_xor(s2, 1); s1 += __shfl_xor(s1, 2); s2 += __shfl_xor(s2, 2); s1 += __shfl_xor(s1, 4); s2 += __shfl_xor(s2, 4); s1 += __shfl_xor(s1, 8); s2 += __shfl_xor(s2, 8);
        const float p1 = exp2f(s1), p2 = exp2f(s2); l1 += p1; l2 += p2; float v[8]; unpack8(vr, v);
#pragma unroll
        for (int e = 0; e < 8; ++e) { o1[e] += p1 * v[e]; o2[e] += p2 * v[e]; }
    }
    const float lam = lamp[0], i1 = 1.f / l1, i2 = lam / l2; float o[8], ss = 0.f;
#pragma unroll
    for (int e = 0; e < 8; ++e) { o[e] = o1[e] * i1 - o2[e] * i2; ss += o[e] * o[e]; }
    ss += __shfl_xor(ss, 1); ss += __shfl_xor(ss, 2); ss += __shfl_xor(ss, 4); ss += __shfl_xor(ss, 8);
    const float rs = rsqrtf(ss * (1.f / 128.f) + EPS);
#pragma unroll
    for (int e = 0; e < 8; ++e) o[e] = o[e] * rs * subg[part * 8 + e] * 0.8f;
    *(uint4*)(MIX + (size_t)t * DM + 1024 + h * 128 + part * 8) = pack8(o);
}

__global__ __launch_bounds__(256) void k_route(const float* __restrict__ x1, const float* __restrict__ WrT, const float* bg, const float* br, unsigned* cnt, int2* list, int4* rec) {
    __shared__ float red[4][40];
    const int t = blockIdx.x, tid = threadIdx.x, lane = tid & 63, wid = tid >> 6;
    float xv[8]; { const float4* xr = (const float4*)(x1 + (size_t)t * DM) + tid * 2; const float4 a = xr[0], b = xr[1]; xv[0] = a.x; xv[1] = a.y; xv[2] = a.z; xv[3] = a.w; xv[4] = b.x; xv[5] = b.y; xv[6] = b.z; xv[7] = b.w; }
    float ss = 0.f;
#pragma unroll
    for (int i = 0; i < 8; ++i) ss += xv[i] * xv[i];
    ss = wave_sum(ss); if (lane == 0) red[wid][36] = ss;
    for (int c = 0; c < 36; ++c) { const float4* wr = (const float4*)(WrT + (size_t)c * DM) + tid * 2; const float4 a = wr[0], b = wr[1];
        float p = xv[0] * a.x + xv[1] * a.y + xv[2] * a.z + xv[3] * a.w + xv[4] * b.x + xv[5] * b.y + xv[6] * b.z + xv[7] * b.w; p = wave_sum(p); if (lane == 0) red[wid][c] = p; }
    __syncthreads();
    if (tid < 37) red[0][tid] = red[0][tid] + red[1][tid] + red[2][tid] + red[3][tid];
    __syncthreads();
    if (tid == 0) {
        const float* tot = red[0];
        const float rs = rsqrtf(tot[36] * (1.f / DM) + EPS);
        int gi = 0; float lgm = tot[0] * rs + bg[0];
        for (int g = 1; g < 4; ++g) { const float l = tot[g] * rs + bg[g]; if (l > lgm) { lgm = l; gi = g; } }
        float den = 0.f; for (int g = 0; g < 4; ++g) den += expf(tot[g] * rs + bg[g] - lgm); const float gw = 1.f / den;
        float* le = red[1]; for (int j = 0; j < 8; ++j) le[j] = tot[4 + gi * 8 + j] * rs + br[gi * 8 + j];
        int e0 = 0; for (int j = 1; j < 8; ++j) if (le[j] > le[e0]) e0 = j;
        int e1 = e0 == 0 ? 1 : 0; for (int j = 0; j < 8; ++j) if (j != e0 && le[j] > le[e1]) e1 = j;
        const float w0 = 1.f / (1.f + expf(le[e1] - le[e0])), w1 = 1.f - w0;
        const int E0 = gi * 8 + e0, E1 = gi * 8 + e1;
        const unsigned p0 = atomicAdd(&cnt[E0], 1u), p1 = atomicAdd(&cnt[E1], 1u);
        list[(size_t)E0 * T + p0] = make_int2(t, __float_as_int(rs)); list[(size_t)E1 * T + p1] = make_int2(t, __float_as_int(rs));
        rec[t] = make_int4((E0 << 16) | (int)p0, (E1 << 16) | (int)p1, __float_as_int(gw * w0), __float_as_int(gw * w1));
    }
}

__global__ __launch_bounds__(256) void k_glu(const bf16_t* __restrict__ GU, const unsigned* cnt, const int2* list, bf16_t* H) {
    const int slot = blockIdx.x, tid = threadIdx.x; int e, pos, ce; if (!find_expert(cnt, slot, e, pos, ce)) return;
    const float rs = pos < ce ? __int_as_float(list[(size_t)e * T + pos].y) : 0.f;
    const int c = tid * 4, base = ((c >> 7) << 8) + (c & 127);
    const uint2 g = *(const uint2*)(GU + (size_t)slot * 2048 + base), u = *(const uint2*)(GU + (size_t)slot * 2048 + base + 128);
    float gv[4] = {bf2f(g.x & 0xffffu), bf2f(g.x >> 16), bf2f(g.y & 0xffffu), bf2f(g.y >> 16)}, uv[4] = {bf2f(u.x & 0xffffu), bf2f(u.x >> 16), bf2f(u.y & 0xffffu), bf2f(u.y >> 16)}, hv[4];
#pragma unroll
    for (int i = 0; i < 4; ++i) { const float a = gv[i] * rs; hv[i] = a / (1.f + expf(-a)) * (uv[i] * rs); }
    uint2 o; o.x = pk2(hv[0], hv[1]); o.y = pk2(hv[2], hv[3]); *(uint2*)(H + (size_t)slot * DE + c) = o;
}

__global__ __launch_bounds__(256) void k_combine(float* out, const bf16_t* __restrict__ Y, const unsigned* cnt, const int4* rec) {
    __shared__ int ps[NE];
    const int t = blockIdx.x, tid = threadIdx.x;
    if (tid == 0) { int s = 0; for (int i = 0; i < NE; ++i) { ps[i] = s; s += ((int)cnt[i] + 255) & ~255; } }
    __syncthreads();
    const int4 r = rec[t]; const int s0 = ps[r.x >> 16] + (r.x & 0xffff), s1 = ps[r.y >> 16] + (r.y & 0xffff); const float w0 = __int_as_float(r.z), w1 = __int_as_float(r.w);
    float a[8], b[8]; unpack8(*(const uint4*)(Y + (size_t)s0 * 2048 + tid * 8), a); unpack8(*(const uint4*)(Y + (size_t)s1 * 2048 + tid * 8), b);
    float4* o = (float4*)(out + (size_t)t * DM) + tid * 2; float4 x0 = o[0], x1 = o[1];
    x0.x += w0 * a[0] + w1 * b[0]; x0.y += w0 * a[1] + w1 * b[1]; x0.z += w0 * a[2] + w1 * b[2]; x0.w += w0 * a[3] + w1 * b[3];
    x1.x += w0 * a[4] + w1 * b[4]; x1.y += w0 * a[5] + w1 * b[5]; x1.z += w0 * a[6] + w1 * b[6]; x1.w += w0 * a[7] + w1 * b[7];
    o[0] = x0; o[1] = x1;
}


#include <hip/hip_cooperative_groups.h>
namespace cg = cooperative_groups;
#define LAS __attribute__((address_space(3)))
#define GAS __attribute__((address_space(1)))
typedef unsigned u32x4 __attribute__((ext_vector_type(4)));
typedef unsigned u32x2 __attribute__((ext_vector_type(2)));
typedef float f32x2 __attribute__((ext_vector_type(2)));
#define LDS_WAIT() asm volatile("s_waitcnt lgkmcnt(0)" ::: "memory")
#define VM_WAIT() asm volatile("s_waitcnt vmcnt(0)" ::: "memory")

#ifndef MK_F8
#define MK_F8 1
#endif
#ifndef MK_F8_P1
#define MK_F8_P1 0
#endif
constexpr float F8_SXN = 16.f, F8_SWI = 256.f;
constexpr float F8_SX = 16.f, F8_SW = 256.f, F8_SH = 8.f, F8_SD = 128.f;
typedef int i32x4 __attribute__((ext_vector_type(4)));
typedef int i32x8 __attribute__((ext_vector_type(8)));
constexpr int NWAVES = 8, NTHR = 512;
constexpr int RING_BYTES = 131072, EXTRA_OFF = RING_BYTES, LDS_BYTES = 163840;
typedef __bf16 bf16x2_t __attribute__((ext_vector_type(2)));
__device__ __forceinline__ unsigned cvt_pk_bf16(float lo, float hi) { const f32x2 v = {lo, hi}; const bf16x2_t b = __builtin_convertvector(v, bf16x2_t); return __builtin_bit_cast(unsigned, b); }
__device__ __forceinline__ float fast_gelu(float x) { const float e = __builtin_amdgcn_exp2f(-2.302208198f * (x + 0.044715f * x * x * x)); return x * __builtin_amdgcn_rcpf(1.f + e); }
__device__ __forceinline__ float clamp448(float x) { return __builtin_fminf(__builtin_fmaxf(x, -448.f), 448.f); }
__device__ __forceinline__ unsigned pk4_fp8(float a, float b, float c, float d) { int w = 0; w = __builtin_amdgcn_cvt_pk_fp8_f32(clamp448(a), clamp448(b), w, false); w = __builtin_amdgcn_cvt_pk_fp8_f32(clamp448(c), clamp448(d), w, true); return (unsigned)w; }
__device__ __forceinline__ float fast_silu(float a) { return a * __builtin_amdgcn_rcpf(1.f + __builtin_amdgcn_exp2f(-1.4426950408889634f * a)); }

constexpr int WTAB_OFF = EXTRA_OFF + 4096 + 256;
__device__ __forceinline__ unsigned mk_hwslot() { return (unsigned)__builtin_amdgcn_s_getreg((5 << 11) | 4) & 63u; }
#ifndef MK_HWTID
#define MK_HWTID 1
#endif
__device__ __forceinline__ int mk_tid(LAS unsigned char* lds) {
    if (!MK_HWTID) { int t = threadIdx.x; asm volatile("" : "+v"(t)); return t; }
    const int w = __builtin_amdgcn_readfirstlane((int)((volatile LAS unsigned char*)(lds + WTAB_OFF))[mk_hwslot()]);
    int l; asm volatile("v_mbcnt_lo_u32_b32 %0, -1, 0\n\tv_mbcnt_hi_u32_b32 %0, -1, %0" : "=v"(l));
    return w * 64 + l;
}
namespace pg8 {
constexpr int BM = 256, BK = 64, HALF = 128, HTB = HALF * BK * 2, STAGE_BYTES = 8 * HTB, NXCD = 8, WGM = 8;
__host__ __device__ __forceinline__ int lds_byte(int r, int c) { const int st = (r >> 4) * 2 + (c >> 5), rr = r & 15, cc = c & 31, ob = rr * 64 + cc * 2; return st * 1024 + (ob ^ (((ob >> 9) & 1) << 5)); }
__host__ __device__ __forceinline__ void stage_rc(int b, int& R, int& C) { const int st = b / 1024, sb = b % 1024, swz = sb ^ (((sb >> 9) & 1) << 5); R = (st >> 1) * 16 + swz / 64; C = (st & 1) * 32 + (swz % 64) / 2; }
__host__ __device__ __forceinline__ int perm32(int rho) { const int n = rho >> 4, i = rho & 15; return 8 * (i >> 2) + 4 * n + (i & 3); }

struct Unit { unsigned Ao, Bo; int pm, pn, e, pos0, ce; };

struct StaticOrder {
    int nM, nN, nwg, G, c, K, esz; const char* A; const char* Bt;
    __device__ void init(const void* A_, const void* Bt_, int M, int N, int K_, int G_, int c_, int esz_ = 2) { A = (const char*)A_; Bt = (const char*)Bt_; nM = M / BM; nN = N / BM; nwg = nM * nN; G = G_; c = c_; K = K_; esz = esz_; }
    __device__ bool next(int i, Unit& u) const {
        const long L = (long)i * G + c; if (L >= nwg) return false;
        int wgid = (int)L; { const int q = nwg / NXCD, r = nwg % NXCD, xcd = wgid % NXCD, off = wgid / NXCD; wgid = (xcd < r ? xcd * (q + 1) : r * (q + 1) + (xcd - r) * q) + off; }
        const int nig = WGM * nN, gid = wgid / nig, fm = gid * WGM, gsz = (nM - fm) < WGM ? (nM - fm) : WGM;
        u.pm = fm + ((wgid % nig) % gsz); u.pn = (wgid % nig) / gsz; u.e = 0; u.pos0 = 0; u.ce = 0;
        u.Ao = (unsigned)u.pm * BM * K * (unsigned)esz; u.Bo = (unsigned)u.pn * BM * K * (unsigned)esz; return true;
    }
    __device__ __forceinline__ void fill(const Unit&, LAS unsigned* dst, int tid) const { if (tid < BM) dst[tid] = (unsigned)(tid * K) * (unsigned)esz; }
};
template <bool GATHER, int KK, int ESZ> struct MoeOrder {
    const volatile LAS int* cntl; int G, vcu; const char* A; const char* Bt; const int2* list;
    static constexpr int nN = 8;
    __device__ bool next(int i, Unit& u) const {
        const int q = i * G + vcu; const int rt = q / nN, pn = q - rt * nN;
        if (rt >= 160) return false;
        const int e = __builtin_amdgcn_readfirstlane(cntl[64 + rt]); if (e < 0) return false;
        u.pm = rt; u.pn = pn; u.e = e; u.pos0 = __builtin_amdgcn_readfirstlane(cntl[224 + rt]); u.ce = __builtin_amdgcn_readfirstlane(cntl[e]);
        u.Bo = (unsigned)(e * 2048 + pn * BM) * (unsigned)(KK * ESZ); u.Ao = GATHER ? 0u : (unsigned)rt * (unsigned)(BM * KK * ESZ); return true;
    }
    __device__ __forceinline__ void fill(const Unit& u, LAS unsigned* dst, int tid) const {
        if (tid < BM) { if (GATHER) { const int pos = u.pos0 + tid; const int tok = pos < u.ce ? list[(size_t)u.e * T + pos].x : 0; dst[tid] = (unsigned)(tok * KK) * (unsigned)ESZ; } else dst[tid] = (unsigned)(tid * KK) * (unsigned)ESZ; }
    }
};

#ifndef MK_WT
#define MK_WT 0
#endif
struct EpiG1 {
    static constexpr bool PERM = true;
    bf16_t* U5; const float* qg; const float* kg; const float2* rope;
    __device__ __forceinline__ void operator()(const f32x4 (&acc)[2][2][4][2], const Unit& u, int wr, int wc, int fr, int fq) const {
        const int kind = u.pn >> 2, lc0 = (u.pn & 3) * 256 + wc * 64 + 8 * fq, row0 = u.pm * BM + wr * 64 + fr;
        const int lx_ = (fq * 16 + fr) << 2;
#define SX(v, m) __int_as_float(__builtin_amdgcn_ds_bpermute(lx_ ^ ((m) << 2), __float_as_int(v)))
        const __amdgpu_buffer_rsrc_t rsU = __builtin_amdgcn_make_buffer_rsrc((void*)U5, (short)0, 0x7fffffff, 0x00020000);
        constexpr float DS = MK_F8_P1 ? 1.f / (F8_SXN * F8_SWI) : 1.f;
        if (kind == 2 || kind == 3) {
            const float* g = kind == 2 ? qg : kg; const float sc = kind == 2 ? C2 : 1.f;
            f32x4 gv[2][2];
#pragma unroll
            for (int bj = 0; bj < 2; ++bj)
#pragma unroll
                for (int n = 0; n < 2; ++n) gv[bj][n] = *(const f32x4*)(g + 32 * bj + 8 * fq + 4 * n);
#pragma unroll
            for (int ai = 0; ai < 2; ++ai)
#pragma unroll
                for (int m = 0; m < 4; ++m) {
                    const int row = row0 + ai * HALF + m * 16, pos = row & (SEQ - 1);
                    float ss = 0.f;
#pragma unroll
                    for (int bj = 0; bj < 2; ++bj)
#pragma unroll
                        for (int n = 0; n < 2; ++n) { const f32x4 x = acc[ai][bj][m][n] * DS; ss += (x[0] * x[0] + x[1] * x[1]) + (x[2] * x[2] + x[3] * x[3]); }
                    ss += SX(ss, 16); ss += SX(ss, 32);
                    const float rs = rsqrtf(ss * (1.f / 64.f) + EPS) * sc;
                    f32x4 y[2][2];
#pragma unroll
                    for (int bj = 0; bj < 2; ++bj)
#pragma unroll
                        for (int n = 0; n < 2; ++n) y[bj][n] = acc[ai][bj][m][n] * (rs * DS) * gv[bj][n];
                    f32x4 pr[2];
#pragma unroll
                    for (int n = 0; n < 2; ++n)
#pragma unroll
                        for (int e = 0; e < 4; ++e) pr[n][e] = SX(y[0][n][e], 16);
                    if (fq < 2) {
#pragma unroll
                        for (int n = 0; n < 2; ++n) { const f32x4 c01 = *(const f32x4*)(rope + pos * 8 + 4 * n), c23 = *(const f32x4*)(rope + pos * 8 + 4 * n + 2);
                            const float cs[4] = {c01[0], c01[2], c23[0], c23[2]}, sn[4] = {c01[1], c01[3], c23[1], c23[3]};
#pragma unroll
                            for (int e = 0; e < 4; ++e) y[0][n][e] = fq == 0 ? y[0][n][e] * cs[e] - pr[n][e] * sn[e] : y[0][n][e] * cs[e] + pr[n][e] * sn[e]; }
                    }
                    const int vo = ((kind * T + row) * 1024 + lc0) * 2;
#pragma unroll
                    for (int bj = 0; bj < 2; ++bj) { u32x4 w; w.x = cvt_pk_bf16(y[bj][0][0], y[bj][0][1]); w.y = cvt_pk_bf16(y[bj][0][2], y[bj][0][3]); w.z = cvt_pk_bf16(y[bj][1][0], y[bj][1][1]); w.w = cvt_pk_bf16(y[bj][1][2], y[bj][1][3]);
                        __builtin_amdgcn_raw_buffer_store_b128(w, rsU, vo + 64 * bj, 0, MK_WT ? 16 : 0); }
                }
        } else {
#pragma unroll
            for (int ai = 0; ai < 2; ++ai)
#pragma unroll
                for (int m = 0; m < 4; ++m) { const int vo = ((kind * T + row0 + ai * HALF + m * 16) * 1024 + lc0) * 2;
#pragma unroll
                    for (int bj = 0; bj < 2; ++bj) { f32x4 v0 = acc[ai][bj][m][0] * DS, v1 = acc[ai][bj][m][1] * DS;
                        if (kind != 4) {
#pragma unroll
                            for (int e = 0; e < 4; ++e) { v0[e] = fast_gelu(v0[e]); v1[e] = fast_gelu(v1[e]); } }
                        u32x4 w; w.x = cvt_pk_bf16(v0[0], v0[1]); w.y = cvt_pk_bf16(v0[2], v0[3]); w.z = cvt_pk_bf16(v1[0], v1[1]); w.w = cvt_pk_bf16(v1[2], v1[3]);
                        __builtin_amdgcn_raw_buffer_store_b128(w, rsU, vo + 64 * bj, 0, MK_WT ? 16 : 0); } }
        }
    }
};
#undef SX
struct EpiG2 {
    static constexpr bool PERM = false;
    const float* x; float* out; bf16_t* X1B; int skip;
    __device__ __forceinline__ void operator()(const f32x4 (&acc)[2][2][4][2], const Unit& u, int wr, int wc, int fr, int fq) const {
        if (skip == 3) return;
        const __amdgpu_buffer_rsrc_t rsO = __builtin_amdgcn_make_buffer_rsrc((void*)out, (short)0, 0x7fffffff, 0x00020000);
        const int col0 = u.pn * BM + wc * 32 + 4 * fq;
#pragma unroll
        for (int ai = 0; ai < 2; ++ai) {
            f32x4 xv[4][2][2];
#pragma unroll
            for (int m = 0; m < 4; ++m) { const size_t off = (size_t)(u.pm * BM + ai * HALF + wr * 64 + m * 16 + fr) * DM + col0;
#pragma unroll
                for (int bj = 0; bj < 2; ++bj)
#pragma unroll
                    for (int n = 0; n < 2; ++n) xv[m][bj][n] = *(const f32x4*)(x + off + bj * HALF + n * 16); }
            __builtin_amdgcn_sched_barrier(0);
#pragma unroll
            for (int m = 0; m < 4; ++m) { const size_t off = (size_t)(u.pm * BM + ai * HALF + wr * 64 + m * 16 + fr) * DM + col0;
#pragma unroll
                for (int bj = 0; bj < 2; ++bj)
#pragma unroll
                    for (int n = 0; n < 2; ++n) { const size_t o = off + bj * HALF + n * 16;
                        f32x4 v = acc[ai][bj][m][n] + xv[m][bj][n];
                        if (skip == 4) { const f32x4 pv = *(const f32x4*)(out + o); if (pv[0] != v[0] || pv[1] != v[1] || pv[2] != v[2] || pv[3] != v[3]) v[0] += 1.0e6f; }
                        if (!(skip & 1)) { if (MK_WT) __builtin_amdgcn_raw_buffer_store_b128(__builtin_bit_cast(u32x4, v), rsO, (int)(o * 4), 0, 16); else *(f32x4*)(out + o) = v; }
                        if (MK_F8) { if (!(skip & 2)) *(unsigned*)((unsigned char*)X1B + o) = pk4_fp8(v[0] * F8_SX, v[1] * F8_SX, v[2] * F8_SX, v[3] * F8_SX); }
                        else { u32x2 w; w.x = cvt_pk_bf16(v[0], v[1]); w.y = cvt_pk_bf16(v[2], v[3]); *(u32x2*)(X1B + o) = w; } } }
        }
    }
};
#ifndef MK_EPI_DRAIN
#define MK_EPI_DRAIN 1
#endif
#ifndef MK_EPI_BUF
#define MK_EPI_BUF 1
#endif
struct EpiGLU {
    static constexpr bool PERM = true;
    bf16_t* H; const int2* list;
    __device__ __forceinline__ void operator()(const f32x4 (&acc)[2][2][4][2], const Unit& u, int wr, int wc, int fr, int fq) const {
        const __amdgpu_buffer_rsrc_t rsL = __builtin_amdgcn_make_buffer_rsrc((void*)list, (short)0, 0x7fffffff, 0x00020000), rsH = __builtin_amdgcn_make_buffer_rsrc((void*)H, (short)0, 0x7fffffff, 0x00020000);
        constexpr int ESZ = MK_F8 ? 1 : 2;
        const int r0 = wr * 64 + fr, soL = u.e * T * 8, soH = (u.pm * BM * DE + u.pn * 128) * ESZ;
#pragma unroll
        for (int ai = 0; ai < 2; ++ai)
#pragma unroll
            for (int m = 0; m < 4; ++m) { const int r = r0 + ai * HALF + m * 16, pos = u.pos0 + r;
                float rs; if (MK_EPI_BUF) { rs = __uint_as_float(__builtin_amdgcn_raw_buffer_load_b32(rsL, pos * 8 + 4, soL, 0)); rs = pos < u.ce ? rs : 0.f; } else rs = pos < u.ce ? __int_as_float(list[(size_t)u.e * T + pos].y) : 0.f;
                if (MK_F8) rs *= 1.f / (F8_SX * F8_SW);
                f32x4 h0, h1;
#pragma unroll
                for (int e = 0; e < 4; ++e) { h0[e] = fast_silu(acc[ai][0][m][0][e] * rs) * (acc[ai][1][m][0][e] * rs); h1[e] = fast_silu(acc[ai][0][m][1][e] * rs) * (acc[ai][1][m][1][e] * rs); }
                const int vo = (r * DE + wc * 32 + 8 * fq) * ESZ;
                if (MK_F8) { u32x2 w; w.x = pk4_fp8(h0[0] * F8_SH, h0[1] * F8_SH, h0[2] * F8_SH, h0[3] * F8_SH); w.y = pk4_fp8(h1[0] * F8_SH, h1[1] * F8_SH, h1[2] * F8_SH, h1[3] * F8_SH);
                    if (MK_EPI_BUF) __builtin_amdgcn_raw_buffer_store_b64(w, rsH, vo + soH, 0, 0); else *(u32x2*)((unsigned char*)H + (size_t)(u.pm * BM + r) * DE + u.pn * 128 + wc * 32 + 8 * fq) = w; }
                else { u32x4 w; w.x = cvt_pk_bf16(h0[0], h0[1]); w.y = cvt_pk_bf16(h0[2], h0[3]); w.z = cvt_pk_bf16(h1[0], h1[1]); w.w = cvt_pk_bf16(h1[2], h1[3]);
                    if (MK_EPI_BUF) __builtin_amdgcn_raw_buffer_store_b128(w, rsH, vo + soH, 0, 0); else *(u32x4*)(H + (size_t)(u.pm * BM + r) * DE + u.pn * 128 + wc * 32 + 8 * fq) = w; } }
    }
};
#ifndef MK_Y8
#define MK_Y8 1
#endif
constexpr float F8_SY = 64.f;
struct EpiY {
    static constexpr bool PERM = true;
    bf16_t* Y; int skip;
    __device__ __forceinline__ void operator()(const f32x4 (&acc)[2][2][4][2], const Unit& u, int wr, int wc, int fr, int fq) const {
        if (skip) return;
        const __amdgpu_buffer_rsrc_t rsY = __builtin_amdgcn_make_buffer_rsrc((void*)Y, (short)0, 0x7fffffff, 0x00020000);
        const int soY = (u.pm * BM * 2048 + u.pn * BM) * 2; const float sc = MK_F8 ? 1.f / (F8_SH * F8_SD) : 1.f;
#pragma unroll
        for (int ai = 0; ai < 2; ++ai)
#pragma unroll
            for (int m = 0; m < 4; ++m) { const int vo = ((ai * HALF + wr * 64 + m * 16 + fr) * 2048 + wc * 32 + 8 * fq) * 2;
#pragma unroll
                for (int bj = 0; bj < 2; ++bj) {
                    if (MK_Y8) { constexpr float s8 = (MK_F8 ? 1.f / (F8_SH * F8_SD) : 1.f) * F8_SY; const f32x4 a0 = acc[ai][bj][m][0], a1 = acc[ai][bj][m][1];
                        u32x2 w8; w8.x = pk4_fp8(a0[0] * s8, a0[1] * s8, a0[2] * s8, a0[3] * s8); w8.y = pk4_fp8(a1[0] * s8, a1[1] * s8, a1[2] * s8, a1[3] * s8);
                        __builtin_amdgcn_raw_buffer_store_b64(w8, rsY, (vo >> 1) + bj * HALF + (soY >> 1), 0, 0);
                        __builtin_amdgcn_sched_barrier(0);
                    } else { const f32x4 v0 = acc[ai][bj][m][0] * sc, v1 = acc[ai][bj][m][1] * sc;
                    u32x4 w; w.x = cvt_pk_bf16(v0[0], v0[1]); w.y = cvt_pk_bf16(v0[2], v0[3]); w.z = cvt_pk_bf16(v1[0], v1[1]); w.w = cvt_pk_bf16(v1[2], v1[3]);
                    if (MK_EPI_BUF) __builtin_amdgcn_raw_buffer_store_b128(w, rsY, vo + bj * HALF * 2 + soY, 0, 0); else *(u32x4*)(Y + (size_t)(u.pm * BM + ai * HALF + wr * 64 + m * 16 + fr) * 2048 + u.pn * BM + wc * 32 + 8 * fq + bj * HALF) = w; } } }
    }
};

template <class Epi, class Sched, bool ALIGN_EPI, bool F8 = false>
__device__ __forceinline__ void gemm_phase(LAS unsigned char* lds, LAS unsigned* rtab  , const int K, const Sched& S, const Epi& E) {
    const int tid = mk_tid(lds), wid = __builtin_amdgcn_readfirstlane(tid >> 6), lane = tid & 63, wr = wid >> 2, wc = wid & 3, fr = lane & 15, fq = lane >> 4;
    const int nt = F8 ? K / 128 : K / BK;
    unsigned voffB[2], rcA[2];
#pragma unroll
    for (int i = 0; i < 2; ++i) { int R, C; stage_rc(tid * 16 + i * 8192, R, C); const int Rb = Epi::PERM ? ((R & ~31) + perm32(R & 31)) : R; voffB[i] = F8 ? (unsigned)(Rb * K + 2 * C) : (unsigned)(Rb * K + C) * 2u; rcA[i] = (unsigned)(R * 4) | ((unsigned)(C * 2) << 16); }
    const unsigned kstep = (unsigned)(BK * 2), hstep = F8 ? (unsigned)(HALF * K) : (unsigned)(HALF * K * 2);
    const unsigned ldsw = (unsigned)wid * 1024u;
    const int aoff = F8 ? lds_byte(wr * 64 + fr, fq * 16) : lds_byte(wr * 64 + fr, fq * 8), boff = F8 ? lds_byte(wc * 32 + fr, fq * 16) : lds_byte(wc * 32 + fr, fq * 8);
#define PG8_SA(b, h) (((b) * 2 + (h)) * HTB)
#define PG8_SB(b, h) ((4 + (b) * 2 + (h)) * HTB)
#define PG8_STAGE(bufoff, so, voff) do { const char* _gb = (const char*)S.Bt + (so); asm volatile("" : "+s"(_gb)); _Pragma("unroll") for (int _i = 0; _i < 2; ++_i) { unsigned _vb = (voff)[_i]; asm volatile("" : "+v"(_vb)); \
        __builtin_amdgcn_global_load_lds((const unsigned*)(_gb + _vb), (LAS unsigned*)(lds + (bufoff) + ldsw + _i * 8192), 16, 0, 0); } } while (0)
#define PG8_STAGE_A(bufoff, so, tb, h) do { const char* _ga = (const char*)S.A + (so); asm volatile("" : "+s"(_ga)); _Pragma("unroll") for (int _i = 0; _i < 2; ++_i) { \
        const unsigned _ro = *(const LAS unsigned*)((const LAS unsigned char*)rtab + ((tb) * 1024 + (h) * 512) + (rcA[_i] & 0xffffu)) + (rcA[_i] >> 16); \
        __builtin_amdgcn_global_load_lds((const unsigned*)(_ga + _ro), (LAS unsigned*)(lds + (bufoff) + ldsw + _i * 8192), 16, 0, 0); } } while (0)
#define PG8_CAT8(lo, hi) __builtin_shufflevector(__builtin_bit_cast(i32x4, lo), __builtin_bit_cast(i32x4, hi), 0, 1, 2, 3, 4, 5, 6, 7)
#define PG8_LDA(dst, b, h) do { _Pragma("unroll") for (int m = 0; m < 4; ++m) { if constexpr (F8) dst##8[m] = PG8_CAT8(*(const LAS bf16x8*)(lds + PG8_SA(b, h) + aoff + m * 2048), *(const LAS bf16x8*)(lds + PG8_SA(b, h) + aoff + m * 2048 + 16)); \
        else { _Pragma("unroll") for (int k = 0; k < 2; ++k) dst[m][k] = *(const LAS bf16x8*)(lds + PG8_SA(b, h) + aoff + m * 2048 + k * 1024); } } } while (0)
#define PG8_LDB(dst, b, h) do { _Pragma("unroll") for (int n = 0; n < 2; ++n) { if constexpr (F8) dst##8[n] = PG8_CAT8(*(const LAS bf16x8*)(lds + PG8_SB(b, h) + boff + n * 2048), *(const LAS bf16x8*)(lds + PG8_SB(b, h) + boff + n * 2048 + 16)); \
        else { _Pragma("unroll") for (int k = 0; k < 2; ++k) dst[n][k] = *(const LAS bf16x8*)(lds + PG8_SB(b, h) + boff + n * 2048 + k * 1024); } } } while (0)
#define PG8_MMA(ai, bj, At, Bt) do { __builtin_amdgcn_s_setprio(1); _Pragma("unroll") for (int m = 0; m < 4; ++m) _Pragma("unroll") for (int n = 0; n < 2; ++n) { \
        if constexpr (F8) acc[ai][bj][m][n] = __builtin_amdgcn_mfma_scale_f32_16x16x128_f8f6f4(Bt##8[n], At##8[m], acc[ai][bj][m][n], 0, 0, 0, 0x7f7f7f7f, 0, 0x7f7f7f7f); \
        else { _Pragma("unroll") for (int k = 0; k < 2; ++k) acc[ai][bj][m][n] = __builtin_amdgcn_mfma_f32_16x16x32_bf16(Bt[n][k], At[m][k], acc[ai][bj][m][n], 0, 0, 0); } } __builtin_amdgcn_s_setprio(0); } while (0)
#define PG8_WAIT_V(n) asm volatile("s_waitcnt vmcnt(" #n ")" ::: "memory")
#define PG8_WAIT_L(n) asm volatile("s_waitcnt lgkmcnt(" #n ")" ::: "memory")
#define PG8_BAR __builtin_amdgcn_s_barrier()
#define PG8_SCHED __builtin_amdgcn_sched_barrier(0)
    Unit cur, nxt; int ui = 0;
    if (!S.next(0, cur)) return;
    f32x4 acc[2][2][4][2];
#pragma unroll
    for (int a = 0; a < 2; ++a)
#pragma unroll
        for (int b = 0; b < 2; ++b)
#pragma unroll
            for (int m = 0; m < 4; ++m)
#pragma unroll
                for (int n = 0; n < 2; ++n) acc[a][b][m][n] = (f32x4){0.f, 0.f, 0.f, 0.f};
    bf16x8 At[4][2], B0[2][2], B1[2][2]; i32x8 At8[4], B08[2], B18[2];
    S.fill(cur, rtab, tid);
    asm volatile("s_waitcnt lgkmcnt(0)" ::: "memory"); PG8_BAR; asm volatile("" ::: "memory");
    unsigned cA = cur.Ao, cB = cur.Bo;
    PG8_STAGE(PG8_SB(0, 0), cB, voffB); PG8_STAGE(PG8_SB(0, 1), cB + hstep, voffB); PG8_STAGE_A(PG8_SA(0, 0), cA, 0, 0); PG8_STAGE_A(PG8_SA(0, 1), cA, 0, 1);
    if (wr == 1) PG8_BAR;
    PG8_WAIT_V(2); PG8_BAR;
    PG8_STAGE(PG8_SB(1, 0), cB + kstep, voffB); PG8_STAGE_A(PG8_SA(1, 0), cA + kstep, 0, 0); PG8_STAGE(PG8_SB(1, 1), cB + hstep + kstep, voffB);
    PG8_WAIT_V(6); PG8_BAR;
    for (;;) {
        const bool has_next = S.next(ui + 1, nxt);
        const unsigned nA = has_next ? nxt.Ao : cA, nB = has_next ? nxt.Bo : cB;
        const int tbc = ui & 1, tbn = has_next ? (tbc ^ 1) : tbc;
        if (has_next) S.fill(nxt, rtab + tbn * 256, mk_tid(lds));
#pragma unroll 1
        for (int t = 0; t < nt; t += 2) {
            const bool last = (t == nt - 2);
            unsigned a1 = cA + (unsigned)(t + 1) * kstep;
            unsigned a2 = last ? nA : cA + (unsigned)(t + 2) * kstep, b2 = last ? nB : cB + (unsigned)(t + 2) * kstep;
            unsigned a3 = a2 + kstep, b3 = b2 + kstep;
            asm volatile("" : "+s"(a1), "+s"(a2), "+s"(a3), "+s"(b2), "+s"(b3));
            const int tb2 = last ? tbn : tbc;
            PG8_LDB(B0, 0, 0); PG8_LDB(B1, 0, 1); PG8_SCHED; PG8_LDA(At, 0, 0); PG8_STAGE_A(PG8_SA(1, 1), a1, tbc, 1);
            PG8_WAIT_V(8); PG8_WAIT_L(0); PG8_BAR; PG8_MMA(0, 0, At, B0); PG8_MMA(0, 1, At, B1); PG8_BAR; PG8_SCHED;
            PG8_LDA(At, 0, 1); PG8_STAGE(PG8_SB(0, 0), b2, voffB); PG8_STAGE(PG8_SB(0, 1), b2 + hstep, voffB); PG8_STAGE_A(PG8_SA(0, 0), a2, tb2, 0);
            PG8_WAIT_V(8); PG8_WAIT_L(0); PG8_BAR; PG8_MMA(1, 0, At, B0); PG8_MMA(1, 1, At, B1); PG8_BAR; PG8_SCHED;
            PG8_LDB(B0, 1, 0); PG8_LDB(B1, 1, 1); PG8_SCHED; PG8_LDA(At, 1, 0); PG8_STAGE_A(PG8_SA(0, 1), a2, tb2, 1);
            PG8_WAIT_V(8); PG8_WAIT_L(0); PG8_BAR; PG8_MMA(0, 0, At, B0); PG8_MMA(0, 1, At, B1); PG8_BAR; PG8_SCHED;
            PG8_LDA(At, 1, 1); PG8_STAGE(PG8_SB(1, 0), b3, voffB); PG8_STAGE(PG8_SB(1, 1), b3 + hstep, voffB); PG8_STAGE_A(PG8_SA(1, 0), a3, tb2, 0);
            PG8_WAIT_V(8); PG8_WAIT_L(0); PG8_BAR; PG8_MMA(1, 0, At, B0); PG8_MMA(1, 1, At, B1); PG8_BAR; PG8_SCHED;
        }
        if constexpr (ALIGN_EPI) { if (wr == 0) PG8_BAR; }
        { int te = mk_tid(lds); asm volatile("" : "+v"(te)); const int le = te & 63; E(acc, cur, wr, wc, le & 15, le >> 4); }
        if (!has_next) break;
        if (MK_EPI_DRAIN) PG8_WAIT_V(0);
#pragma unroll
        for (int a = 0; a < 2; ++a)
#pragma unroll
            for (int b = 0; b < 2; ++b)
#pragma unroll
                for (int m = 0; m < 4; ++m)
#pragma unroll
                    for (int n = 0; n < 2; ++n) acc[a][b][m][n] = (f32x4){0.f, 0.f, 0.f, 0.f};
        cur = nxt; cA = nA; cB = nB; ++ui;
        if constexpr (ALIGN_EPI) { if (wr == 1) PG8_BAR; }
    }
    PG8_WAIT_V(0);
    if constexpr (!ALIGN_EPI) { if (wr == 0) PG8_BAR; }
    PG8_BAR;
#undef PG8_SA
#undef PG8_SB
#undef PG8_STAGE
#undef PG8_STAGE_A
#undef PG8_LDA
#undef PG8_LDB
#undef PG8_MMA
#undef PG8_CAT8
#undef PG8_WAIT_V
#undef PG8_WAIT_L
#undef PG8_BAR
#undef PG8_SCHED
}
}


namespace dattn {
using s16x4 = __attribute__((ext_vector_type(4))) short;
using f32x16 = __attribute__((ext_vector_type(16))) float;
constexpr int KVB = 64, NT = SEQ / KVB;
constexpr int L_V = 0, L_K = 32768, L_Q = 65536, L_SC = EXTRA_OFF;
#define SBAR() __builtin_amdgcn_sched_barrier(0)
#ifndef MK_ATT_SBAR
#define MK_ATT_SBAR 1
#endif
#define ABAR() do { if (MK_ATT_SBAR) __builtin_amdgcn_sched_barrier(0); } while (0)
__device__ __forceinline__ int crow(int r, int hi) { return (r & 3) + 8 * (r >> 2) + 4 * hi; }
__device__ __forceinline__ int v_rd_base(int lane) { return ((lane & 3) << 3) | (((lane >> 2) & 3) << 6) | (((lane >> 4) & 1) << 5) | (((lane >> 5) & 1) << 8); }
constexpr int v_rd_off(int d0, int ks, int half) { return d0 * 512 + ks * 4096 + half * 2048; }
template <int OFF> __device__ __forceinline__ s16x4 tr_read(int vb) { s16x4 r; asm volatile("ds_read_b64_tr_b16 %0, %1 offset:%2" : "=&v"(r) : "v"(vb), "i"(OFF) : "memory"); return r; }
__device__ __forceinline__ unsigned hk_src(int L, int colbase) { const int row = L >> 7, ch = ((L & 127) >> 4) ^ ((row >> 1) & 7); return (unsigned)(row * 1024 + colbase + ch * 8) * 2u; }
__device__ __forceinline__ unsigned v_src(int L, int colbase) { const int st = L >> 9, rem = L & 511, kk = ((st >> 2) << 3) | (rem >> 6), k = (kk & ~0xC) | ((kk & 4) << 1) | ((kk & 8) >> 1), c = (st & 3) * 32 + ((rem & 63) >> 1); return (unsigned)(k * 1024 + colbase + c) * 2u; }

#ifndef MK_QREG
#define MK_QREG 1
#endif
__device__ __forceinline__ void qk(f32x16& p0, f32x16& p1, const LAS char* Kb, const LAS char* Qh, const int (&ab)[4], const bf16x8 (&qf)[4]) {
#pragma unroll
    for (int d = 0; d < 4; ++d) {
        const bf16x8 q = MK_QREG ? qf[d] : *(const LAS bf16x8*)(Qh + ab[d]);
        const bf16x8 b0 = *(const LAS bf16x8*)(Kb + ab[d]), b1 = *(const LAS bf16x8*)(Kb + ab[d] + 4096);
        if (d == 0) { const f32x16 z = {}; p0 = __builtin_amdgcn_mfma_f32_32x32x16_bf16(b0, q, z, 0, 0, 0); p1 = __builtin_amdgcn_mfma_f32_32x32x16_bf16(b1, q, z, 0, 0, 0); }
        else { p0 = __builtin_amdgcn_mfma_f32_32x32x16_bf16(b0, q, p0, 0, 0, 0); p1 = __builtin_amdgcn_mfma_f32_32x32x16_bf16(b1, q, p1, 0, 0, 0); } }
}
__device__ __forceinline__ void sm_pack(f32x16& p0, f32x16& p1, float& l, bf16x8& a0, bf16x8& a1, bf16x8& a2, bf16x8& a3) {
#pragma unroll
    for (int r = 0; r < 16; ++r) { p0[r] = __builtin_amdgcn_exp2f(p0[r]); p1[r] = __builtin_amdgcn_exp2f(p1[r]); }
    float s0 = 0.f, s1 = 0.f;
#pragma unroll
    for (int r = 0; r < 16; ++r) { s0 += p0[r]; s1 += p1[r]; }
    l += s0 + s1;
#define PK4(P, BASE, OUT) do { const unsigned a0_ = cvt_pk_bf16(P[BASE + 0], P[BASE + 1]), a1_ = cvt_pk_bf16(P[BASE + 2], P[BASE + 3]);   \
    const unsigned b0_ = cvt_pk_bf16(P[BASE + 4], P[BASE + 5]), b1_ = cvt_pk_bf16(P[BASE + 6], P[BASE + 7]);                              \
    auto r0_ = __builtin_amdgcn_permlane32_swap(a0_, b0_, false, false); auto r1_ = __builtin_amdgcn_permlane32_swap(a1_, b1_, false, false); \
    u32x4 w_ = {r0_[0], r1_[0], r0_[1], r1_[1]}; OUT = __builtin_bit_cast(bf16x8, w_); } while (0)
    PK4(p0, 0, a0); PK4(p0, 8, a1); PK4(p1, 0, a2); PK4(p1, 8, a3);
#undef PK4
}
template <int D0> __device__ __forceinline__ void pv1(f32x16& o, int vb, bf16x8 a0, bf16x8 a1, bf16x8 a2, bf16x8 a3) {
    const s16x4 l0 = tr_read<v_rd_off(D0, 0, 0)>(vb), h0 = tr_read<v_rd_off(D0, 0, 1)>(vb), l1 = tr_read<v_rd_off(D0, 1, 0)>(vb), h1 = tr_read<v_rd_off(D0, 1, 1)>(vb);
    const s16x4 l2 = tr_read<v_rd_off(D0, 2, 0)>(vb), h2 = tr_read<v_rd_off(D0, 2, 1)>(vb), l3 = tr_read<v_rd_off(D0, 3, 0)>(vb), h3 = tr_read<v_rd_off(D0, 3, 1)>(vb);
    asm volatile("s_waitcnt lgkmcnt(0)" ::: "memory"); SBAR();
#define PK(L, H) (bf16x8){L[0], L[1], L[2], L[3], H[0], H[1], H[2], H[3]}
    o = __builtin_amdgcn_mfma_f32_32x32x16_bf16(a0, PK(l0, h0), o, 0, 0, 0); o = __builtin_amdgcn_mfma_f32_32x32x16_bf16(a1, PK(l1, h1), o, 0, 0, 0);
    o = __builtin_amdgcn_mfma_f32_32x32x16_bf16(a2, PK(l2, h2), o, 0, 0, 0); o = __builtin_amdgcn_mfma_f32_32x32x16_bf16(a3, PK(l3, h3), o, 0, 0, 0);
#undef PK
}
typedef short v4i16_t __attribute__((ext_vector_type(4)));
__device__ __forceinline__ s16x4 vtr(const LAS char* p) { return __builtin_bit_cast(s16x4, __builtin_amdgcn_ds_read_tr16_b64_v4i16((LAS v4i16_t*)p)); }
__device__ __forceinline__ void sm_half(f32x16& p, float& l, bf16x8& aL, bf16x8& aH) {
#pragma unroll
    for (int r = 0; r < 16; ++r) p[r] = __builtin_amdgcn_exp2f(p[r]);
    float s0 = 0.f;
#pragma unroll
    for (int r = 0; r < 16; ++r) s0 += p[r];
    l += s0;
#define PK4(P, BASE, OUT) do { const unsigned a0_ = cvt_pk_bf16(P[BASE + 0], P[BASE + 1]), a1_ = cvt_pk_bf16(P[BASE + 2], P[BASE + 3]);   \
    const unsigned b0_ = cvt_pk_bf16(P[BASE + 4], P[BASE + 5]), b1_ = cvt_pk_bf16(P[BASE + 6], P[BASE + 7]);                              \
    auto r0_ = __builtin_amdgcn_permlane32_swap(a0_, b0_, false, false); auto r1_ = __builtin_amdgcn_permlane32_swap(a1_, b1_, false, false); \
    u32x4 w_ = {r0_[0], r1_[0], r0_[1], r1_[1]}; OUT = __builtin_bit_cast(bf16x8, w_); } while (0)
    PK4(p, 0, aL); PK4(p, 8, aH);
#undef PK4
}
#ifndef MK_ATT_PRIO
#define MK_ATT_PRIO 0
#endif
template <int KS0> __device__ __forceinline__ void pv_half(f32x16 (&o)[4], const LAS char* vp, bf16x8 aL, bf16x8 aH) {
    if (MK_ATT_PRIO) __builtin_amdgcn_s_setprio(1);
#define PK(L, H) (bf16x8){L[0], L[1], L[2], L[3], H[0], H[1], H[2], H[3]}
#pragma unroll
    for (int d = 0; d < 4; ++d) {
        const s16x4 l0 = vtr(vp + v_rd_off(d, KS0, 0)), h0 = vtr(vp + v_rd_off(d, KS0, 1)), l1 = vtr(vp + v_rd_off(d, KS0 + 1, 0)), h1 = vtr(vp + v_rd_off(d, KS0 + 1, 1));
        o[d] = __builtin_amdgcn_mfma_f32_32x32x16_bf16(aL, PK(l0, h0), o[d], 0, 0, 0); o[d] = __builtin_amdgcn_mfma_f32_32x32x16_bf16(aH, PK(l1, h1), o[d], 0, 0, 0); }
#undef PK
    if (MK_ATT_PRIO) __builtin_amdgcn_s_setprio(0);
}
#define DGLDS(gp, loff) __builtin_amdgcn_global_load_lds((const unsigned*)(gp), (LAS unsigned*)(lds + (loff)), 16, 0, 0)

template <int CH> __device__ __forceinline__ void attn_pass(LAS unsigned char* lds, const char* Kg, const char* Vg, f32x16 (&o)[4], float& l, int wid, int lane, int h, const int (&ab)[4]) {
    unsigned ksrc, vsrc[2];
    { const int L = wid * 1024 + lane * 16; ksrc = hk_src(L, h * 128 + CH * 64); }
#pragma unroll
    for (int i = 0; i < 2; ++i) { const int L = (wid * 2 + i) * 1024 + lane * 16; vsrc[i] = v_src(L, h * 128); }
    constexpr size_t TSTEP = (size_t)KVB * 1024 * 2;
#define STAGE_K(t) DGLDS(Kg + (size_t)(t) * TSTEP + ksrc, L_K + ((t) & 1) * 8192 + wid * 1024)
#define STAGE_V(t) do { _Pragma("unroll") for (int i_ = 0; i_ < 2; ++i_) DGLDS(Vg + (size_t)(t) * TSTEP + vsrc[i_], L_V + ((t) & 1) * 16384 + (wid * 2 + i_) * 1024); } while (0)
#define TOP_BAR() do { asm volatile("s_waitcnt vmcnt(0)" ::: "memory"); __syncthreads(); } while (0)
    const LAS char* Qh = (const LAS char*)(lds + L_Q + wid * 8192 + CH * 4096);
    const LAS char* K0 = (const LAS char*)(lds + L_K); const LAS char* K1 = K0 + 8192;
    const LAS char* vb0 = (const LAS char*)(lds + L_V) + v_rd_base(lane); const LAS char* vb1 = vb0 + 16384;
    f32x16 pA0, pA1, pB0, pB1; bf16x8 a0, a1, a2, a3;
    TOP_BAR();
    STAGE_K(0); STAGE_V(0);
    TOP_BAR();
    bf16x8 qf[4];
#pragma unroll
    for (int d = 0; d < 4; ++d) qf[d] = *(const LAS bf16x8*)(Qh + ab[d]);
    qk(pA0, pA1, K0, Qh, ab, qf);
    STAGE_K(1);
#define STEP(PC0, PC1, PN0, PN1, j, KNEXT, VBUF, DO_K, DO_V) do { \
        TOP_BAR(); \
        if (DO_K) STAGE_K((j) + 2); \
        if (DO_V) { STAGE_V((j) + 1); qk(PN0, PN1, KNEXT, Qh, ab, qf); } \
        sm_half(PC0, l, a0, a1); ABAR();            \
        pv_half<0>(o, VBUF, a0, a1); \
        sm_half(PC1, l, a2, a3); ABAR();            \
        pv_half<2>(o, VBUF, a2, a3); ABAR();        \
    } while (0)
    for (int j = 0; j < NT - 2; j += 2) {
        STEP(pA0, pA1, pB0, pB1, j, K1, vb0, true, true);
        STEP(pB0, pB1, pA0, pA1, j + 1, K0, vb1, true, true);
    }
    STEP(pA0, pA1, pB0, pB1, NT - 2, K1, vb0, false, true);
    STEP(pB0, pB1, pA0, pA1, NT - 1, K0, vb1, false, false);
#undef STEP
#undef STAGE_K
#undef STAGE_V
#undef TOP_BAR
}

__device__ __forceinline__ void attn_unit(LAS unsigned char* lds, int b, int h, int qb, const bf16_t* QN, const bf16_t* KN, const bf16_t* VB, bf16_t* MIX, const float* subg, float lam) {
    int tid = mk_tid(lds); asm volatile("" : "+v"(tid));
    const int lane = tid & 63, r32 = lane & 31, hi = lane >> 5; const int wid = __builtin_amdgcn_readfirstlane(tid >> 6);
    const size_t rowbase = (size_t)b * SEQ; const int q0 = qb * 256;
    const char* Kg = (const char*)(KN + rowbase * 1024); const char* Vg = (const char*)(VB + rowbase * 1024); const char* Qg = (const char*)(QN + (rowbase + q0 + wid * 32) * 1024);
    __syncthreads();
#pragma unroll
    for (int i = 0; i < 8; ++i) { const int L = (i & 3) * 1024 + lane * 16; DGLDS(Qg + hk_src(L, h * 128 + (i >> 2) * 64), L_Q + wid * 8192 + i * 1024); }
    int ab[4];
#pragma unroll
    for (int d = 0; d < 4; ++d) ab[d] = r32 * 128 + ((d * 32 + hi * 16) ^ (((r32 >> 1) & 7) << 4));
    LAS float* sc = (LAS float*)(lds + L_SC) + wid * 64;
    f32x16 o[4]; float l = 0.f;
#pragma unroll
    for (int d = 0; d < 4; ++d) o[d] = f32x16{};
    attn_pass<0>(lds, Kg, Vg, o, l, wid, lane, h, ab);
    { auto rr = __builtin_amdgcn_permlane32_swap(__float_as_uint(l), __float_as_uint(l), false, false); l = __uint_as_float(rr[0]) + __uint_as_float(rr[1]); }
    if (hi == 0) sc[r32] = 1.f / l;
    asm volatile("s_waitcnt lgkmcnt(0)" ::: "memory");
    LAS unsigned* park0 = (LAS unsigned*)(lds + L_Q + wid * 8192) + lane;
    LAS unsigned* park1 = (LAS unsigned*)(lds + 135680 + wid * 3072) + lane;
    unsigned keep[4];
#pragma unroll
    for (int r = 0; r < 16; r += 2) { const float i0 = sc[crow(r, hi)], i1 = sc[crow(r + 1, hi)];
#pragma unroll
        for (int d = 0; d < 4; ++d) { const unsigned w = cvt_pk_bf16(o[d][r] * i0, o[d][r + 1] * i1); const int j = d * 8 + (r >> 1); if (j < 16) park0[64 * j] = w; else if (j < 28) park1[64 * (j - 16)] = w; else keep[j - 28] = w; } }
#pragma unroll
    for (int d = 0; d < 4; ++d) o[d] = f32x16{};
    l = 0.f;
    attn_pass<1>(lds, Kg, Vg, o, l, wid, lane, h, ab);
    { auto rr = __builtin_amdgcn_permlane32_swap(__float_as_uint(l), __float_as_uint(l), false, false); l = __uint_as_float(rr[0]) + __uint_as_float(rr[1]); }
    if (hi == 0) sc[32 + r32] = lam / l;
    asm volatile("s_waitcnt lgkmcnt(0)" ::: "memory");
    float ss[16];
#pragma unroll
    for (int r = 0; r < 16; ++r) { const float i2 = sc[32 + crow(r, hi)]; float s = 0.f;
#pragma unroll
        for (int d = 0; d < 4; ++d) { const int j = d * 8 + (r >> 1); const unsigned w = j < 16 ? park0[64 * j] : (j < 28 ? park1[64 * (j - 16)] : keep[j - 28]); const float o1n = (r & 1) ? bf2f(w >> 16) : bf2f(w & 0xffffu); const float v = o1n - o[d][r] * i2; o[d][r] = v; s += v * v; }
        ss[r] = s; }
#pragma unroll
    for (int r = 0; r < 16; ++r) { float s = ss[r]; s += __shfl_xor(s, 1); s += __shfl_xor(s, 2); s += __shfl_xor(s, 4); s += __shfl_xor(s, 8); s += __shfl_xor(s, 16); ss[r] = rsqrtf(s * (1.f / 128.f) + EPS) * 0.8f; }
    asm volatile("s_waitcnt lgkmcnt(0)" ::: "memory");
    LAS bf16_t* stg = (LAS bf16_t*)(lds + L_Q + wid * 8192);
#pragma unroll
    for (int d = 0; d < 4; ++d) { const float g = subg[d * 32 + r32];
#pragma unroll
        for (int r = 0; r < 16; ++r) stg[crow(r, hi) * 128 + d * 32 + r32] = (bf16_t)f2bf(o[d][r] * ss[r] * g); }
    asm volatile("s_waitcnt lgkmcnt(0)" ::: "memory");
    bf16_t* Ow = MIX + (rowbase + q0 + wid * 32) * DM + 1024 + h * 128;
#pragma unroll
    for (int i = 0; i < 8; ++i) { const int row = i * 4 + (lane >> 4), ch = lane & 15; const u32x4 v = *(const LAS u32x4*)(stg + row * 128 + ch * 8); *(u32x4*)(Ow + (size_t)row * DM + ch * 8) = v; }
    asm volatile("s_waitcnt lgkmcnt(0)" ::: "memory");
}

__device__ __forceinline__ int v_st(int k, int c) { const int kk = (k & ~0xC) | ((k & 4) << 1) | ((k & 8) >> 1); return ((kk >> 3) * 4 + (c >> 5)) * 512 + ((kk & 7) * 32 + (c & 31)) * 2; }
__device__ __forceinline__ void gmlp_pair(LAS unsigned char* lds, int pair, const bf16_t* U, const bf16_t* VG, const bf16_t* WsB, const float* lng, const float* lnb, const float* gbs, bf16_t* MIX) {
    int tid = mk_tid(lds); asm volatile("" : "+v"(tid));
    const int lane = tid & 63, r32 = lane & 31, hi = lane >> 5; const int wid = __builtin_amdgcn_readfirstlane(tid >> 6);
    const int it = pair * 2 + (wid >> 2), ib = wid & 3;
    const int h = it & 7, c = (it >> 3) & 31, b = it >> 8, t0 = b * SEQ + c * 128;
    const int img = (wid >> 2) * 32768;
    __syncthreads();
    {
        const int t = tid & 255, sr = t >> 4, sc = (t & 15) * 8;
        f32x4 g0 = *(const f32x4*)(lng + h * 128 + sc), g1 = *(const f32x4*)(lng + h * 128 + sc + 4), b0 = *(const f32x4*)(lnb + h * 128 + sc), b1 = *(const f32x4*)(lnb + h * 128 + sc + 4);
        uint4 vq[8];
#pragma unroll
        for (int k = 0; k < 8; ++k) vq[k] = *(const uint4*)(VG + (size_t)(t0 + sr + 16 * k) * 1024 + h * 128 + sc);
#pragma unroll
        for (int k = 0; k < 8; ++k) { const int row = sr + 16 * k; float f[8]; unpack8(vq[k], f);
            float s = 0.f;
#pragma unroll
            for (int i = 0; i < 8; ++i) s += f[i];
            s += __shfl_xor(s, 1); s += __shfl_xor(s, 2); s += __shfl_xor(s, 4); s += __shfl_xor(s, 8);
            const float mu = s * (1.f / 128.f); float q = 0.f;
#pragma unroll
            for (int i = 0; i < 8; ++i) { f[i] -= mu; q += f[i] * f[i]; }
            q += __shfl_xor(q, 1); q += __shfl_xor(q, 2); q += __shfl_xor(q, 4); q += __shfl_xor(q, 8);
            const float rs = rsqrtf(q * (1.f / 128.f) + EPS);
            u32x4 w; w.x = cvt_pk_bf16(f[0] * rs * g0[0] + b0[0], f[1] * rs * g0[1] + b0[1]); w.y = cvt_pk_bf16(f[2] * rs * g0[2] + b0[2], f[3] * rs * g0[3] + b0[3]);
            w.z = cvt_pk_bf16(f[4] * rs * g1[0] + b1[0], f[5] * rs * g1[1] + b1[1]); w.w = cvt_pk_bf16(f[6] * rs * g1[2] + b1[2], f[7] * rs * g1[3] + b1[3]);
            *(LAS u32x4*)(lds + img + (row >> 6) * 16384 + v_st(row & 63, sc)) = w; }
    }
    uint4 uq[8];
#pragma unroll
    for (int i = 0; i < 8; ++i) { const int row = i * 4 + (lane >> 4), ch = lane & 15; uq[i] = *(const uint4*)(U + (size_t)(t0 + ib * 32 + row) * 1024 + h * 128 + ch * 8); }
    bf16x8 pa[2][4];
#pragma unroll
    for (int tl = 0; tl < 2; ++tl)
#pragma unroll
        for (int ks = 0; ks < 4; ++ks) pa[tl][ks] = *(const bf16x8*)(WsB + (size_t)h * 16384 + (size_t)(ib * 32 + r32) * 128 + tl * 64 + ks * 16 + hi * 8);
    asm volatile("s_waitcnt lgkmcnt(0)" ::: "memory"); __syncthreads();
    f32x16 o[4];
#pragma unroll
    for (int d = 0; d < 4; ++d) o[d] = f32x16{};
    const int vb = (int)(uintptr_t)(lds + img) + v_rd_base(lane);
#pragma unroll
    for (int tl = 0; tl < 2; ++tl) { const int vbt = vb + tl * 16384;
        pv1<0>(o[0], vbt, pa[tl][0], pa[tl][1], pa[tl][2], pa[tl][3]); pv1<1>(o[1], vbt, pa[tl][0], pa[tl][1], pa[tl][2], pa[tl][3]);
        pv1<2>(o[2], vbt, pa[tl][0], pa[tl][1], pa[tl][2], pa[tl][3]); pv1<3>(o[3], vbt, pa[tl][0], pa[tl][1], pa[tl][2], pa[tl][3]); }
    LAS bf16_t* stg = (LAS bf16_t*)(lds + 65536 + wid * 8192);
#pragma unroll
    for (int r = 0; r < 16; ++r) { const float bsv = gbs[h * 128 + ib * 32 + crow(r, hi)];
#pragma unroll
        for (int d = 0; d < 4; ++d) stg[crow(r, hi) * 128 + d * 32 + r32] = (bf16_t)f2bf(o[d][r] + bsv); }
    asm volatile("s_waitcnt lgkmcnt(0)" ::: "memory");
#pragma unroll
    for (int i = 0; i < 8; ++i) { const int row = i * 4 + (lane >> 4), ch = lane & 15; const size_t trow = (size_t)(t0 + ib * 32 + row);
        float sv[8], uv[8]; { const u32x4 q_ = *(const LAS u32x4*)(stg + row * 128 + ch * 8); uint4 q2_; q2_.x = q_[0]; q2_.y = q_[1]; q2_.z = q_[2]; q2_.w = q_[3]; unpack8(q2_, sv); } unpack8(uq[i], uv);
#pragma unroll
        for (int e = 0; e < 8; ++e) sv[e] *= uv[e];
        *(uint4*)(MIX + trow * DM + h * 128 + ch * 8) = pack8(sv); }
    asm volatile("s_waitcnt lgkmcnt(0)" ::: "memory");
}
#undef DGLDS
#undef SBAR
}

struct MkArgs { const float* in[23]; float* out; unsigned char* ws; int ph_lo, ph_hi; };
typedef const __attribute__((address_space(4))) MkArgs* kargp_t;
constexpr int RTAB_OFF = EXTRA_OFF;
constexpr int CNTL_OFF = EXTRA_OFF + 2048;
constexpr int MISC_OFF = EXTRA_OFF + 4096;

#define XB_TMO      128
#define XB_XCNT(j)  (256  + 64 * (j))
#define XB_XSUB(j)  (1280 + 64 * (j))
#define XB_XGEN(j)  (2304 + 64 * (j))
#define XB_TOP      3328
#define XB_TOPGEN   3392
#define XCD_BAR_WORDS 3456
#define XB_SPIN_CAP (1u << 18)
#ifndef MK_SETTLE2_MASK
#define MK_SETTLE2_MASK 0x6F
#endif
#define MK_REL_DELAY_DEFAULT 1
constexpr int CW_BAR = 4096;
__device__ __forceinline__ unsigned xb_ld(unsigned* p)              { return __hip_atomic_load(p, __ATOMIC_RELAXED, __HIP_MEMORY_SCOPE_AGENT); }
__device__ __forceinline__ unsigned xb_add(unsigned* p, unsigned v) { return __hip_atomic_fetch_add(p, v, __ATOMIC_RELAXED, __HIP_MEMORY_SCOPE_AGENT); }
__device__ __forceinline__ unsigned xb_xcc_id() { return (unsigned)__builtin_amdgcn_s_getreg((3 << 11) | 20) & 0xFu; }
#define XB_SPIN(cond, bar) do { unsigned _sp = 0; while (cond) { __builtin_amdgcn_s_sleep(1); \
    if ((++_sp & 255u) == 0u) { if (xb_ld(&(bar)[XB_TMO])) break; if (_sp > XB_SPIN_CAP) { atomicAdd(&(bar)[XB_TMO], 1u); break; } } } } while (0)
__device__ __forceinline__ void xcd_barrier_complete(unsigned* bar, unsigned x, unsigned& nloc, unsigned& nx) {
    const unsigned G = gridDim.x * gridDim.y * gridDim.z;
    unsigned sum, cnt, mine, sp = 0u;
    for (;;) {
        sum = 0u; cnt = 0u; mine = 0u;
#pragma unroll
        for (unsigned j = 0; j < 16; ++j) { const unsigned c = xb_ld(&bar[XB_XCNT(j)]); sum += c; cnt += (c > 0u) ? 1u : 0u; mine = (j == x) ? c : mine; }
        if (sum == G) break;
        __builtin_amdgcn_s_sleep(1);
        if ((++sp & 255u) == 0u) { if (xb_ld(&bar[XB_TMO])) break; if (sp > XB_SPIN_CAP) { atomicAdd(&bar[XB_TMO], 1u); break; } }
    }
    nloc = mine > 0u ? mine : 1u; nx = cnt > 0u ? cnt : 1u;
}
#ifndef MK_BAR_STRONG
#define MK_BAR_STRONG 0
#endif
__device__ __forceinline__ void xcd_barrier(unsigned* bar, volatile LAS unsigned* st, bool leader  , int settle = MK_REL_DELAY_DEFAULT) {
    if (MK_BAR_STRONG) __builtin_amdgcn_fence(__ATOMIC_RELEASE, "agent");
    asm volatile("s_waitcnt vmcnt(0)" ::: "memory");
    __syncthreads();
    if (leader) {
        __builtin_amdgcn_s_waitcnt(0);
#ifndef MK_EARLY_WB
#define MK_EARLY_WB 0
#endif
        if (MK_EARLY_WB) asm volatile("buffer_wbl2 sc1" ::: "memory");
        const unsigned x = xb_xcc_id();
        unsigned nloc = st[0], nx = st[1];
        if (nloc == 0u) { xcd_barrier_complete(bar, x, nloc, nx); st[0] = nloc; st[1] = nx; }
        const unsigned old = xb_add(&bar[XB_XSUB(x)], 1u);
        const unsigned gen = old / nloc;
        if (old + 1u == (gen + 1u) * nloc) {
#ifndef MK_SYS_REL
#define MK_SYS_REL 1
#endif
            if (MK_SYS_REL) __builtin_amdgcn_fence(__ATOMIC_RELEASE, ""); else __builtin_amdgcn_fence(__ATOMIC_RELEASE, "agent");
            asm volatile("s_waitcnt vmcnt(0)" ::: "memory");
#ifndef MK_REL_DELAY
#define MK_REL_DELAY 0
#endif
            if (settle > 0) {
#pragma unroll 1
                for (int i_ = 0; i_ < settle; ++i_) __builtin_amdgcn_s_sleep(127); }
            if (MK_REL_DELAY == -1) { asm volatile("buffer_wbl2 sc1\n\ts_waitcnt vmcnt(0)" ::: "memory"); }
            if (MK_REL_DELAY == -2) __builtin_amdgcn_s_sleep(32);
            const unsigned og = xb_add(&bar[XB_TOP], 1u);
            const unsigned tg = og / nx;
            if (og + 1u == (tg + 1u) * nx) xb_add(&bar[XB_TOPGEN], 1u);
            else XB_SPIN((int)(xb_ld(&bar[XB_TOPGEN]) - (tg + 1u)) < 0, bar);
            __builtin_amdgcn_fence(__ATOMIC_ACQUIRE, "agent");
            xb_add(&bar[XB_XGEN(x)], 1u);
            asm volatile("s_waitcnt vmcnt(0)" ::: "memory");
        } else {
            XB_SPIN((int)(xb_ld(&bar[XB_XGEN(x)]) - (gen + 1u)) < 0, bar);
            __builtin_amdgcn_fence(__ATOMIC_ACQUIRE, "agent");
            asm volatile("s_waitcnt vmcnt(0)" ::: "memory");
        }
    }
    __syncthreads();
    if (MK_BAR_STRONG) { __builtin_amdgcn_fence(__ATOMIC_ACQUIRE, "agent"); asm volatile("s_waitcnt vmcnt(0)" ::: "memory"); }
}

#ifndef MK_P0_B8
#define MK_P0_B8 0
#endif
#ifndef MK_P0_W64
#define MK_P0_W64 1
#endif
constexpr int P0_SCR = MK_P0_W64 ? 16640 : 16384;
struct P0Item { const float* W; bf16_t* WT; const float* gk; int K, N, mode, k0, n0; float f8s; };
template <bool WIDE> __device__ __forceinline__ void p0_load(const P0Item& d, int lane, f32x4 (&v)[16]) {
    if constexpr (WIDE) { const int c = lane & 15, rr = lane >> 4;
#pragma unroll
        for (int i = 0; i < 16; ++i) v[i] = __builtin_nontemporal_load((const f32x4*)(d.W + (size_t)(d.k0 + (MK_P0_B8 ? 16 * (i >> 2) + 4 * rr + (i & 3) : rr + 4 * i)) * d.N + d.n0 + 4 * c));
    } else {
    const int c = lane & 7, rr = lane >> 3;
#pragma unroll
#ifndef MK_P0_NT
#define MK_P0_NT 1
#endif
    for (int i = 0; i < 8; ++i) { const f32x4* q_ = (const f32x4*)(d.W + (size_t)(d.k0 + rr + 8 * i) * d.N + d.n0 + 4 * c); v[i] = MK_P0_NT ? __builtin_nontemporal_load(q_) : *q_; }
    }
}
template <bool WIDE> __device__ __forceinline__ void p0_process(const P0Item& d, int lane, const f32x4 (&v)[16], LAS float* scr) {
    if constexpr (WIDE && MK_P0_B8) {
        const int c = lane & 15, rr = lane >> 4; LAS unsigned* t8 = (LAS unsigned*)scr;
#pragma unroll
        for (int g = 0; g < 4; ++g) { f32x4 sc = d.gk ? *(const f32x4*)(d.gk + d.k0 + 16 * g + 4 * rr) : (f32x4){1.f, 1.f, 1.f, 1.f}; sc = sc * d.f8s;
#pragma unroll
            for (int j = 0; j < 4; ++j) t8[(4 * c + j) * 17 + 4 * g + rr] = pk4_fp8(v[4 * g + 0][j] * sc[0], v[4 * g + 1][j] * sc[1], v[4 * g + 2][j] * sc[2], v[4 * g + 3][j] * sc[3]); }
        LDS_WAIT(); asm volatile("" ::: "memory");
        const int c4 = lane >> 4, nl = lane & 15;
#pragma unroll
        for (int j = 0; j < 4; ++j) { const int n = nl + 16 * j; const LAS unsigned* s8 = t8 + n * 17 + 4 * c4; u32x4 o; o.x = s8[0]; o.y = s8[1]; o.z = s8[2]; o.w = s8[3];
            *(u32x4*)((unsigned char*)d.WT + (size_t)map_row(d.mode, d.n0 + n) * d.K + d.k0 + 16 * c4) = o; }
        LDS_WAIT(); asm volatile("" ::: "memory");
    } else if constexpr (WIDE) {
        { const int c = lane & 15, rr = lane >> 4;
#pragma unroll
          for (int i = 0; i < 16; ++i) { LAS float* q = scr + (rr + 4 * i) * 65 + 4 * c; q[0] = v[i][0]; q[1] = v[i][1]; q[2] = v[i][2]; q[3] = v[i][3]; } }
        LDS_WAIT(); asm volatile("" ::: "memory");
        const int c4 = lane & 3, nl = lane >> 2; f32x4 g[4];
#pragma unroll
        for (int q = 0; q < 4; ++q) { g[q] = d.gk ? *(const f32x4*)(d.gk + d.k0 + 16 * c4 + 4 * q) : (f32x4){1.f, 1.f, 1.f, 1.f}; g[q] = g[q] * d.f8s; }
#pragma unroll
        for (int j = 0; j < 4; ++j) { const int n = nl + 16 * j; const LAS float* s = scr + (16 * c4) * 65 + n; u32x4 o;
            o.x = pk4_fp8(s[0 * 65] * g[0][0], s[1 * 65] * g[0][1], s[2 * 65] * g[0][2], s[3 * 65] * g[0][3]); o.y = pk4_fp8(s[4 * 65] * g[1][0], s[5 * 65] * g[1][1], s[6 * 65] * g[1][2], s[7 * 65] * g[1][3]);
            o.z = pk4_fp8(s[8 * 65] * g[2][0], s[9 * 65] * g[2][1], s[10 * 65] * g[2][2], s[11 * 65] * g[2][3]); o.w = pk4_fp8(s[12 * 65] * g[3][0], s[13 * 65] * g[3][1], s[14 * 65] * g[3][2], s[15 * 65] * g[3][3]);
            *(u32x4*)((unsigned char*)d.WT + (size_t)map_row(d.mode, d.n0 + n) * d.K + d.k0 + 16 * c4) = o; }
        LDS_WAIT(); asm volatile("" ::: "memory");
    } else {
    const int c = lane & 7, rr = lane >> 3;
#pragma unroll
    for (int i = 0; i < 8; ++i) { LAS float* q = scr + (rr + 8 * i) * 33 + 4 * c; q[0] = v[i][0]; q[1] = v[i][1]; q[2] = v[i][2]; q[3] = v[i][3]; }
    LDS_WAIT(); asm volatile("" ::: "memory");
    if (d.f8s != 0.f) {
        const int c4 = lane & 3, nl = lane >> 2; f32x4 g[4];
#pragma unroll
        for (int q = 0; q < 4; ++q) { g[q] = d.gk ? *(const f32x4*)(d.gk + d.k0 + 16 * c4 + 4 * q) : (f32x4){1.f, 1.f, 1.f, 1.f}; g[q] = g[q] * d.f8s; }
#pragma unroll
        for (int j = 0; j < 2; ++j) { const int n = nl + 16 * j; const LAS float* s = scr + (16 * c4) * 33 + n; u32x4 o;
            o.x = pk4_fp8(s[0 * 33] * g[0][0], s[1 * 33] * g[0][1], s[2 * 33] * g[0][2], s[3 * 33] * g[0][3]); o.y = pk4_fp8(s[4 * 33] * g[1][0], s[5 * 33] * g[1][1], s[6 * 33] * g[1][2], s[7 * 33] * g[1][3]);
            o.z = pk4_fp8(s[8 * 33] * g[2][0], s[9 * 33] * g[2][1], s[10 * 33] * g[2][2], s[11 * 33] * g[2][3]); o.w = pk4_fp8(s[12 * 33] * g[3][0], s[13 * 33] * g[3][1], s[14 * 33] * g[3][2], s[15 * 33] * g[3][3]);
            *(u32x4*)((unsigned char*)d.WT + (size_t)map_row(d.mode, d.n0 + n) * d.K + d.k0 + 16 * c4) = o;
#if MK_ST2
            asm volatile("" ::: "memory"); __builtin_nontemporal_store(o, (u32x4*)((unsigned char*)d.WT + (size_t)map_row(d.mode, d.n0 + n) * d.K + d.k0 + 16 * c4));
#endif
            }
    } else {
        f32x4 g0 = {1.f, 1.f, 1.f, 1.f}, g1 = g0;
        if (d.gk) { g0 = *(const f32x4*)(d.gk + d.k0 + 8 * c); g1 = *(const f32x4*)(d.gk + d.k0 + 8 * c + 4); }
#pragma unroll
        for (int j = 0; j < 4; ++j) { const int n = rr + 8 * j; const LAS float* s = scr + (8 * c) * 33 + n;
            u32x4 o; o.x = pk2(s[0 * 33] * g0[0], s[1 * 33] * g0[1]); o.y = pk2(s[2 * 33] * g0[2], s[3 * 33] * g0[3]); o.z = pk2(s[4 * 33] * g1[0], s[5 * 33] * g1[1]); o.w = pk2(s[6 * 33] * g1[2], s[7 * 33] * g1[3]);
            *(u32x4*)(d.WT + (size_t)map_row(d.mode, d.n0 + n) * d.K + d.k0 + 8 * c) = o; }
    }
    LDS_WAIT(); asm volatile("" ::: "memory");
    }
}

constexpr int P0_I_IN = (DM / 64) * (INW / 32), P0_I_OUT = (DM / 64) * (DM / 32), P0_XW = (MK_F8 && MK_P0_W64) ? 64 : 32, P0_I_G = (DM / 64) * (DE / P0_XW), P0_I_D = (DE / 64) * (DM / P0_XW);
constexpr int P0_DENSE = P0_I_IN + P0_I_OUT, P0_EXPERT = NE * (2 * P0_I_G + P0_I_D), P0_NITEMS = P0_DENSE + P0_EXPERT;
struct P0Dec {
    const float *w_in, *attn_g, *w_out, *ffn_g, *wgate, *wup, *wdown; unsigned char* ws;
    __device__ __forceinline__ void operator()(int it, P0Item& d) const {
        int r = it; int item; bf16_t* Wgu = (bf16_t*)(ws + WS_WGU); bf16_t* Wd = (bf16_t*)(ws + WS_WD);
        d.f8s = 0.f;
        if (r < P0_I_IN) { d.W = w_in; d.WT = (bf16_t*)(ws + WS_WIN); d.gk = attn_g; d.K = DM; d.N = INW; d.mode = 1; item = r; if (MK_F8_P1) d.f8s = F8_SWI; }
        else if ((r -= P0_I_IN) < P0_I_OUT) { d.W = w_out; d.WT = (bf16_t*)(ws + WS_WOUT); d.gk = nullptr; d.K = DM; d.N = DM; d.mode = 0; item = r; }
        else { r -= P0_I_OUT; const int e = r / (2 * P0_I_G + P0_I_D); r -= e * (2 * P0_I_G + P0_I_D);
            const size_t egu = MK_F8 ? (size_t)e * 2048 * 2048 / 2 : (size_t)e * 2048 * 2048, ed = MK_F8 ? (size_t)e * 2048 * 1024 / 2 : (size_t)e * 2048 * 1024;
            if (r < P0_I_G) { d.W = wgate + (size_t)e * DM * DE; d.WT = Wgu + egu; d.gk = ffn_g; d.K = DM; d.N = DE; d.mode = 2; item = r; if (MK_F8) d.f8s = F8_SW; }
            else if ((r -= P0_I_G) < P0_I_G) { d.W = wup + (size_t)e * DM * DE; d.WT = Wgu + egu; d.gk = ffn_g; d.K = DM; d.N = DE; d.mode = 3; item = r; if (MK_F8) d.f8s = F8_SW; }
            else { r -= P0_I_G; d.W = wdown + (size_t)e * DE * DM; d.WT = Wd + ed; d.gk = nullptr; d.K = DE; d.N = DM; d.mode = 0; item = r; if (MK_F8) d.f8s = F8_SD; } }
        const int wn = (MK_P0_W64 && d.f8s != 0.f) ? 64 : 32, nblk = d.N / wn; d.k0 = 64 * (item / nblk); d.n0 = wn * (item % nblk);
    }
};
#ifndef MK_ST2
#define MK_ST2 0
#endif
#ifndef MK_P0_AHEAD
#define MK_P0_AHEAD 2
#endif
template <bool WIDE> __device__ __forceinline__ void p0_run(const P0Dec& decode, int it0, int stride, int itEnd, int lane, LAS float* scr) {
#if MK_P0_AHEAD == 4
    f32x4 v0[16], v1[16], v2[16], v3[16], v4[16];
    int it = it0;
#define P0_LD(OFF, VN) { if (it + (OFF) * stride < itEnd) { P0Item dl; decode(it + (OFF) * stride, dl); p0_load<WIDE>(dl, lane, VN); } }
    P0_LD(0, v0) P0_LD(1, v1) P0_LD(2, v2) P0_LD(3, v3)
#define P0_STEP(VN, VC) { P0_LD(4, VN) { P0Item dp; decode(it, dp); p0_process<WIDE>(dp, lane, VC, scr); } it += stride; if (it >= itEnd) break; }
    while (it < itEnd) {
        P0_STEP(v4, v0) P0_STEP(v0, v1) P0_STEP(v1, v2) P0_STEP(v2, v3) P0_STEP(v3, v4)
    }
#undef P0_STEP
#undef P0_LD
#else
    f32x4 v0[16], v1[16];
    int it = it0;
#define P0_LD(OFF, VN) { if (it + (OFF) * stride < itEnd) { P0Item dl; decode(it + (OFF) * stride, dl); p0_load<WIDE>(dl, lane, VN); } }
    P0_LD(0, v0)
#define P0_STEP(VN, VC) { P0_LD(1, VN) { P0Item dp; decode(it, dp); p0_process<WIDE>(dp, lane, VC, scr); } it += stride; if (it >= itEnd) break; }
    while (it < itEnd) {
        P0_STEP(v1, v0) P0_STEP(v0, v1)
    }
#undef P0_STEP
#undef P0_LD
#endif
}
#ifndef MK_XROW
#define MK_XROW 0
#endif
constexpr int XS_PER_E = 64 + 64 + 64, XS_TOTAL = NE * XS_PER_E;
struct XSItem { const float* W; unsigned char* WT; const float* gk; int K, N, mode, k0, n0; float f8s; };
struct XSDec {
    const float *ffn_g, *wgate, *wup, *wdown; unsigned char* ws;
    __device__ __forceinline__ void operator()(int si, XSItem& d) const {
        const int e = si / XS_PER_E; int r = si - e * XS_PER_E;
        unsigned char* Wgu = ws + WS_WGU + (size_t)e * 2048 * 2048; unsigned char* Wd = ws + WS_WD + (size_t)e * 2048 * 1024;
        if (r < 64) { d.W = wgate + (size_t)e * DM * DE; d.WT = Wgu; d.gk = ffn_g; d.K = DM; d.N = DE; d.mode = 2; d.f8s = F8_SW; d.n0 = (r >> 4) * 256; d.k0 = (r & 15) * 128; }
        else if (r < 128) { r -= 64; d.W = wup + (size_t)e * DM * DE; d.WT = Wgu; d.gk = ffn_g; d.K = DM; d.N = DE; d.mode = 3; d.f8s = F8_SW; d.n0 = (r >> 4) * 256; d.k0 = (r & 15) * 128; }
        else { r -= 128; d.W = wdown + (size_t)e * DE * DM; d.WT = Wd; d.gk = nullptr; d.K = DE; d.N = DM; d.mode = 0; d.f8s = F8_SD; d.n0 = (r >> 3) * 256; d.k0 = (r & 7) * 128; }
    }
};
__device__ __forceinline__ void xs_load(const XSItem& d, int j, int lane, f32x4 (&v)[16]) {
    const f32x4* src = (const f32x4*)(d.W + (size_t)(d.k0 + 16 * j) * d.N + d.n0) + lane;
#pragma unroll
    for (int i = 0; i < 16; ++i) v[i] = __builtin_nontemporal_load(src + (size_t)i * (d.N / 4));
}
__device__ __forceinline__ void xs_process(const XSItem& d, int j, int lane, const f32x4 (&v)[16], LAS float* scr) {
#pragma unroll
    for (int i = 0; i < 16; ++i) *(LAS f32x4*)(scr + i * 256 + 4 * lane) = v[i];
    LDS_WAIT(); asm volatile("" ::: "memory");
    const int k = d.k0 + 16 * j; float g[16];
#pragma unroll
    for (int i = 0; i < 16; ++i) g[i] = d.gk ? d.gk[k + i] * d.f8s : d.f8s;
#pragma unroll
    for (int q = 0; q < 4; ++q) { const int n = lane + 64 * q; const LAS float* s = scr + n; u32x4 o;
        o.x = pk4_fp8(s[0 * 256] * g[0], s[1 * 256] * g[1], s[2 * 256] * g[2], s[3 * 256] * g[3]); o.y = pk4_fp8(s[4 * 256] * g[4], s[5 * 256] * g[5], s[6 * 256] * g[6], s[7 * 256] * g[7]);
        o.z = pk4_fp8(s[8 * 256] * g[8], s[9 * 256] * g[9], s[10 * 256] * g[10], s[11 * 256] * g[11]); o.w = pk4_fp8(s[12 * 256] * g[12], s[13 * 256] * g[13], s[14 * 256] * g[14], s[15 * 256] * g[15]);
        *(u32x4*)(d.WT + (size_t)map_row(d.mode, d.n0 + n) * d.K + k) = o; }
    LDS_WAIT(); asm volatile("" ::: "memory");
}
__device__ __forceinline__ void xs_run(const XSDec& decode, int it0, int stride, int itEnd, int lane, LAS float* scr) {
    const int nsup = it0 < itEnd ? (itEnd - 1 - it0) / stride + 1 : 0, nf = nsup * 8;
    XSItem d, dn; f32x4 va[16], vb[16];
    if (nf > 0) { decode(it0, d); xs_load(d, 0, lane, va); }
#pragma unroll 1
    for (int f = 0; f < nf; f += 2) {
        xs_load(d, (f + 1) & 7, lane, vb);
        xs_process(d, f & 7, lane, va, scr);
        dn = d;
        if (f + 2 < nf) { if (((f + 2) & 7) == 0) decode(it0 + ((f + 2) >> 3) * stride, dn); xs_load(dn, (f + 2) & 7, lane, va); }
        xs_process(d, (f + 1) & 7, lane, vb, scr);
        d = dn;
    }
}
#ifndef MK_XCONV
#define MK_XCONV 1
#endif

#ifndef MK_POISON_CHECK
#define MK_POISON_CHECK 0
#endif
#ifndef MK_REP
#define MK_REP -1
#endif
#define REPS(k) ((MK_REP == (k)) ? 2 : 1)
#ifndef MK_PROBE
#define MK_PROBE -1
#endif
#ifndef MK_USE_CG
#define MK_USE_CG 0
#endif
#define PHASE_VARS() kargp_t ap = (kargp_t)__builtin_amdgcn_kernarg_segment_ptr(); asm volatile("" : "+s"(ap)); \
    int tid = mk_tid(lds); asm volatile("" : "+v"(tid)); const int lane = tid & 63, wave = __builtin_amdgcn_readfirstlane(tid >> 6); \
    const int G = gridDim.x, vcu = (blockIdx.x % 8) * (G / 8) + blockIdx.x / 8; unsigned char* ws = ap->ws; (void)lane; (void)wave; (void)vcu; (void)ws

__global__ void __launch_bounds__(NTHR, 2) mk_fwd(MkArgs args) {
    extern __shared__ __attribute__((aligned(16))) unsigned char lds_raw[];
    LAS unsigned char* const lds = (LAS unsigned char*)lds_raw;
    const int lo = args.ph_lo, hi = args.ph_hi;
    {
        const int t0_ = threadIdx.x; if (t0_ < 32) ((LAS unsigned*)(lds + MISC_OFF))[t0_] = 0u;
        if ((t0_ & 63) == 0) ((volatile LAS unsigned char*)(lds + WTAB_OFF))[mk_hwslot()] = (unsigned char)(t0_ >> 6);
        __syncthreads(); }
    if (hi - lo > 1 && mk_tid(lds) == 0) (void)xb_add((unsigned*)(args.ws + WS_CTL) + CW_BAR + XB_XCNT(xb_xcc_id()), 1u);
#define IN(k) (lo <= (k) && (k) < hi)
#define STAMP(i) do { if (MK_PROBE >= 0 && blockIdx.x == 0 && mk_tid(lds) == 0) __hip_atomic_store((unsigned long long*)(args.ws + WS_LAM + 1024) + (i), __builtin_amdgcn_s_memrealtime(), __ATOMIC_RELAXED, __HIP_MEMORY_SCOPE_AGENT); } while (0)
    STAMP(0);
#define SEAM_XCD(k) do { if (IN(k) && IN((k) + 1)) { kargp_t ap_ = (kargp_t)__builtin_amdgcn_kernarg_segment_ptr(); asm volatile("" : "+s"(ap_)); \
        for (int sr_ = 0; sr_ < REPS(9); ++sr_) xcd_barrier((unsigned*)(ap_->ws + WS_CTL) + CW_BAR, (volatile LAS unsigned*)(lds + MISC_OFF) + 8, mk_tid(lds) == 0, MK_REL_DELAY * (((MK_SETTLE2_MASK >> (k)) & 1) ? 2 : 1)); } } while (0)

    if (IN(0)) for (int rep_ = 0; rep_ < REPS(0); ++rep_) {
        PHASE_VARS();
        const int gw = vcu * NWAVES + wave, NGW = G * NWAVES, gtid = blockIdx.x * NTHR + tid, NGT = G * NTHR;
        const float* ffn_g = ap->in[15];
        LAS float* scr = (LAS float*)(lds + wave * P0_SCR);
        const P0Dec dec{ap->in[2], ap->in[1], ap->in[14], ffn_g, ap->in[20], ap->in[21], ap->in[22], ws};
        static_assert(!(MK_P0_W64 && MK_F8) || MK_XCONV, "wide fp8 items need the expert conversion outside the prologue");
        p0_run<false>(dec, gw, NGW, (MK_XCONV || (MK_XROW && MK_F8)) ? P0_DENSE : P0_NITEMS, lane, scr);
        if (MK_XROW && MK_F8 && !MK_XCONV) { const XSDec xdec{ffn_g, ap->in[20], ap->in[21], ap->in[22], ws}; xs_run(xdec, gw, NGW, XS_TOTAL, lane, scr); }
        float2* rope = (float2*)(ws + WS_ROPE); bf16_t* WsB = (bf16_t*)(ws + WS_WSB);
        for (int i = gtid; i < 4096 * 8; i += NGT) { const int pos = i >> 3, f = i & 7; const float inv = 1.0f / powf(500000.0f, (float)(2 * f) / 16.0f); const float ang = (float)pos * inv; rope[i] = make_float2(cosf(ang), sinf(ang)); }
        { const float* wgrp = ap->in[16]; const float* wrt = ap->in[18]; bf16_t* WrH = (bf16_t*)(ws + WS_WRH); bf16_t* WrL = WrH + 48 * 2048;
          for (int i = gtid; i < 48 * 2048; i += NGT) { const int c = i / 2048, k = i % 2048; float w = 0.f; if (c < 36) w = (c < 4 ? wgrp[k * 4 + c] : wrt[k * 32 + (c - 4)]) * ffn_g[k];
              const unsigned hb = f2bf(w); WrH[i] = (bf16_t)hb; WrL[i] = (bf16_t)f2bf(w - bf2f(hb)); } }
        { const float* gws = ap->in[5]; for (int i = gtid; i < 8 * 128 * 128; i += NGT) WsB[i] = (bf16_t)f2bf(gws[i]); }
        if (gtid == 0) { float a = 0.f, b = 0.f; for (int i = 0; i < 64; ++i) { a += ap->in[9][i] * ap->in[10][i]; b += ap->in[11][i] * ap->in[12][i]; } ((float*)(ws + WS_LAM))[0] = expf(a) - expf(b) + 0.2f; }
        const float* x = ap->in[0]; bf16_t* XN = (bf16_t*)(ws + WS_XN);
        for (int m = gw; m < T; m += NGW) {
            const f32x4* xr = (const f32x4*)(x + (size_t)m * DM) + lane; f32x4 v[8]; float s = 0.f;
#pragma unroll
            for (int j = 0; j < 8; ++j) { v[j] = xr[64 * j]; s += (v[j][0] * v[j][0] + v[j][1] * v[j][1]) + (v[j][2] * v[j][2] + v[j][3] * v[j][3]); }
            const float rs = rsqrtf(wave_sum(s) * (1.f / DM) + EPS);
            if (MK_F8_P1) { unsigned* o4 = (unsigned*)((unsigned char*)XN + (size_t)m * DM) + lane; const float r8 = rs * F8_SXN;
#pragma unroll
                for (int j = 0; j < 8; ++j) o4[64 * j] = pk4_fp8(v[j][0] * r8, v[j][1] * r8, v[j][2] * r8, v[j][3] * r8);
            } else {
            u32x2* o8 = (u32x2*)(XN + (size_t)m * DM) + lane;
#pragma unroll
            for (int j = 0; j < 8; ++j) { u32x2 w; w.x = pk2(v[j][0] * rs, v[j][1] * rs); w.y = pk2(v[j][2] * rs, v[j][3] * rs); o8[64 * j] = w; } }
        }
    }
#if MK_USE_CG
    if (IN(0) && IN(1)) cg::this_grid().sync();
#else
    SEAM_XCD(0);
#endif
    STAMP(1);
    if (IN(1)) {
        PHASE_VARS();
        pg8::StaticOrder S; S.init(ws + WS_XN, ws + WS_WIN, T, INW, DM, G, (int)blockIdx.x, MK_F8_P1 ? 1 : 2);
        pg8::EpiG1 E{(bf16_t*)(ws + WS_U), ap->in[7], ap->in[8], (const float2*)(ws + WS_ROPE)};
        for (int rep_ = 0; rep_ < REPS(1); ++rep_) pg8::gemm_phase<pg8::EpiG1, pg8::StaticOrder, true, MK_F8_P1 != 0>(lds, (LAS unsigned*)(lds + RTAB_OFF), DM, S, E);
    }
    SEAM_XCD(1);
    STAMP(2);
    if (IN(2)) {
        PHASE_VARS();
        bf16_t* U = (bf16_t*)(ws + WS_U); bf16_t* VG = U + (size_t)T * 1024; bf16_t* QN = VG + (size_t)T * 1024; bf16_t* KN = QN + (size_t)T * 1024; bf16_t* VB = KN + (size_t)T * 1024;
        bf16_t* MIX = (bf16_t*)(ws + WS_MIX);
        {
            const float* subg = ap->in[13]; const float lamv = ((const float*)(ws + WS_LAM))[0];
            const P0Dec dec{ap->in[2], ap->in[1], ap->in[14], ap->in[15], ap->in[20], ap->in[21], ap->in[22], ws};
            const int gw = vcu * NWAVES + wave, NGW = G * NWAVES, cls = vcu & 1; LAS float* scr = (LAS float*)(lds + wave * P0_SCR);
            constexpr int PER_WAVE = (P0_EXPERT + 2047) / 2048, HALFW = (PER_WAVE + 1) / 2;
#define XS_CHUNK(r) do { kargp_t aq = (kargp_t)__builtin_amdgcn_kernarg_segment_ptr(); asm volatile("" : "+s"(aq)); const XSDec xdec{aq->in[15], aq->in[20], aq->in[21], aq->in[22], aq->ws}; \
                const int t_ = mk_tid(lds), gw_ = ((blockIdx.x % 8) * (gridDim.x / 8) + blockIdx.x / 8) * NWAVES + (t_ >> 6), ngw_ = gridDim.x * NWAVES, xper = (XS_TOTAL + ngw_ - 1) / ngw_, xh = (xper + 1) / 2; \
                const int x0 = gw_ + ((r) == 0 ? 0 : xh) * ngw_, x1 = (r) == 0 ? (xh * ngw_ < XS_TOTAL ? xh * ngw_ : XS_TOTAL) : XS_TOTAL; \
                xs_run(xdec, x0, ngw_, x1, t_ & 63, (LAS float*)(lds + (t_ >> 6) * P0_SCR)); } while (0)
#define P0_CHUNK(r) do { kargp_t aq = (kargp_t)__builtin_amdgcn_kernarg_segment_ptr(); asm volatile("" : "+s"(aq)); const P0Dec dq{aq->in[2], aq->in[1], aq->in[14], aq->in[15], aq->in[20], aq->in[21], aq->in[22], aq->ws}; \
                const int t_ = mk_tid(lds), gw_ = ((blockIdx.x % 8) * (gridDim.x / 8) + blockIdx.x / 8) * NWAVES + (t_ >> 6), ngw_ = gridDim.x * NWAVES; \
                const int c0_ = P0_DENSE + gw_ + ((r) * HALFW) * ngw_, c1_ = P0_DENSE + gw_ + (((r) + 1) * HALFW < PER_WAVE ? ((r) + 1) * HALFW : PER_WAVE) * ngw_; \
                p0_run<(MK_P0_W64 && MK_F8)>(dq, c0_, ngw_, c1_ < P0_NITEMS ? c1_ : P0_NITEMS, t_ & 63, (LAS float*)(lds + (t_ >> 6) * P0_SCR)); } while (0)
#ifndef MK_XCLS
#define MK_XCLS 3
#endif
#define P0_ALL() do { kargp_t aq = (kargp_t)__builtin_amdgcn_kernarg_segment_ptr(); asm volatile("" : "+s"(aq)); const P0Dec dq{aq->in[2], aq->in[1], aq->in[14], aq->in[15], aq->in[20], aq->in[21], aq->in[22], aq->ws}; \
                const int t_ = mk_tid(lds), gw_ = ((blockIdx.x % 8) * (gridDim.x / 8) + blockIdx.x / 8) * NWAVES + (t_ >> 6), ngw_ = gridDim.x * NWAVES; \
                p0_run<(MK_P0_W64 && MK_F8)>(dq, P0_DENSE + gw_, ngw_, P0_NITEMS, t_ & 63, (LAS float*)(lds + (t_ >> 6) * P0_SCR)); } while (0)
            __syncthreads();
            int rnd = 0;
            if (MK_XCLS == 3) {
                const int cls3 = vcu % 3; bool conv_done = !MK_XCONV;
                for (int rep_ = 0; rep_ < REPS(21); ++rep_) for (int un = vcu; un < NB * 8 * 16; un += G, ++rnd) { const int bh = un >> 4, qb = un & 15;
                    if (!conv_done && cls3 == rnd) { __syncthreads(); for (int rc_ = 0; rc_ < REPS(22); ++rc_) P0_ALL(); __syncthreads(); conv_done = true; }
                    dattn::attn_unit(lds, bh >> 3, bh & 7, qb, QN, KN, VB, MIX, subg, lamv);
                }
                if (!conv_done) { __syncthreads(); for (int rc_ = 0; rc_ < REPS(22); ++rc_) P0_ALL(); __syncthreads(); }
            } else {
            for (int rep_ = 0; rep_ < REPS(21); ++rep_) for (int un = vcu; un < NB * 8 * 16; un += G, ++rnd) { const int bh = un >> 4, qb = un & 15;
                const int c0 = P0_DENSE + gw + (rnd * HALFW) * NGW, c1 = P0_DENSE + gw + ((rnd + 1) * HALFW < PER_WAVE ? (rnd + 1) * HALFW : PER_WAVE) * NGW;
                if (MK_XCONV && cls == 0 && rnd < 2 && rep_ == 0) { __syncthreads(); if (MK_XROW && MK_F8) XS_CHUNK(rnd); else { for (int rc_ = 0; rc_ < REPS(22); ++rc_) P0_CHUNK(rnd); } __syncthreads(); }
                dattn::attn_unit(lds, bh >> 3, bh & 7, qb, QN, KN, VB, MIX, subg, lamv);
                if (MK_XCONV && cls == 1 && rnd < 2 && rep_ == 0) { __syncthreads(); if (MK_XROW && MK_F8) XS_CHUNK(rnd); else { for (int rc_ = 0; rc_ < REPS(22); ++rc_) P0_CHUNK(rnd); } __syncthreads(); }
            }
            }
        }
        {
            kargp_t ag = (kargp_t)__builtin_amdgcn_kernarg_segment_ptr(); asm volatile("" : "+s"(ag));
            const bf16_t* WsB = (const bf16_t*)(ag->ws + WS_WSB); bf16_t* U2 = (bf16_t*)(ag->ws + WS_U); bf16_t* VG2 = U2 + (size_t)T * 1024; bf16_t* MIX2 = (bf16_t*)(ag->ws + WS_MIX);
            __syncthreads();
            for (int pr = blockIdx.x; pr < (NB * 32 * 8 / 2) * REPS(20); pr += gridDim.x) dattn::gmlp_pair(lds, pr & (NB * 32 * 8 / 2 - 1), U2, VG2, WsB, ag->in[3], ag->in[4], ag->in[6], MIX2);
        }
    }
    SEAM_XCD(2);
    STAMP(3);
    if (IN(3)) {
        PHASE_VARS();
        pg8::StaticOrder S; S.init(ws + WS_MIX, ws + WS_WOUT, T, DM, DM, G, (int)blockIdx.x);
        pg8::EpiG2 E{ap->in[0], ap->out, (bf16_t*)(ws + WS_XN), 0};
#ifndef MK_REPNS
#define MK_REPNS 0
#endif
        for (int rep_ = 0; rep_ < REPS(3); ++rep_) { if (MK_REPNS) { int sk = rep_ * MK_REPNS; asm volatile("" : "+s"(sk)); E.skip = sk; } pg8::gemm_phase<pg8::EpiG2, pg8::StaticOrder, true>(lds, (LAS unsigned*)(lds + RTAB_OFF), DM, S, E); }
    }
#ifndef MK_DELAY3
#define MK_DELAY3 0
#endif
    if (MK_DELAY3) {
#pragma unroll 1
        for (int i_ = 0; i_ < MK_DELAY3; ++i_) __builtin_amdgcn_s_sleep(127); }
    SEAM_XCD(3);
    STAMP(4);
    if (IN(4)) {
        PHASE_VARS();
        const float* out = ap->out; const bf16_t* WrH = (const bf16_t*)(ws + WS_WRH); const bf16_t* WrL = WrH + 48 * 2048; const float* bgrp = ap->in[17]; const float* brt = ap->in[19];
        unsigned* cnt = (unsigned*)(ws + WS_CTL); int2* list = (int2*)(ws + WS_LIST); int4* rec = (int4*)(ws + WS_REC);
        LAS float* part = (LAS float*)lds;
        const int mt = wave & 3, kh = wave >> 2, row = lane & 15, kq = lane >> 4;
        for (int rp_ = 0; rp_ < REPS(4); ++rp_) for (int un = blockIdx.x; un < T / 64; un += G) {
            const int t0 = un * 64 + mt * 16;
            const float* xr = out + (size_t)(t0 + row) * DM + kh * 1024 + kq * 8;
            const bf16_t* wh = WrH + (size_t)row * 2048 + kh * 1024 + kq * 8; const bf16_t* wl = WrL + (size_t)row * 2048 + kh * 1024 + kq * 8;
            f32x4 acc[3]; float ss = 0.f;
#pragma unroll
            for (int n = 0; n < 3; ++n) acc[n] = (f32x4){0.f, 0.f, 0.f, 0.f};
            bf16x8 bhA[2][3], blA[2][3], bhB[2][3], blB[2][3]; f32x4 xA[2][2], xB[2][2];
#define P4_LOAD(BH, BL, X, KS) do { _Pragma("unroll") for (int u = 0; u < 2; ++u) { _Pragma("unroll") for (int n = 0; n < 3; ++n) { BH[u][n] = *(const bf16x8*)(wh + (size_t)n * 16 * 2048 + ((KS) + u) * 32); BL[u][n] = *(const bf16x8*)(wl + (size_t)n * 16 * 2048 + ((KS) + u) * 32); } \
                    X[u][0] = *(const f32x4*)(xr + ((KS) + u) * 32); X[u][1] = *(const f32x4*)(xr + ((KS) + u) * 32 + 4); } } while (0)
#define P4_COMP(BH, BL, X) do { _Pragma("unroll") for (int u = 0; u < 2; ++u) { const f32x4 x0 = X[u][0], x1 = X[u][1]; \
                    ss += (x0[0] * x0[0] + x0[1] * x0[1]) + (x0[2] * x0[2] + x0[3] * x0[3]) + (x1[0] * x1[0] + x1[1] * x1[1]) + (x1[2] * x1[2] + x1[3] * x1[3]); \
                    u32x4 hp, lp; \
                    hp.x = cvt_pk_bf16(x0[0], x0[1]); hp.y = cvt_pk_bf16(x0[2], x0[3]); hp.z = cvt_pk_bf16(x1[0], x1[1]); hp.w = cvt_pk_bf16(x1[2], x1[3]); \
                    lp.x = cvt_pk_bf16(x0[0] - bf2f(hp.x & 0xffffu), x0[1] - bf2f(hp.x >> 16)); lp.y = cvt_pk_bf16(x0[2] - bf2f(hp.y & 0xffffu), x0[3] - bf2f(hp.y >> 16)); \
                    lp.z = cvt_pk_bf16(x1[0] - bf2f(hp.z & 0xffffu), x1[1] - bf2f(hp.z >> 16)); lp.w = cvt_pk_bf16(x1[2] - bf2f(hp.w & 0xffffu), x1[3] - bf2f(hp.w >> 16)); \
                    const bf16x8 ah = __builtin_bit_cast(bf16x8, hp), al = __builtin_bit_cast(bf16x8, lp); \
                    _Pragma("unroll") for (int n = 0; n < 3; ++n) { \
                        acc[n] = __builtin_amdgcn_mfma_f32_16x16x32_bf16(ah, BH[u][n], acc[n], 0, 0, 0); acc[n] = __builtin_amdgcn_mfma_f32_16x16x32_bf16(al, BH[u][n], acc[n], 0, 0, 0); acc[n] = __builtin_amdgcn_mfma_f32_16x16x32_bf16(ah, BL[u][n], acc[n], 0, 0, 0); } } } while (0)
            P4_LOAD(bhA, blA, xA, 0);
#pragma unroll 1
            for (int ks = 0; ks < 32; ks += 4) {
                P4_LOAD(bhB, blB, xB, ks + 2);
                __builtin_amdgcn_sched_barrier(0);
                P4_COMP(bhA, blA, xA);
                __builtin_amdgcn_sched_barrier(0);
                if (ks + 4 < 32) P4_LOAD(bhA, blA, xA, ks + 4);
                __builtin_amdgcn_sched_barrier(0);
                P4_COMP(bhB, blB, xB);
                __builtin_amdgcn_sched_barrier(0);
            }
#undef P4_LOAD
#undef P4_COMP
            ss += __shfl_xor(ss, 16); ss += __shfl_xor(ss, 32);
            __syncthreads();
            LAS float* pb = part + (kh * 4 + mt) * 16 * 52;
#pragma unroll
            for (int n = 0; n < 3; ++n)
#pragma unroll
                for (int r = 0; r < 4; ++r) pb[(kq * 4 + r) * 52 + n * 16 + row] = acc[n][r];
            if (kq == 0) pb[row * 52 + 48] = ss;
            __syncthreads();
            if (kh == 0 && lane < 16 && rp_ == REPS(4) - 1) {
                const LAS float* p0 = part + (mt * 16 + lane) * 52; const LAS float* p1 = p0 + 4 * 16 * 52; const int t = t0 + lane;
#define TOT(c) (p0[c] + p1[c])
                const float rs = rsqrtf(TOT(48) * (1.f / DM) + EPS);
                int gi = 0; float lgm = TOT(0) * rs + bgrp[0];
                for (int g = 1; g < 4; ++g) { const float l = TOT(g) * rs + bgrp[g]; if (l > lgm) { lgm = l; gi = g; } }
                float den = 0.f; for (int g = 0; g < 4; ++g) den += expf(TOT(g) * rs + bgrp[g] - lgm); const float gwt = 1.f / den;
                int e0 = 0, e1 = 0; float l0 = -3.0e38f, l1 = -3.0e38f;
                for (int j = 0; j < 8; ++j) { const float l = TOT(4 + gi * 8 + j) * rs + brt[gi * 8 + j]; if (l > l0) { l1 = l0; e1 = e0; l0 = l; e0 = j; } else if (l > l1) { l1 = l; e1 = j; } }
#undef TOT
                const float w0 = 1.f / (1.f + expf(l1 - l0)), w1 = 1.f - w0;
                const int E0 = gi * 8 + e0, E1 = gi * 8 + e1;
                const unsigned q0 = atomicAdd(&cnt[E0], 1u), q1 = atomicAdd(&cnt[E1], 1u);
                list[(size_t)E0 * T + q0] = make_int2(t, __float_as_int(rs)); list[(size_t)E1 * T + q1] = make_int2(t, __float_as_int(rs));
                rec[t] = make_int4((E0 << 16) | (int)q0, (E1 << 16) | (int)q1, __float_as_int(gwt * w0), __float_as_int(gwt * w1));
            }
        }
    }
    SEAM_XCD(4);
    STAMP(5);
    if (IN(5) || IN(6) || IN(7)) {
        PHASE_VARS();
        volatile LAS int* cntl = (volatile LAS int*)(lds + CNTL_OFF); unsigned* cnt = (unsigned*)(ws + WS_CTL);
        __syncthreads();
        if (tid < NE) cntl[tid] = (int)__hip_atomic_load(cnt + tid, __ATOMIC_RELAXED, __HIP_MEMORY_SCOPE_AGENT);
        __syncthreads();
        if (tid == 0) { int s = 0; for (int i = 0; i < NE; ++i) { cntl[32 + i] = s; s += (cntl[i] + 255) & ~255; } }
        __syncthreads();
        if (tid < 160) { const int slot0 = tid * 256; int e = -1, p0 = 0; for (int j = 0; j < NE; ++j) { const int ps = cntl[32 + j], pad = (cntl[j] + 255) & ~255; if (slot0 >= ps && slot0 < ps + pad) { e = j; p0 = slot0 - ps; } } cntl[64 + tid] = e; cntl[224 + tid] = p0; }
        __syncthreads();
    }
    if (IN(5)) {
        PHASE_VARS();
        constexpr int ESZ = MK_F8 ? 1 : 2;
        pg8::MoeOrder<true, DM, ESZ> S{(const volatile LAS int*)(lds + CNTL_OFF), G, vcu, (const char*)(ws + WS_XN), (const char*)(ws + WS_WGU), (const int2*)(ws + WS_LIST)};
        pg8::EpiGLU E{(bf16_t*)(ws + WS_H), (const int2*)(ws + WS_LIST)};
        for (int rep_ = 0; rep_ < REPS(5); ++rep_) pg8::gemm_phase<pg8::EpiGLU, pg8::MoeOrder<true, DM, ESZ>, true, MK_F8 != 0>(lds, (LAS unsigned*)(lds + RTAB_OFF), DM, S, E);
    }
    SEAM_XCD(5);
    STAMP(6);
    if (IN(6)) {
        PHASE_VARS();
        constexpr int ESZ = MK_F8 ? 1 : 2;
        pg8::MoeOrder<false, DE, ESZ> S{(const volatile LAS int*)(lds + CNTL_OFF), G, vcu, (const char*)(ws + WS_H), (const char*)(ws + WS_WD), nullptr};
        pg8::EpiY E{(bf16_t*)(ws + WS_Y), 0};
        for (int rep_ = 0; rep_ < REPS(6); ++rep_) { if (MK_REPNS) { int sk = (rep_ + 1 < REPS(6)) ? 1 : 0; asm volatile("" : "+s"(sk)); E.skip = sk; } pg8::gemm_phase<pg8::EpiY, pg8::MoeOrder<false, DE, ESZ>, true, MK_F8 != 0>(lds, (LAS unsigned*)(lds + RTAB_OFF), DE, S, E); }
    }
    SEAM_XCD(6);
    STAMP(7);
    if (IN(7)) {
        PHASE_VARS();
        const int gw = vcu * NWAVES + wave, NGW = G * NWAVES;
        volatile LAS int* cntl = (volatile LAS int*)(lds + CNTL_OFF); float* out = ap->out; const bf16_t* Y = (const bf16_t*)(ws + WS_Y); const int4* rec = (const int4*)(ws + WS_REC);
        for (int ps_ = 0; ps_ < (MK_REP == 7 ? 3 : 1); ++ps_) {
        const float sg_ = (ps_ == 1) ? -1.f : 1.f; if (ps_) asm volatile("s_waitcnt vmcnt(0)" ::: "memory");
        int4 rn = rec[gw < T ? gw : 0];
        for (int t = gw; t < T; t += NGW) {
            const int4 r = rn; if (t + NGW < T) rn = rec[t + NGW];
            const int s0 = cntl[32 + (r.x >> 16)] + (r.x & 0xffff), s1 = cntl[32 + (r.y >> 16)] + (r.y & 0xffff); const float w0 = __int_as_float(r.z), w1 = __int_as_float(r.w);
            f32x4* o = (f32x4*)(out + (size_t)t * DM) + lane; const u32x2* y0 = (const u32x2*)(Y + (size_t)s0 * 2048) + lane; const u32x2* y1 = (const u32x2*)(Y + (size_t)s1 * 2048) + lane;
            f32x4 v[8]; u32x2 a[8], b[8];
#if MK_Y8
            { const unsigned* z0 = (const unsigned*)((const unsigned char*)Y + (size_t)s0 * 2048) + lane; const unsigned* z1 = (const unsigned*)((const unsigned char*)Y + (size_t)s1 * 2048) + lane; unsigned a8[8], b8[8];
#pragma unroll
              for (int j = 0; j < 8; ++j) { v[j] = o[64 * j]; a8[j] = z0[64 * j]; b8[j] = z1[64 * j]; }
              __builtin_amdgcn_sched_barrier(0);
              const float u0 = w0 * (sg_ / pg8::F8_SY), u1 = w1 * (sg_ / pg8::F8_SY);
#pragma unroll
              for (int j = 0; j < 8; ++j) { const auto al = __builtin_amdgcn_cvt_pk_f32_fp8((int)a8[j], false), ah = __builtin_amdgcn_cvt_pk_f32_fp8((int)a8[j], true), bl = __builtin_amdgcn_cvt_pk_f32_fp8((int)b8[j], false), bh = __builtin_amdgcn_cvt_pk_f32_fp8((int)b8[j], true);
                  v[j][0] += u0 * al[0] + u1 * bl[0]; v[j][1] += u0 * al[1] + u1 * bl[1]; v[j][2] += u0 * ah[0] + u1 * bh[0]; v[j][3] += u0 * ah[1] + u1 * bh[1]; o[64 * j] = v[j]; }
              continue; }
#endif
#pragma unroll
            for (int j = 0; j < 8; ++j) { v[j] = o[64 * j]; a[j] = y0[64 * j]; b[j] = y1[64 * j]; }
            __builtin_amdgcn_sched_barrier(0);
#pragma unroll
            for (int j = 0; j < 8; ++j) {
                v[j][0] += w0 * bf2f(a[j].x & 0xffffu) + w1 * bf2f(b[j].x & 0xffffu); v[j][1] += w0 * bf2f(a[j].x >> 16) + w1 * bf2f(b[j].x >> 16);
                v[j][2] += w0 * bf2f(a[j].y & 0xffffu) + w1 * bf2f(b[j].y & 0xffffu); v[j][3] += w0 * bf2f(a[j].y >> 16) + w1 * bf2f(b[j].y >> 16); o[64 * j] = v[j]; }
        }
        }
    }
#if MK_PROBE >= 0
    { kargp_t ap_ = (kargp_t)__builtin_amdgcn_kernarg_segment_ptr(); asm volatile("" : "+s"(ap_)); xcd_barrier((unsigned*)(ap_->ws + WS_CTL) + CW_BAR, (volatile LAS unsigned*)(lds + MISC_OFF) + 8, mk_tid(lds) == 0); }
    STAMP(8);
    { kargp_t ap_ = (kargp_t)__builtin_amdgcn_kernarg_segment_ptr(); asm volatile("" : "+s"(ap_)); xcd_barrier((unsigned*)(ap_->ws + WS_CTL) + CW_BAR, (volatile LAS unsigned*)(lds + MISC_OFF) + 8, mk_tid(lds) == 0); }
    { PHASE_VARS();
      const unsigned long long* ts = (const unsigned long long*)(ws + WS_LAM + 1024);
      const unsigned long long t0 = __hip_atomic_load(ts + 0, __ATOMIC_RELAXED, __HIP_MEMORY_SCOPE_AGENT), ta = __hip_atomic_load(ts + MK_PROBE, __ATOMIC_RELAXED, __HIP_MEMORY_SCOPE_AGENT), tb = __hip_atomic_load(ts + MK_PROBE + 1, __ATOMIC_RELAXED, __HIP_MEMORY_SCOPE_AGENT), te = __hip_atomic_load(ts + 8, __ATOMIC_RELAXED, __HIP_MEMORY_SCOPE_AGENT);
      const float f = (float)(tb - ta) / (float)(te - t0), sc = 1.f - f;
      f32x4* o = (f32x4*)ap->out; for (size_t i = (size_t)blockIdx.x * NTHR + tid; i < (size_t)T * DM / 4; i += (size_t)G * NTHR) { f32x4 v = o[i]; v = v * sc; o[i] = v; } }
#endif
#undef IN
#undef SEAM_XCD
}

#ifndef MK_PLAN
#define MK_PLAN 0
#endif
extern "C" void kernel_launch(void* const* d_in, const int* in_sizes, int n_in, void* d_out, int out_size, void* d_ws, size_t ws_size, hipStream_t stream) {
    static int ok = 0, grid = 0;
    if (ok == 0) {
        if (n_in != 23 || in_sizes[0] != T * DM || out_size != T * DM || ws_size < WS_END) { fprintf(stderr, "kernel_launch: unexpected shapes (n_in %d, in0 %d, out %d, ws %zu)\n", n_in, n_in > 0 ? in_sizes[0] : -1, out_size, ws_size); ok = -1; return; }
        if (hipFuncSetAttribute((const void*)k_gmlp, hipFuncAttributeMaxDynamicSharedMemorySize, (128 * 129 + 128 * 128) * 4) != hipSuccess) { fprintf(stderr, "kernel_launch: hipFuncSetAttribute failed\n"); ok = -1; return; }
        if (hipFuncSetAttribute((const void*)mk_fwd, hipFuncAttributeMaxDynamicSharedMemorySize, LDS_BYTES) != hipSuccess) { fprintf(stderr, "kernel_launch: hipFuncSetAttribute(mk_fwd) failed\n"); ok = -1; return; }
        int dev = 0, cus = 0, per_cu = 0;
        (void)hipGetDevice(&dev); (void)hipDeviceGetAttribute(&cus, hipDeviceAttributeMultiprocessorCount, dev);
        if (hipOccupancyMaxActiveBlocksPerMultiprocessor(&per_cu, (const void*)mk_fwd, NTHR, LDS_BYTES) != hipSuccess || per_cu < 1) { fprintf(stderr, "kernel_launch: occupancy query says %d blocks per CU\n", per_cu); per_cu = 1; }
        (void)hipGetLastError();
        grid = cus;
        if (grid % 8 != 0 || grid <= 0) { fprintf(stderr, "kernel_launch: unexpected CU count %d\n", cus); ok = -1; return; }
        ok = 1;
    }
    if (ok < 0) return;
    const float* x = (const float*)d_in[0]; const float* attn_g = (const float*)d_in[1]; const float* w_in = (const float*)d_in[2];
    const float* lng = (const float*)d_in[3]; const float* lnb = (const float*)d_in[4]; const float* gws = (const float*)d_in[5]; const float* gbs = (const float*)d_in[6];
    const float* qg = (const float*)d_in[7]; const float* kg = (const float*)d_in[8];
    const float* lq1 = (const float*)d_in[9]; const float* lk1 = (const float*)d_in[10]; const float* lq2 = (const float*)d_in[11]; const float* lk2 = (const float*)d_in[12];
    const float* subg = (const float*)d_in[13]; const float* w_out = (const float*)d_in[14]; const float* ffn_g = (const float*)d_in[15];
    const float* wgrp = (const float*)d_in[16]; const float* bgrp = (const float*)d_in[17]; const float* wrt = (const float*)d_in[18]; const float* brt = (const float*)d_in[19];
    const float* wgate = (const float*)d_in[20]; const float* wup = (const float*)d_in[21]; const float* wdown = (const float*)d_in[22];
    char* ws = (char*)d_ws; float* out = (float*)d_out;
    unsigned* cnt = (unsigned*)(ws + WS_CTL); float2* rope = (float2*)(ws + WS_ROPE); float* WrT = (float*)(ws + WS_WRT); bf16_t* WsB = (bf16_t*)(ws + WS_WSB); float* lam = (float*)(ws + WS_LAM);
    int2* list = (int2*)(ws + WS_LIST); int4* rec = (int4*)(ws + WS_REC);
    bf16_t* Win = (bf16_t*)(ws + WS_WIN); bf16_t* Wout = (bf16_t*)(ws + WS_WOUT); bf16_t* Wgu = (bf16_t*)(ws + WS_WGU); bf16_t* Wd = (bf16_t*)(ws + WS_WD);
    bf16_t* XN = (bf16_t*)(ws + WS_XN); bf16_t* MIX = (bf16_t*)(ws + WS_MIX); bf16_t* Z = (bf16_t*)(ws + WS_Z);
    bf16_t* U = (bf16_t*)(ws + WS_U); bf16_t* VG = U + (size_t)T * 1024; bf16_t* QN = VG + (size_t)T * 1024; bf16_t* KN = QN + (size_t)T * 1024; bf16_t* VB = KN + (size_t)T * 1024;
    bf16_t* H = (bf16_t*)(ws + WS_H); bf16_t* Y = (bf16_t*)(ws + WS_Y); bf16_t* GU = Y;
    (void)Z; (void)GU; (void)H; (void)rec; (void)list; (void)WsB;

    (void)hipMemsetAsync(ws + WS_CTL, 0, 32768, stream);
    MkArgs a{}; for (int i = 0; i < 23; ++i) a.in[i] = (const float*)d_in[i]; a.out = out; a.ws = (unsigned char*)d_ws;
    auto MK = [&](int lo, int hi) { a.ph_lo = lo; a.ph_hi = hi; hipLaunchKernelGGL(mk_fwd, dim3(grid), dim3(NTHR), LDS_BYTES, stream, a); };
#if MK_PLAN == 0
    a.ph_lo = 0; a.ph_hi = 8; void* kargs[] = {&a};
    const hipError_t ce = hipLaunchCooperativeKernel((const void*)mk_fwd, dim3(grid), dim3(NTHR), kargs, LDS_BYTES, stream);
    if (ce != hipSuccess) fprintf(stderr, "kernel_launch: cooperative launch failed: %s (grid %d)\n", hipGetErrorString(ce), grid);
#else
    auto V1_PRO = [&]() {
        k_transpose<<<dim3(INW / 32, DM / 32, 1), 256, 0, stream>>>(w_in, DM, INW, Win, attn_g, 1, 0, 0);
        k_transpose<<<dim3(DM / 32, DM / 32, 1), 256, 0, stream>>>(w_out, DM, DM, Wout, nullptr, 0, 0, 0);
        k_transpose<<<dim3(DE / 32, DM / 32, NE), 256, 0, stream>>>(wgate, DM, DE, Wgu, ffn_g, 2, (size_t)DM * DE, (size_t)2048 * 2048);
        k_transpose<<<dim3(DE / 32, DM / 32, NE), 256, 0, stream>>>(wup, DM, DE, Wgu, ffn_g, 3, (size_t)DM * DE, (size_t)2048 * 2048);
        k_transpose<<<dim3(DM / 32, DE / 32, NE), 256, 0, stream>>>(wdown, DE, DM, Wd, nullptr, 0, (size_t)DE * DM, (size_t)2048 * 1024);
        k_tables<<<256, 256, 0, stream>>>(rope, WrT, WsB, lam, wgrp, wrt, ffn_g, gws, lq1, lk1, lq2, lk2);
        k_xnorm<<<T, 256, 0, stream>>>(x, XN); };
    auto V1_G1 = [&]() { P_G1 p{XN, Win, Z}; k_gemm128<P_G1><<<dim3(INW / 128, T / 128), 256, 16384, stream>>>(p); k_post<<<T, 256, 0, stream>>>(Z, U, VG, QN, KN, VB, qg, kg, rope); };
    auto V1_MIX = [&]() { k_gmlp<<<NB * 32 * 8, 256, (128 * 129 + 128 * 128) * 4, stream>>>(U, VG, lng, lnb, gws, gbs, MIX); k_attn_simple<<<NB * 8 * 256, 256, 0, stream>>>(QN, KN, VB, subg, lam, MIX); };
    auto V1_G2 = [&]() { P_G2 p{MIX, Wout, x, out, XN}; k_gemm128<P_G2><<<dim3(DM / 128, T / 128), 256, 16384, stream>>>(p); };
    auto V1_ROUTE = [&]() { k_route<<<T, 256, 0, stream>>>(out, WrT, bgrp, brt, cnt, list, rec); };
    auto V1_GU = [&]() { P_GU p{XN, Wgu, cnt, list, GU}; k_gemm128<P_GU><<<dim3(2048 / 128, SLOTS / 128), 256, 16384, stream>>>(p); k_glu<<<SLOTS, 256, 0, stream>>>(GU, cnt, list, H); };
    auto V1_DN = [&]() { P_DN p{H, Wd, cnt, Y}; k_gemm128<P_DN><<<dim3(2048 / 128, SLOTS / 128), 256, 16384, stream>>>(p); };
    auto V1_COMB = [&]() { k_combine<<<T, 256, 0, stream>>>(out, Y, cnt, rec); };
    (void)V1_PRO; (void)V1_G1; (void)V1_MIX; (void)V1_G2; (void)V1_ROUTE; (void)V1_GU; (void)V1_DN; (void)V1_COMB;
#if MK_PLAN == 1
    V1_PRO(); MK(1, 2); V1_MIX(); MK(3, 4); V1_ROUTE(); MK(5, 6); MK(6, 7); V1_COMB();
#elif MK_PLAN == 2
    for (int p = 0; p < 8; ++p) MK(p, p + 1);
#endif
#endif
    const hipError_t le = hipPeekAtLastError();
    if (le != hipSuccess) fprintf(stderr, "kernel_launch: launch failed: %s\n", hipGetErrorName(le));
}
```

```cpp
#include <hip/hip_runtime.h>
#include <cstdio>
#include <cstdint>

typedef unsigned short bf16_t;
typedef short bf16x8 __attribute__((ext_vector_type(8)));
typedef float f32x4 __attribute__((ext_vector_type(4)));

constexpr int NB = 4, SEQ = 4096, T = NB * SEQ, DM = 2048, INW = 5120;
constexpr int NE = 32, DE = 1024, SLOTS = 40960;
constexpr float EPS = 1e-6f;
constexpr float C2 = 0.125f * 1.4426950408889634f;

constexpr size_t MiB = 1u << 20;
constexpr size_t WS_CTL = 0;
constexpr size_t WS_ROPE = 1 * MiB;
constexpr size_t WS_WRT = WS_ROPE + 512 * 1024;
constexpr size_t WS_WSB = 2 * MiB;
constexpr size_t WS_WRH = 2 * MiB + 256 * 1024;
constexpr size_t WS_LAM = 3 * MiB;
constexpr size_t WS_LIST = 4 * MiB;
constexpr size_t WS_REC = 8 * MiB;
constexpr size_t WS_WIN = 12 * MiB;
constexpr size_t WS_WOUT = 32 * MiB;
constexpr size_t WS_WGU = 40 * MiB;
constexpr size_t WS_WD = 296 * MiB;
constexpr size_t WS_XN = 424 * MiB;
constexpr size_t WS_MIX = 488 * MiB;
constexpr size_t WS_Z = 552 * MiB;
constexpr size_t WS_U = 712 * MiB;
constexpr size_t WS_H = 552 * MiB;
constexpr size_t WS_Y = 632 * MiB;
constexpr size_t WS_END = 944 * MiB;

__device__ __forceinline__ unsigned f2bf(float f) { unsigned u = __builtin_bit_cast(unsigned, f); return (u + 0x7fffu + ((u >> 16) & 1u)) >> 16; }
__device__ __forceinline__ float bf2f(unsigned h) { return __builtin_bit_cast(float, h << 16); }
__device__ __forceinline__ unsigned pk2(float lo, float hi) { return f2bf(lo) | (f2bf(hi) << 16); }
__device__ __forceinline__ float wave_sum(float v) {
#pragma unroll
    for (int o = 1; o < 64; o <<= 1) v += __shfl_xor(v, o);
    return v;
}
__device__ __forceinline__ float gelu_tanh(float x) { const float u = 0.7978845608028654f * (x + 0.044715f * x * x * x); return 0.5f * x * (1.f + tanhf(u)); }
__device__ __forceinline__ void unpack8(uint4 r, float* f) {
    f[0] = bf2f(r.x & 0xffffu); f[1] = bf2f(r.x >> 16); f[2] = bf2f(r.y & 0xffffu); f[3] = bf2f(r.y >> 16);
    f[4] = bf2f(r.z & 0xffffu); f[5] = bf2f(r.z >> 16); f[6] = bf2f(r.w & 0xffffu); f[7] = bf2f(r.w >> 16);
}
__device__ __forceinline__ uint4 pack8(const float* f) { uint4 r; r.x = pk2(f[0], f[1]); r.y = pk2(f[2], f[3]); r.z = pk2(f[4], f[5]); r.w = pk2(f[6], f[7]); return r; }

__device__ __forceinline__ int map_row(int mode, int n) {
    if (mode == 1) { const int pn = n >> 8, r = n & 255, wc = r >> 6, bj = (r >> 5) & 1, j = r & 31; return (pn << 8) + (bj << 7) + (wc << 5) + j; }
    if (mode == 2) return ((n >> 7) << 8) + (n & 127);
    if (mode == 3) return ((n >> 7) << 8) + 128 + (n & 127);
    return n;
}
__device__ __forceinline__ int win_logical(int np) { const int pn = np >> 8, r = np & 255, bj = r >> 7, wc = (r >> 5) & 3, j = r & 31; return (pn << 8) + (wc << 6) + (bj << 5) + j; }

__global__ __launch_bounds__(256) void k_transpose(const float* __restrict__ W, int K, int N, bf16_t* __restrict__ WT, const float* __restrict__ gk, int mode, size_t wes, size_t wtes) {
    __shared__ float t[32][33];
    const int tx = threadIdx.x & 31, ty = threadIdx.x >> 5;
    const int k0 = blockIdx.y * 32, n0 = blockIdx.x * 32; const size_t e = blockIdx.z;
    const float* Wp = W + e * wes; bf16_t* WTp = WT + e * wtes;
#pragma unroll
    for (int i = 0; i < 4; ++i) { const int kk = ty + 8 * i; const float g = gk ? gk[k0 + kk] : 1.f; t[kk][tx] = Wp[(size_t)(k0 + kk) * N + n0 + tx] * g; }
    __syncthreads();
#pragma unroll
    for (int i = 0; i < 4; ++i) { const int nn = ty + 8 * i; const int np = map_row(mode, n0 + nn); WTp[(size_t)np * K + k0 + tx] = (bf16_t)f2bf(t[tx][nn]); }
}

__device__ __forceinline__ float block_sum256(float v, float* red) {
    v = wave_sum(v); const int wid = threadIdx.x >> 6;
    if ((threadIdx.x & 63) == 0) red[wid] = v;
    __syncthreads(); const float r = red[0] + red[1] + red[2] + red[3]; __syncthreads(); return r;
}

__global__ __launch_bounds__(256) void k_xnorm(const float* __restrict__ x, bf16_t* __restrict__ XN) {
    __shared__ float red[4];
    const int t = blockIdx.x, tid = threadIdx.x;
    const float4* xr = (const float4*)(x + (size_t)t * DM) + tid * 2; const float4 a = xr[0], b = xr[1];
    float ss = a.x * a.x + a.y * a.y + a.z * a.z + a.w * a.w + b.x * b.x + b.y * b.y + b.z * b.z + b.w * b.w;
    ss = block_sum256(ss, red);
    const float rs = rsqrtf(ss * (1.f / DM) + EPS);
    uint4 o; o.x = pk2(a.x * rs, a.y * rs); o.y = pk2(a.z * rs, a.w * rs); o.z = pk2(b.x * rs, b.y * rs); o.w = pk2(b.z * rs, b.w * rs);
    *(uint4*)(XN + (size_t)t * DM + tid * 8) = o;
}

__global__ __launch_bounds__(256) void k_tables(float2* rope, float* WrT, bf16_t* WsB, float* lam, const float* wgrp, const float* wrt, const float* fng, const float* ws,
                                                const float* lq1, const float* lk1, const float* lq2, const float* lk2) {
    const int gid = blockIdx.x * 256 + threadIdx.x, gsz = gridDim.x * 256;
    for (int i = gid; i < 4096 * 8; i += gsz) { const int pos = i >> 3, f = i & 7; const float inv = 1.0f / powf(500000.0f, (float)(2 * f) / 16.0f); const float ang = (float)pos * inv; rope[i] = make_float2(cosf(ang), sinf(ang)); }
    for (int i = gid; i < 36 * 2048; i += gsz) { const int c = i / 2048, k = i % 2048; const float w = c < 4 ? wgrp[k * 4 + c] : wrt[k * 32 + (c - 4)]; WrT[i] = w * fng[k]; }
    for (int i = gid; i < 8 * 128 * 128; i += gsz) WsB[i] = (bf16_t)f2bf(ws[i]);
    if (gid == 0) { float a = 0.f, b = 0.f; for (int i = 0; i < 64; ++i) { a += lq1[i] * lk1[i]; b += lq2[i] * lk2[i]; } lam[0] = expf(a) - expf(b) + 0.2f; }
}

struct TileBase { const bf16_t* Bt; int K; };
template <class P> __global__ __launch_bounds__(256, 2) void k_gemm128(P p) {
    extern __shared__ __attribute__((aligned(16))) bf16_t shm[];
    typename P::Tile ti; if (!p.tile(ti)) return;
    const int tid = threadIdx.x, wid = tid >> 6, lane = tid & 63, wr = wid >> 1, wc = wid & 1, fr = lane & 15, fq = lane >> 4;
    bf16_t* SA = shm; bf16_t* SB = shm + 4096;
    const int sr = tid >> 2, scol = (tid & 3) * 8; const int K = ti.K;
    const bf16_t* a0 = p.arow(ti, sr) + scol; const bf16_t* a1 = p.arow(ti, sr + 64) + scol;
    const bf16_t* b0 = ti.Bt + (size_t)sr * K + scol; const bf16_t* b1 = ti.Bt + (size_t)(sr + 64) * K + scol;
    f32x4 acc[4][4];
#pragma unroll
    for (int m = 0; m < 4; ++m)
#pragma unroll
        for (int n = 0; n < 4; ++n) acc[m][n] = (f32x4){0.f, 0.f, 0.f, 0.f};
    bf16x8 At[4], Bl[4];
    for (int t = 0; t < K / 32; ++t) {
        __builtin_amdgcn_global_load_lds((const unsigned*)(a0 + t * 32), (unsigned*)((char*)SA + tid * 16), 16, 0, 0);
        __builtin_amdgcn_global_load_lds((const unsigned*)(a1 + t * 32), (unsigned*)((char*)SA + tid * 16 + 4096), 16, 0, 0);
        __builtin_amdgcn_global_load_lds((const unsigned*)(b0 + t * 32), (unsigned*)((char*)SB + tid * 16), 16, 0, 0);
        __builtin_amdgcn_global_load_lds((const unsigned*)(b1 + t * 32), (unsigned*)((char*)SB + tid * 16 + 4096), 16, 0, 0);
        asm volatile("s_waitcnt vmcnt(0)" ::: "memory"); __syncthreads();
#pragma unroll
        for (int m = 0; m < 4; ++m) At[m] = *reinterpret_cast<const bf16x8*>((char*)SA + (wr * 64 + m * 16 + fr) * 64 + fq * 16);
#pragma unroll
        for (int n = 0; n < 4; ++n) Bl[n] = *reinterpret_cast<const bf16x8*>((char*)SB + (wc * 64 + n * 16 + fr) * 64 + fq * 16);
        asm volatile("s_waitcnt lgkmcnt(0)" ::: "memory"); __builtin_amdgcn_sched_barrier(0);
#pragma unroll
        for (int m = 0; m < 4; ++m)
#pragma unroll
            for (int n = 0; n < 4; ++n) acc[m][n] = __builtin_amdgcn_mfma_f32_16x16x32_bf16(At[m], Bl[n], acc[m][n], 0, 0, 0);
        __syncthreads();
    }
#pragma unroll
    for (int m = 0; m < 4; ++m)
#pragma unroll
        for (int n = 0; n < 4; ++n)
#pragma unroll
            for (int j = 0; j < 4; ++j) p.store(ti, wr * 64 + m * 16 + fq * 4 + j, wc * 64 + n * 16 + fr, acc[m][n][j]);
}

struct P_G1 {
    struct Tile : TileBase { int brow, bcol; };
    const bf16_t* A; const bf16_t* Bt; bf16_t* Z;
    __device__ bool tile(Tile& ti) const { ti.brow = blockIdx.y * 128; ti.bcol = blockIdx.x * 128; ti.Bt = Bt + (size_t)ti.bcol * DM; ti.K = DM; return true; }
    __device__ const bf16_t* arow(const Tile& ti, int r) const { return A + (size_t)(ti.brow + r) * DM; }
    __device__ void store(const Tile& ti, int r, int c, float v) const { Z[(size_t)(ti.brow + r) * INW + win_logical(ti.bcol + c)] = (bf16_t)f2bf(v); }
};
struct P_G2 {
    struct Tile : TileBase { int brow, bcol; };
    const bf16_t* A; const bf16_t* Bt; const float* x; float* out; bf16_t* X1B;
    __device__ bool tile(Tile& ti) const { ti.brow = blockIdx.y * 128; ti.bcol = blockIdx.x * 128; ti.Bt = Bt + (size_t)ti.bcol * DM; ti.K = DM; return true; }
    __device__ const bf16_t* arow(const Tile& ti, int r) const { return A + (size_t)(ti.brow + r) * DM; }
    __device__ void store(const Tile& ti, int r, int c, float v) const { const size_t o = (size_t)(ti.brow + r) * DM + ti.bcol + c; const float x1 = v + x[o]; out[o] = x1; X1B[o] = (bf16_t)f2bf(x1); }
};
__device__ __forceinline__ bool find_expert(const unsigned* cnt, int slot0, int& e, int& pos0, int& ce) {
    int ps = 0;
    for (int i = 0; i < NE; ++i) { const int c = (int)cnt[i]; const int pad = (c + 255) & ~255; if (slot0 < ps + pad) { e = i; pos0 = slot0 - ps; ce = c; return true; } ps += pad; }
    return false;
}
struct P_GU {
    struct Tile : TileBase { int slot0, bcol, e, pos0, ce; };
    const bf16_t* X1B; const bf16_t* Wgu; const unsigned* cnt; const int2* list; bf16_t* GU;
    __device__ bool tile(Tile& ti) const { ti.slot0 = blockIdx.y * 128; ti.bcol = blockIdx.x * 128; if (!find_expert(cnt, ti.slot0, ti.e, ti.pos0, ti.ce)) return false;
        ti.Bt = Wgu + (size_t)ti.e * 2048 * 2048 + (size_t)ti.bcol * DM; ti.K = DM; return true; }
    __device__ const bf16_t* arow(const Tile& ti, int r) const { const int pos = ti.pos0 + r; const int tok = pos < ti.ce ? list[(size_t)ti.e * T + pos].x : 0; return X1B + (size_t)tok * DM; }
    __device__ void store(const Tile& ti, int r, int c, float v) const { GU[(size_t)(ti.slot0 + r) * 2048 + ti.bcol + c] = (bf16_t)f2bf(v); }
};
struct P_DN {
    struct Tile : TileBase { int slot0, bcol, e, pos0, ce; };
    const bf16_t* H; const bf16_t* Wd; const unsigned* cnt; bf16_t* Y;
    __device__ bool tile(Tile& ti) const { ti.slot0 = blockIdx.y * 128; ti.bcol = blockIdx.x * 128; if (!find_expert(cnt, ti.slot0, ti.e, ti.pos0, ti.ce)) return false;
        ti.Bt = Wd + (size_t)ti.e * 2048 * 1024 + (size_t)ti.bcol * DE; ti.K = DE; return true; }
    __device__ const bf16_t* arow(const Tile& ti, int r) const { return H + (size_t)(ti.slot0 + r) * DE; }
    __device__ void store(const Tile& ti, int r, int c, float v) const { Y[(size_t)(ti.slot0 + r) * 2048 + ti.bcol + c] = (bf16_t)f2bf(v); }
};

__global__ __launch_bounds__(256) void k_post(const bf16_t* __restrict__ Z, bf16_t* U, bf16_t* VG, bf16_t* QN, bf16_t* KN, bf16_t* VB, const float* qg, const float* kg, const float2* rope) {
    const int t = blockIdx.x, tid = threadIdx.x, pos = t & (SEQ - 1);
    const bf16_t* z = Z + (size_t)t * INW; float f[8];
    { unpack8(*(const uint4*)(z + tid * 8), f);
#pragma unroll
      for (int i = 0; i < 8; ++i) f[i] = gelu_tanh(f[i]);
      const uint4 o = pack8(f); if (tid < 128) *(uint4*)(U + (size_t)t * 1024 + tid * 8) = o; else *(uint4*)(VG + (size_t)t * 1024 + (tid - 128) * 8) = o; }
    if (tid < 128) *(uint4*)(VB + (size_t)t * 1024 + tid * 8) = *(const uint4*)(z + 4096 + tid * 8);
    { const bool isk = tid >= 128; const int col = (tid * 8) & 1023, d0 = col & 63, sub = d0 >> 3;
      unpack8(*(const uint4*)(z + 2048 + tid * 8), f);
      float ss = 0.f;
#pragma unroll
      for (int i = 0; i < 8; ++i) ss += f[i] * f[i];
      ss += __shfl_xor(ss, 1); ss += __shfl_xor(ss, 2); ss += __shfl_xor(ss, 4);
      const float rs = rsqrtf(ss * (1.f / 64.f) + EPS); const float* g = isk ? kg : qg;
      float y[8], pr[8];
#pragma unroll
      for (int i = 0; i < 8; ++i) y[i] = f[i] * rs * g[d0 + i];
#pragma unroll
      for (int i = 0; i < 8; ++i) pr[i] = __shfl_xor(y[i], 1);
      if (sub < 2) {
#pragma unroll
          for (int i = 0; i < 8; ++i) { const float2 cs = rope[pos * 8 + i]; y[i] = sub == 0 ? y[i] * cs.x - pr[i] * cs.y : y[i] * cs.x + pr[i] * cs.y; } }
      if (!isk) {
#pragma unroll
          for (int i = 0; i < 8; ++i) y[i] *= C2; }
      *(uint4*)((isk ? KN : QN) + (size_t)t * 1024 + col) = pack8(y); }
}

__global__ __launch_bounds__(256) void k_gmlp(const bf16_t* __restrict__ U, const bf16_t* __restrict__ VG, const float* lng, const float* lnb, const float* Ws, const float* bs, bf16_t* MIX) {
    extern __shared__ __attribute__((aligned(16))) float sm[];
    float* vln = sm; float* wsl = sm + 128 * 129;
    const int blk = blockIdx.x, h = blk & 7, c = (blk >> 3) & 31, b = blk >> 8, t0 = b * SEQ + c * 128;
    const int tid = threadIdx.x, wid = tid >> 6, lane = tid & 63;
    for (int i = tid; i < 128 * 128; i += 256) wsl[i] = Ws[(size_t)h * 16384 + i];
    for (int jj = 0; jj < 32; ++jj) { const int j = wid * 32 + jj; const bf16_t* vr = VG + (size_t)(t0 + j) * 1024 + h * 128;
        const float a = bf2f(vr[lane]), b2 = bf2f(vr[lane + 64]); const float mu = wave_sum(a + b2) * (1.f / 128.f); const float da = a - mu, db = b2 - mu;
        const float rs = rsqrtf(wave_sum(da * da + db * db) * (1.f / 128.f) + EPS);
        vln[j * 129 + lane] = da * rs * lng[h * 128 + lane] + lnb[h * 128 + lane]; vln[j * 129 + lane + 64] = db * rs * lng[h * 128 + lane + 64] + lnb[h * 128 + lane + 64]; }
    __syncthreads();
    const int d = tid & 127, ih = tid >> 7; float acc[64];
#pragma unroll
    for (int i = 0; i < 64; ++i) acc[i] = 0.f;
    for (int j = 0; j < 128; ++j) { const float v = vln[j * 129 + d];
#pragma unroll
        for (int i = 0; i < 64; ++i) acc[i] += wsl[(ih * 64 + i) * 128 + j] * v; }
#pragma unroll
    for (int i = 0; i < 64; ++i) { const int row = t0 + ih * 64 + i; const float s = acc[i] + bs[h * 128 + ih * 64 + i];
        const float u = bf2f(U[(size_t)row * 1024 + h * 128 + d]); MIX[(size_t)row * DM + h * 128 + d] = (bf16_t)f2bf(u * s); }
}

__global__ __launch_bounds__(256) void k_attn_simple(const bf16_t* __restrict__ QN, const bf16_t* __restrict__ KN, const bf16_t* __restrict__ VB, const float* subg, const float* lamp, bf16_t* MIX) {
    const int tid = threadIdx.x, part = tid & 15, qr = tid >> 4;
    const int blk = blockIdx.x, qb = blk & 255, h = (blk >> 8) & 7, b = blk >> 11;
    const int t = b * SEQ + qb * 16 + qr;
    float q1[4], q2[4];
    { const uint2 a = *(const uint2*)(QN + (size_t)t * 1024 + h * 128 + part * 4), c = *(const uint2*)(QN + (size_t)t * 1024 + h * 128 + 64 + part * 4);
      q1[0] = bf2f(a.x & 0xffffu); q1[1] = bf2f(a.x >> 16); q1[2] = bf2f(a.y & 0xffffu); q1[3] = bf2f(a.y >> 16);
      q2[0] = bf2f(c.x & 0xffffu); q2[1] = bf2f(c.x >> 16); q2[2] = bf2f(c.y & 0xffffu); q2[3] = bf2f(c.y >> 16); }
    float o1[8], o2[8], l1 = 0.f, l2 = 0.f;
#pragma unroll
    for (int e = 0; e < 8; ++e) { o1[e] = 0.f; o2[e] = 0.f; }
    const bf16_t* Kb = KN + (size_t)(b * SEQ) * 1024 + h * 128; const bf16_t* Vb = VB + (size_t)(b * SEQ) * 1024 + h * 128;
#pragma unroll 4
    for (int j = 0; j < SEQ; ++j) {
        const uint2 ka = *(const uint2*)(Kb + (size_t)j * 1024 + part * 4), kc = *(const uint2*)(Kb + (size_t)j * 1024 + 64 + part * 4); const uint4 vr = *(const uint4*)(Vb + (size_t)j * 1024 + part * 8);
        float s1 = q1[0] * bf2f(ka.x & 0xffffu) + q1[1] * bf2f(ka.x >> 16) + q1[2] * bf2f(ka.y & 0xffffu) + q1[3] * bf2f(ka.y >> 16);
        float s2 = q2[0] * bf2f(kc.x & 0xffffu) + q2[1] * bf2f(kc.x >> 16) + q2[2] * bf2f(kc.y & 0xffffu) + q2[3] * bf2f(kc.y >> 16);
        s1 += __shfl_xor(s1, 1); s2 += __shfl_xor(s2, 1); s1 += __shfl_xor(s1, 2); s2 += __shfl_xor(s2, 2); s1 += __shfl_xor(s1, 4); s2 += __shfl_xor(s2, 4); s1 += __shfl_xor(s1, 8); s2 += __shfl_xor(s2, 8);
        const float p1 = exp2f(s1), p2 = exp2f(s2); l1 += p1; l2 += p2; float v[8]; unpack8(vr, v);
#pragma unroll
        for (int e = 0; e < 8; ++e) { o1[e] += p1 * v[e]; o2[e] += p2 * v[e]; }
    }
    const float lam = lamp[0], i1 = 1.f / l1, i2 = lam / l2; float o[8], ss = 0.f;
#pragma unroll
    for (int e = 0; e < 8; ++e) { o[e] = o1[e] * i1 - o2[e] * i2; ss += o[e] * o[e]; }
    ss += __shfl_xor(ss, 1); ss += __shfl_xor(ss, 2); ss += __shfl_xor(ss, 4); ss += __shfl_xor(ss, 8);
    const float rs = rsqrtf(ss * (1.f / 128.f) + EPS);
#pragma unroll
    for (int e = 0; e < 8; ++e) o[e] = o[e] * rs * subg[part * 8 + e] * 0.8f;
    *(uint4*)(MIX + (size_t)t * DM + 1024 + h * 128 + part * 8) = pack8(o);
}

__global__ __launch_bounds__(256) void k_route(const float* __restrict__ x1, const float* __restrict__ WrT, const float* bg, const float* br, unsigned* cnt, int2* list, int4* rec) {
    __shared__ float red[4][40];
    const int t = blockIdx.x, tid = threadIdx.x, lane = tid & 63, wid = tid >> 6;
    float xv[8]; { const float4* xr = (const float4*)(x1 + (size_t)t * DM) + tid * 2; const float4 a = xr[0], b = xr[1]; xv[0] = a.x; xv[1] = a.y; xv[2] = a.z; xv[3] = a.w; xv[4] = b.x; xv[5] = b.y; xv[6] = b.z; xv[7] = b.w; }
    float ss = 0.f;
#pragma unroll
    for (int i = 0; i < 8; ++i) ss += xv[i] * xv[i];
    ss = wave_sum(ss); if (lane == 0) red[wid][36] = ss;
    for (int c = 0; c < 36; ++c) { const float4* wr = (const float4*)(WrT + (size_t)c * DM) + tid * 2; const float4 a = wr[0], b = wr[1];
        float p = xv[0] * a.x + xv[1] * a.y + xv[2] * a.z + xv[3] * a.w + xv[4] * b.x + xv[5] * b.y + xv[6] * b.z + xv[7] * b.w; p = wave_sum(p); if (lane == 0) red[wid][c] = p; }
    __syncthreads();
    if (tid < 37) red[0][tid] = red[0][tid] + red[1][tid] + red[2][tid] + red[3][tid];
    __syncthreads();
    if (tid == 0) {
        const float* tot = red[0];
        const float rs = rsqrtf(tot[36] * (1.f / DM) + EPS);
        int gi = 0; float lgm = tot[0] * rs + bg[0];
        for (int g = 1; g < 4; ++g) { const float l = tot[g] * rs + bg[g]; if (l > lgm) { lgm = l; gi = g; } }
        float den = 0.f; for (int g = 0; g < 4; ++g) den += expf(tot[g] * rs + bg[g] - lgm); const float gw = 1.f / den;
        float* le = red[1]; for (int j = 0; j < 8; ++j) le[j] = tot[4 + gi * 8 + j] * rs + br[gi * 8 + j];
        int e0 = 0; for (int j = 1; j < 8; ++j) if (le[j] > le[e0]) e0 = j;
        int e1 = e0 == 0 ? 1 : 0; for (int j = 0; j < 8; ++j) if (j != e0 && le[j] > le[e1]) e1 = j;
        const float w0 = 1.f / (1.f + expf(le[e1] - le[e0])), w1 = 1.f - w0;
        const int E0 = gi * 8 + e0, E1 = gi * 8 + e1;
        const unsigned p0 = atomicAdd(&cnt[E0], 1u), p1 = atomicAdd(&cnt[E1], 1u);
        list[(size_t)E0 * T + p0] = make_int2(t, __float_as_int(rs)); list[(size_t)E1 * T + p1] = make_int2(t, __float_as_int(rs));
        rec[t] = make_int4((E0 << 16) | (int)p0, (E1 << 16) | (int)p1, __float_as_int(gw * w0), __float_as_int(gw * w1));
    }
}

__global__ __launch_bounds__(256) void k_glu(const bf16_t* __restrict__ GU, const unsigned* cnt, const int2* list, bf16_t* H) {
    const int slot = blockIdx.x, tid = threadIdx.x; int e, pos, ce; if (!find_expert(cnt, slot, e, pos, ce)) return;
    const float rs = pos < ce ? __int_as_float(list[(size_t)e * T + pos].y) : 0.f;
    const int c = tid * 4, base = ((c >> 7) << 8) + (c & 127);
    const uint2 g = *(const uint2*)(GU + (size_t)slot * 2048 + base), u = *(const uint2*)(GU + (size_t)slot * 2048 + base + 128);
    float gv[4] = {bf2f(g.x & 0xffffu), bf2f(g.x >> 16), bf2f(g.y & 0xffffu), bf2f(g.y >> 16)}, uv[4] = {bf2f(u.x & 0xffffu), bf2f(u.x >> 16), bf2f(u.y & 0xffffu), bf2f(u.y >> 16)}, hv[4];
#pragma unroll
    for (int i = 0; i < 4; ++i) { const float a = gv[i] * rs; hv[i] = a / (1.f + expf(-a)) * (uv[i] * rs); }
    uint2 o; o.x = pk2(hv[0], hv[1]); o.y = pk2(hv[2], hv[3]); *(uint2*)(H + (size_t)slot * DE + c) = o;
}

__global__ __launch_bounds__(256) void k_combine(float* out, const bf16_t* __restrict__ Y, const unsigned* cnt, const int4* rec) {
    __shared__ int ps[NE];
    const int t = blockIdx.x, tid = threadIdx.x;
    if (tid == 0) { int s = 0; for (int i = 0; i < NE; ++i) { ps[i] = s; s += ((int)cnt[i] + 255) & ~255; } }
    __syncthreads();
    const int4 r = rec[t]; const int s0 = ps[r.x >> 16] + (r.x & 0xffff), s1 = ps[r.y >> 16] + (r.y & 0xffff); const float w0 = __int_as_float(r.z), w1 = __int_as_float(r.w);
    float a[8], b[8]; unpack8(*(const uint4*)(Y + (size_t)s0 * 2048 + tid * 8), a); unpack8(*(const uint4*)(Y + (size_t)s1 * 2048 + tid * 8), b);
    float4* o = (float4*)(out + (size_t)t * DM) + tid * 2; float4 x0 = o[0], x1 = o[1];
    x0.x += w0 * a[0] + w1 * b[0]; x0.y += w0 * a[1] + w1 * b[1]; x0.z += w0 * a[2] + w1 * b[2]; x0.w += w0 * a[3] + w1 * b[3];
    x1.x += w0 * a[4] + w1 * b[4]; x1.y += w0 * a[5] + w1 * b[5]; x1.z += w0 * a[6] + w1 * b[6]; x1.w += w0 * a[7] + w1 * b[7];
    o[0] = x0; o[1] = x1;
}


#include <hip/hip_cooperative_groups.h>
namespace cg = cooperative_groups;
#define LAS __attribute__((address_space(3)))
#define GAS __attribute__((address_space(1)))
typedef unsigned u32x4 __attribute__((ext_vector_type(4)));
typedef unsigned u32x2 __attribute__((ext_vector_type(2)));
typedef float f32x2 __attribute__((ext_vector_type(2)));
#define LDS_WAIT() asm volatile("s_waitcnt lgkmcnt(0)" ::: "memory")
#define VM_WAIT() asm volatile("s_waitcnt vmcnt(0)" ::: "memory")

#ifndef MK_F8
#define MK_F8 1
#endif
#ifndef MK_TBO
#define MK_TBO 1
#endif
#ifndef MK_ST16
#define MK_ST16 0
#endif
#ifndef MK_LIST_LINE
#define MK_LIST_LINE 0
#endif
constexpr size_t MK_WS_LIST = MK_LIST_LINE ? 880 * MiB : (MK_ST16 ? 600 * MiB : WS_LIST);
#ifndef MK_LIST_SYS
#define MK_LIST_SYS 0
#endif
constexpr int LIST_ESZ = MK_LIST_LINE ? 128 : (MK_ST16 ? 16 : 8);
#ifndef MK_F8_P1
#define MK_F8_P1 0
#endif
constexpr float F8_SXN = 16.f, F8_SWI = 256.f;
constexpr float F8_SX = 16.f, F8_SW = 256.f, F8_SH = 8.f, F8_SD = 128.f;
typedef int i32x4 __attribute__((ext_vector_type(4)));
typedef int i32x8 __attribute__((ext_vector_type(8)));
constexpr int NWAVES = 8, NTHR = 512;
constexpr int RING_BYTES = 131072, EXTRA_OFF = RING_BYTES, LDS_BYTES = 163840;
typedef __bf16 bf16x2_t __attribute__((ext_vector_type(2)));
__device__ __forceinline__ unsigned cvt_pk_bf16(float lo, float hi) { const f32x2 v = {lo, hi}; const bf16x2_t b = __builtin_convertvector(v, bf16x2_t); return __builtin_bit_cast(unsigned, b); }
__device__ __forceinline__ float fast_gelu(float x) { const float e = __builtin_amdgcn_exp2f(-2.302208198f * (x + 0.044715f * x * x * x)); return x * __builtin_amdgcn_rcpf(1.f + e); }
__device__ __forceinline__ float clamp448(float x) { return __builtin_fminf(__builtin_fmaxf(x, -448.f), 448.f); }
__device__ __forceinline__ unsigned pk4_fp8(float a, float b, float c, float d) { int w = 0; w = __builtin_amdgcn_cvt_pk_fp8_f32(clamp448(a), clamp448(b), w, false); w = __builtin_amdgcn_cvt_pk_fp8_f32(clamp448(c), clamp448(d), w, true); return (unsigned)w; }
__device__ __forceinline__ float fast_silu(float a) { return a * __builtin_amdgcn_rcpf(1.f + __builtin_amdgcn_exp2f(-1.4426950408889634f * a)); }

constexpr int WTAB_OFF = EXTRA_OFF + 4096 + 256;
__device__ __forceinline__ unsigned mk_hwslot() { return (unsigned)__builtin_amdgcn_s_getreg((5 << 11) | 4) & 63u; }
#ifndef MK_HWTID
#define MK_HWTID 1
#endif
__device__ __forceinline__ int mk_tid(LAS unsigned char* lds) {
    if (!MK_HWTID) { int t = threadIdx.x; asm volatile("" : "+v"(t)); return t; }
    const int w = __builtin_amdgcn_readfirstlane((int)((volatile LAS unsigned char*)(lds + WTAB_OFF))[mk_hwslot()]);
    int l; asm volatile("v_mbcnt_lo_u32_b32 %0, -1, 0\n\tv_mbcnt_hi_u32_b32 %0, -1, %0" : "=v"(l));
    return w * 64 + l;
}
namespace pg8 {
constexpr int BM = 256, BK = 64, HALF = 128, HTB = HALF * BK * 2, STAGE_BYTES = 8 * HTB, NXCD = 8, WGM = 8;
__host__ __device__ __forceinline__ int lds_byte(int r, int c) { const int st = (r >> 4) * 2 + (c >> 5), rr = r & 15, cc = c & 31, ob = rr * 64 + cc * 2; return st * 1024 + (ob ^ (((ob >> 9) & 1) << 5)); }
__host__ __device__ __forceinline__ void stage_rc(int b, int& R, int& C) { const int st = b / 1024, sb = b % 1024, swz = sb ^ (((sb >> 9) & 1) << 5); R = (st >> 1) * 16 + swz / 64; C = (st & 1) * 32 + (swz % 64) / 2; }
__host__ __device__ __forceinline__ int perm32(int rho) { const int n = rho >> 4, i = rho & 15; return 8 * (i >> 2) + 4 * n + (i & 3); }

struct Unit { unsigned Ao, Bo; int pm, pn, e, pos0, ce; };

struct StaticOrder {
    int nM, nN, nwg, G, c, K, esz; const char* A; const char* Bt;
    __device__ void init(const void* A_, const void* Bt_, int M, int N, int K_, int G_, int c_, int esz_ = 2) { A = (const char*)A_; Bt = (const char*)Bt_; nM = M / BM; nN = N / BM; nwg = nM * nN; G = G_; c = c_; K = K_; esz = esz_; }
    __device__ bool next(int i, Unit& u) const {
        const long L = (long)i * G + c; if (L >= nwg) return false;
        int wgid = (int)L; { const int q = nwg / NXCD, r = nwg % NXCD, xcd = wgid % NXCD, off = wgid / NXCD; wgid = (xcd < r ? xcd * (q + 1) : r * (q + 1) + (xcd - r) * q) + off; }
        const int nig = WGM * nN, gid = wgid / nig, fm = gid * WGM, gsz = (nM - fm) < WGM ? (nM - fm) : WGM;
        u.pm = fm + ((wgid % nig) % gsz); u.pn = (wgid % nig) / gsz; u.e = 0; u.pos0 = 0; u.ce = 0;
        u.Ao = (unsigned)u.pm * BM * K * (unsigned)esz; u.Bo = (unsigned)u.pn * BM * K * (unsigned)esz; return true;
    }
    __device__ __forceinline__ void fill(const Unit&, LAS unsigned* dst, int tid) const { if (tid < BM) dst[tid] = (unsigned)(tid * K) * (unsigned)esz; }
};
template <bool GATHER, int KK, int ESZ> struct MoeOrder {
    const volatile LAS int* cntl; int G, vcu; const char* A; const char* Bt; const int2* list;
    static constexpr int nN = 8;
    __device__ bool next(int i, Unit& u) const {
        const int q = i * G + vcu; const int rt = q / nN, pn = q - rt * nN;
        if (rt >= 160) return false;
        const int e = __builtin_amdgcn_readfirstlane(cntl[64 + rt]); if (e < 0) return false;
        u.pm = rt; u.pn = pn; u.e = e; u.pos0 = __builtin_amdgcn_readfirstlane(cntl[224 + rt]); u.ce = __builtin_amdgcn_readfirstlane(cntl[e]);
        u.Bo = (unsigned)(e * 2048 + pn * BM) * (unsigned)(KK * ESZ); u.Ao = GATHER ? 0u : (unsigned)rt * (unsigned)(BM * KK * ESZ); return true;
    }
    __device__ __forceinline__ void fill(const Unit& u, LAS unsigned* dst, int tid) const {
        if (tid < BM) { if (GATHER) { const int pos = u.pos0 + tid; int tok = 0; if (pos < u.ce) tok = MK_LIST_SYS ? (int)__hip_atomic_load((const unsigned*)((const char*)list + ((size_t)u.e * T + pos) * LIST_ESZ), __ATOMIC_RELAXED, __HIP_MEMORY_SCOPE_SYSTEM) : *(const int*)((const char*)list + ((size_t)u.e * T + pos) * LIST_ESZ); dst[tid] = (unsigned)(tok * KK) * (unsigned)ESZ; } else dst[tid] = (unsigned)(tid * KK) * (unsigned)ESZ; }
    }
};

#ifndef MK_WT
#define MK_WT 0
#endif
struct EpiG1 {
    static constexpr bool PERM = true;
    bf16_t* U5; const float* qg; const float* kg; const float2* rope;
    __device__ __forceinline__ void operator()(const f32x4 (&acc)[2][2][4][2], const Unit& u, int wr, int wc, int fr, int fq) const {
        const int kind = u.pn >> 2, lc0 = (u.pn & 3) * 256 + wc * 64 + 8 * fq, row0 = u.pm * BM + wr * 64 + fr;
        const int lx_ = (fq * 16 + fr) << 2;
#define SX(v, m) __int_as_float(__builtin_amdgcn_ds_bpermute(lx_ ^ ((m) << 2), __float_as_int(v)))
        const __amdgpu_buffer_rsrc_t rsU = __builtin_amdgcn_make_buffer_rsrc((void*)U5, (short)0, 0x7fffffff, 0x00020000);
        constexpr float DS = MK_F8_P1 ? 1.f / (F8_SXN * F8_SWI) : 1.f;
        if (kind == 2 || kind == 3) {
            const float* g = kind == 2 ? qg : kg; const float sc = kind == 2 ? C2 : 1.f;
            f32x4 gv[2][2];
#pragma unroll
            for (int bj = 0; bj < 2; ++bj)
#pragma unroll
                for (int n = 0; n < 2; ++n) gv[bj][n] = *(const f32x4*)(g + 32 * bj + 8 * fq + 4 * n);
#pragma unroll
            for (int ai = 0; ai < 2; ++ai)
#pragma unroll
                for (int m = 0; m < 4; ++m) {
                    const int row = row0 + ai * HALF + m * 16, pos = row & (SEQ - 1);
                    float ss = 0.f;
#pragma unroll
                    for (int bj = 0; bj < 2; ++bj)
#pragma unroll
                        for (int n = 0; n < 2; ++n) { const f32x4 x = acc[ai][bj][m][n] * DS; ss += (x[0] * x[0] + x[1] * x[1]) + (x[2] * x[2] + x[3] * x[3]); }
                    ss += SX(ss, 16); ss += SX(ss, 32);
                    const float rs = rsqrtf(ss * (1.f / 64.f) + EPS) * sc;
                    f32x4 y[2][2];
#pragma unroll
                    for (int bj = 0; bj < 2; ++bj)
#pragma unroll
                        for (int n = 0; n < 2; ++n) y[bj][n] = acc[ai][bj][m][n] * (rs * DS) * gv[bj][n];
                    f32x4 pr[2];
#pragma unroll
                    for (int n = 0; n < 2; ++n)
#pragma unroll
                        for (int e = 0; e < 4; ++e) pr[n][e] = SX(y[0][n][e], 16);
                    if (fq < 2) {
#pragma unroll
                        for (int n = 0; n < 2; ++n) { const f32x4 c01 = *(const f32x4*)(rope + pos * 8 + 4 * n), c23 = *(const f32x4*)(rope + pos * 8 + 4 * n + 2);
                            const float cs[4] = {c01[0], c01[2], c23[0], c23[2]}, sn[4] = {c01[1], c01[3], c23[1], c23[3]};
#pragma unroll
                            for (int e = 0; e < 4; ++e) y[0][n][e] = fq == 0 ? y[0][n][e] * cs[e] - pr[n][e] * sn[e] : y[0][n][e] * cs[e] + pr[n][e] * sn[e]; }
                    }
                    const int vo = ((kind * T + row) * 1024 + lc0) * 2;
#pragma unroll
                    for (int bj = 0; bj < 2; ++bj) { u32x4 w; w.x = cvt_pk_bf16(y[bj][0][0], y[bj][0][1]); w.y = cvt_pk_bf16(y[bj][0][2], y[bj][0][3]); w.z = cvt_pk_bf16(y[bj][1][0], y[bj][1][1]); w.w = cvt_pk_bf16(y[bj][1][2], y[bj][1][3]);
                        __builtin_amdgcn_raw_buffer_store_b128(w, rsU, vo + 64 * bj, 0, MK_WT ? 16 : 0); }
                }
        } else {
#pragma unroll
            for (int ai = 0; ai < 2; ++ai)
#pragma unroll
                for (int m = 0; m < 4; ++m) { const int vo = ((kind * T + row0 + ai * HALF + m * 16) * 1024 + lc0) * 2;
#pragma unroll
                    for (int bj = 0; bj < 2; ++bj) { f32x4 v0 = acc[ai][bj][m][0] * DS, v1 = acc[ai][bj][m][1] * DS;
                        if (kind != 4) {
#pragma unroll
                            for (int e = 0; e < 4; ++e) { v0[e] = fast_gelu(v0[e]); v1[e] = fast_gelu(v1[e]); } }
                        u32x4 w; w.x = cvt_pk_bf16(v0[0], v0[1]); w.y = cvt_pk_bf16(v0[2], v0[3]); w.z = cvt_pk_bf16(v1[0], v1[1]); w.w = cvt_pk_bf16(v1[2], v1[3]);
                        __builtin_amdgcn_raw_buffer_store_b128(w, rsU, vo + 64 * bj, 0, MK_WT ? 16 : 0); } }
        }
    }
};
#undef SX
struct EpiG2 {
    static constexpr bool PERM = false;
    const float* x; float* out; bf16_t* X1B; int skip;
    __device__ __forceinline__ void operator()(const f32x4 (&acc)[2][2][4][2], const Unit& u, int wr, int wc, int fr, int fq) const {
        if (skip == 3) return;
        const __amdgpu_buffer_rsrc_t rsO = __builtin_amdgcn_make_buffer_rsrc((void*)out, (short)0, 0x7fffffff, 0x00020000);
        const int col0 = u.pn * BM + wc * 32 + 4 * fq;
#pragma unroll
        for (int ai = 0; ai < 2; ++ai) {
            f32x4 xv[4][2][2];
#pragma unroll
            for (int m = 0; m < 4; ++m) { const size_t off = (size_t)(u.pm * BM + ai * HALF + wr * 64 + m * 16 + fr) * DM + col0;
#pragma unroll
                for (int bj = 0; bj < 2; ++bj)
#pragma unroll
                    for (int n = 0; n < 2; ++n) xv[m][bj][n] = *(const f32x4*)(x + off + bj * HALF + n * 16); }
            __builtin_amdgcn_sched_barrier(0);
#pragma unroll
            for (int m = 0; m < 4; ++m) { const size_t off = (size_t)(u.pm * BM + ai * HALF + wr * 64 + m * 16 + fr) * DM + col0;
#pragma unroll
                for (int bj = 0; bj < 2; ++bj)
#pragma unroll
                    for (int n = 0; n < 2; ++n) { const size_t o = off + bj * HALF + n * 16;
                        f32x4 v = acc[ai][bj][m][n] + xv[m][bj][n];
                        if (skip == 4) { const f32x4 pv = *(const f32x4*)(out + o); if (pv[0] != v[0] || pv[1] != v[1] || pv[2] != v[2] || pv[3] != v[3]) v[0] += 1.0e6f; }
                        if (!(skip & 1)) { if (MK_WT) __builtin_amdgcn_raw_buffer_store_b128(__builtin_bit_cast(u32x4, v), rsO, (int)(o * 4), 0, 16); else *(f32x4*)(out + o) = v; }
                        if (MK_F8) { if (!(skip & 2)) *(unsigned*)((unsigned char*)X1B + o) = pk4_fp8(v[0] * F8_SX, v[1] * F8_SX, v[2] * F8_SX, v[3] * F8_SX); }
                        else { u32x2 w; w.x = cvt_pk_bf16(v[0], v[1]); w.y = cvt_pk_bf16(v[2], v[3]); *(u32x2*)(X1B + o) = w; } } }
        }
    }
};
#ifndef MK_EPI_DRAIN
#define MK_EPI_DRAIN 1
#endif
#ifndef MK_EPI_BUF
#define MK_EPI_BUF 1
#endif
struct EpiGLU {
    static constexpr bool PERM = true;
    bf16_t* H; const int2* list;
    __device__ __forceinline__ void operator()(const f32x4 (&acc)[2][2][4][2], const Unit& u, int wr, int wc, int fr, int fq) const {
        const __amdgpu_buffer_rsrc_t rsL = __builtin_amdgcn_make_buffer_rsrc((void*)list, (short)0, 0x7fffffff, 0x00020000), rsH = __builtin_amdgcn_make_buffer_rsrc((void*)H, (short)0, 0x7fffffff, 0x00020000);
        constexpr int ESZ = MK_F8 ? 1 : 2;
        const int r0 = wr * 64 + fr, soL = u.e * T * LIST_ESZ, soH = (u.pm * BM * DE + u.pn * 128) * ESZ;
#if MK_F8 && MK_ST16
#pragma unroll
        for (int ai = 0; ai < 2; ++ai)
#pragma unroll
            for (int mp = 0; mp < 4; mp += 2) { u32x2 ch[2];
#pragma unroll
                for (int q = 0; q < 2; ++q) { const int m = mp + q, r = r0 + ai * HALF + m * 16, pos = u.pos0 + r;
                    float rs = __uint_as_float(__builtin_amdgcn_raw_buffer_load_b32(rsL, pos * LIST_ESZ + 4, soL, MK_LIST_SYS ? 17 : 0)); rs = pos < u.ce ? rs : 0.f; rs *= 1.f / (F8_SX * F8_SW);
                    f32x4 h0, h1;
#pragma unroll
                    for (int e = 0; e < 4; ++e) { h0[e] = fast_silu(acc[ai][0][m][0][e] * rs) * (acc[ai][1][m][0][e] * rs); h1[e] = fast_silu(acc[ai][0][m][1][e] * rs) * (acc[ai][1][m][1][e] * rs); }
                    ch[q].x = pk4_fp8(h0[0] * F8_SH, h0[1] * F8_SH, h0[2] * F8_SH, h0[3] * F8_SH); ch[q].y = pk4_fp8(h1[0] * F8_SH, h1[1] * F8_SH, h1[2] * F8_SH, h1[3] * F8_SH); __builtin_amdgcn_sched_barrier(0); }
                const auto sx = __builtin_amdgcn_permlane16_swap(ch[0].x, ch[1].x, false, false), sy = __builtin_amdgcn_permlane16_swap(ch[0].y, ch[1].y, false, false);
                u32x4 w = {sx[0], sy[0], sx[1], sy[1]};
                const int rw = r0 + ai * HALF + (mp + (fq & 1)) * 16;
                __builtin_amdgcn_raw_buffer_store_b128(w, rsH, rw * DE + wc * 32 + 16 * (fq >> 1) + soH, 0, 0);
                __builtin_amdgcn_sched_barrier(0); }
        return;
#endif
#pragma unroll
        for (int ai = 0; ai < 2; ++ai)
#pragma unroll
            for (int m = 0; m < 4; ++m) { const int r = r0 + ai * HALF + m * 16, pos = u.pos0 + r;
                float rs; if (MK_EPI_BUF) { rs = __uint_as_float(__builtin_amdgcn_raw_buffer_load_b32(rsL, pos * LIST_ESZ + 4, soL, MK_LIST_SYS ? 17 : 0)); rs = pos < u.ce ? rs : 0.f; } else rs = pos < u.ce ? __int_as_float(list[(size_t)u.e * T + pos].y) : 0.f;
                if (MK_F8) rs *= 1.f / (F8_SX * F8_SW);
                f32x4 h0, h1;
#pragma unroll
                for (int e = 0; e < 4; ++e) { h0[e] = fast_silu(acc[ai][0][m][0][e] * rs) * (acc[ai][1][m][0][e] * rs); h1[e] = fast_silu(acc[ai][0][m][1][e] * rs) * (acc[ai][1][m][1][e] * rs); }
                const int vo = (r * DE + wc * 32 + 8 * fq) * ESZ;
                if (MK_F8) { u32x2 w; w.x = pk4_fp8(h0[0] * F8_SH, h0[1] * F8_SH, h0[2] * F8_SH, h0[3] * F8_SH); w.y = pk4_fp8(h1[0] * F8_SH, h1[1] * F8_SH, h1[2] * F8_SH, h1[3] * F8_SH);
                    if (MK_EPI_BUF) __builtin_amdgcn_raw_buffer_store_b64(w, rsH, vo + soH, 0, 0); else *(u32x2*)((unsigned char*)H + (size_t)(u.pm * BM + r) * DE + u.pn * 128 + wc * 32 + 8 * fq) = w; }
                else { u32x4 w; w.x = cvt_pk_bf16(h0[0], h0[1]); w.y = cvt_pk_bf16(h0[2], h0[3]); w.z = cvt_pk_bf16(h1[0], h1[1]); w.w = cvt_pk_bf16(h1[2], h1[3]);
                    if (MK_EPI_BUF) __builtin_amdgcn_raw_buffer_store_b128(w, rsH, vo + soH, 0, 0); else *(u32x4*)(H + (size_t)(u.pm * BM + r) * DE + u.pn * 128 + wc * 32 + 8 * fq) = w; } }
    }
};
#ifndef MK_Y8
#define MK_Y8 1
#endif
constexpr float F8_SY = 64.f;
struct EpiY {
    static constexpr bool PERM = true;
    bf16_t* Y; int skip;
    __device__ __forceinline__ void operator()(const f32x4 (&acc)[2][2][4][2], const Unit& u, int wr, int wc, int fr, int fq) const {
        if (skip) return;
        const __amdgpu_buffer_rsrc_t rsY = __builtin_amdgcn_make_buffer_rsrc((void*)Y, (short)0, 0x7fffffff, 0x00020000);
        const int soY = (u.pm * BM * 2048 + u.pn * BM) * 2; const float sc = MK_F8 ? 1.f / (F8_SH * F8_SD) : 1.f;
#if MK_Y8 && MK_ST16
        {   constexpr float s8 = (MK_F8 ? 1.f / (F8_SH * F8_SD) : 1.f) * F8_SY;
#pragma unroll
            for (int ai = 0; ai < 2; ++ai)
#pragma unroll
                for (int mp = 0; mp < 4; mp += 2)
#pragma unroll
                    for (int bj = 0; bj < 2; ++bj) {
                        unsigned sxa, sxb, sya, syb;
                        { const f32x4 p0 = acc[ai][bj][mp][0], p1 = acc[ai][bj][mp + 1][0];
                          const auto sx = __builtin_amdgcn_permlane16_swap(pk4_fp8(p0[0] * s8, p0[1] * s8, p0[2] * s8, p0[3] * s8), pk4_fp8(p1[0] * s8, p1[1] * s8, p1[2] * s8, p1[3] * s8), false, false); sxa = sx[0]; sxb = sx[1]; }
                        __builtin_amdgcn_sched_barrier(0);
                        { const f32x4 p0 = acc[ai][bj][mp][1], p1 = acc[ai][bj][mp + 1][1];
                          const auto sy = __builtin_amdgcn_permlane16_swap(pk4_fp8(p0[0] * s8, p0[1] * s8, p0[2] * s8, p0[3] * s8), pk4_fp8(p1[0] * s8, p1[1] * s8, p1[2] * s8, p1[3] * s8), false, false); sya = sy[0]; syb = sy[1]; }
                        u32x4 w = {sxa, sya, sxb, syb};
                        const int rw = ai * HALF + wr * 64 + (mp + (fq & 1)) * 16 + fr;
                        __builtin_amdgcn_raw_buffer_store_b128(w, rsY, rw * 2048 + wc * 32 + 16 * (fq >> 1) + bj * HALF + (soY >> 1), 0, 0);
                        __builtin_amdgcn_sched_barrier(0); }
            return; }
#endif
#pragma unroll
        for (int ai = 0; ai < 2; ++ai)
#pragma unroll
            for (int m = 0; m < 4; ++m) { const int vo = ((ai * HALF + wr * 64 + m * 16 + fr) * 2048 + wc * 32 + 8 * fq) * 2;
#pragma unroll
                for (int bj = 0; bj < 2; ++bj) {
                    if (MK_Y8) { constexpr float s8 = (MK_F8 ? 1.f / (F8_SH * F8_SD) : 1.f) * F8_SY; const f32x4 a0 = acc[ai][bj][m][0], a1 = acc[ai][bj][m][1];
                        u32x2 w8; w8.x = pk4_fp8(a0[0] * s8, a0[1] * s8, a0[2] * s8, a0[3] * s8); w8.y = pk4_fp8(a1[0] * s8, a1[1] * s8, a1[2] * s8, a1[3] * s8);
                        __builtin_amdgcn_raw_buffer_store_b64(w8, rsY, (vo >> 1) + bj * HALF + (soY >> 1), 0, 0);
                        __builtin_amdgcn_sched_barrier(0);
                    } else { const f32x4 v0 = acc[ai][bj][m][0] * sc, v1 = acc[ai][bj][m][1] * sc;
                    u32x4 w; w.x = cvt_pk_bf16(v0[0], v0[1]); w.y = cvt_pk_bf16(v0[2], v0[3]); w.z = cvt_pk_bf16(v1[0], v1[1]); w.w = cvt_pk_bf16(v1[2], v1[3]);
                    if (MK_EPI_BUF) __builtin_amdgcn_raw_buffer_store_b128(w, rsY, vo + bj * HALF * 2 + soY, 0, 0); else *(u32x4*)(Y + (size_t)(u.pm * BM + ai * HALF + wr * 64 + m * 16 + fr) * 2048 + u.pn * BM + wc * 32 + 8 * fq + bj * HALF) = w; } } }
    }
};

template <class Epi, class Sched, bool ALIGN_EPI, bool F8 = false>
__device__ __forceinline__ void gemm_phase(LAS unsigned char* lds, LAS unsigned* rtab  , const int K, const Sched& S, const Epi& E) {
    const int tid = mk_tid(lds), wid = __builtin_amdgcn_readfirstlane(tid >> 6), lane = tid & 63, wr = wid >> 2, wc = wid & 3, fr = lane & 15, fq = lane >> 4;
    const int nt = F8 ? K / 128 : K / BK;
    unsigned voffB[2], rcA[2];
#pragma unroll
    for (int i = 0; i < 2; ++i) { int R, C; stage_rc(tid * 16 + i * 8192, R, C); const int Rb = Epi::PERM ? ((R & ~31) + perm32(R & 31)) : R; voffB[i] = F8 ? (unsigned)(Rb * K + 2 * C) : (unsigned)(Rb * K + C) * 2u; rcA[i] = (unsigned)(R * 4) | ((unsigned)(C * 2) << 16); }
    const unsigned kstep = (unsigned)(BK * 2), hstep = F8 ? (unsigned)(HALF * K) : (unsigned)(HALF * K * 2);
    const unsigned ldsw = (unsigned)wid * 1024u;
    const int aoff = F8 ? lds_byte(wr * 64 + fr, fq * 16) : lds_byte(wr * 64 + fr, fq * 8), boff = F8 ? lds_byte(wc * 32 + fr, fq * 16) : lds_byte(wc * 32 + fr, fq * 8);
#define PG8_SA(b, h) (((b) * 2 + (h)) * HTB)
#define PG8_SB(b, h) ((4 + (b) * 2 + (h)) * HTB)
#define PG8_STAGE(bufoff, so, voff) do { const char* _gb = (const char*)S.Bt + (so); asm volatile("" : "+s"(_gb)); _Pragma("unroll") for (int _i = 0; _i < 2; ++_i) { unsigned _vb = (voff)[_i]; asm volatile("" : "+v"(_vb)); \
        __builtin_amdgcn_global_load_lds((const unsigned*)(_gb + _vb), (LAS unsigned*)(lds + (bufoff) + ldsw + _i * 8192), 16, 0, 0); } } while (0)
#define PG8_STAGE_A(bufoff, so, tb, h) do { const char* _ga = (const char*)S.A + (so); asm volatile("" : "+s"(_ga)); unsigned _tbo = (unsigned)((tb) * 1024 + (h) * 512); if (MK_TBO) asm volatile("" : "+s"(_tbo));        \
        _Pragma("unroll") for (int _i = 0; _i < 2; ++_i) { \
        const unsigned _ro = *(const LAS unsigned*)((const LAS unsigned char*)rtab + _tbo + (rcA[_i] & 0xffffu)) + (rcA[_i] >> 16); \
        __builtin_amdgcn_global_load_lds((const unsigned*)(_ga + _ro), (LAS unsigned*)(lds + (bufoff) + ldsw + _i * 8192), 16, 0, 0); } } while (0)
#define PG8_CAT8(lo, hi) __builtin_shufflevector(__builtin_bit_cast(i32x4, lo), __builtin_bit_cast(i32x4, hi), 0, 1, 2, 3, 4, 5, 6, 7)
#define PG8_LDA(dst, b, h) do { _Pragma("unroll") for (int m = 0; m < 4; ++m) { if constexpr (F8) dst##8[m] = PG8_CAT8(*(const LAS bf16x8*)(lds + PG8_SA(b, h) + aoff + m * 2048), *(const LAS bf16x8*)(lds + PG8_SA(b, h) + aoff + m * 2048 + 16)); \
        else { _Pragma("unroll") for (int k = 0; k < 2; ++k) dst[m][k] = *(const LAS bf16x8*)(lds + PG8_SA(b, h) + aoff + m * 2048 + k * 1024); } } } while (0)
#define PG8_LDB(dst, b, h) do { _Pragma("unroll") for (int n = 0; n < 2; ++n) { if constexpr (F8) dst##8[n] = PG8_CAT8(*(const LAS bf16x8*)(lds + PG8_SB(b, h) + boff + n * 2048), *(const LAS bf16x8*)(lds + PG8_SB(b, h) + boff + n * 2048 + 16)); \
        else { _Pragma("unroll") for (int k = 0; k < 2; ++k) dst[n][k] = *(const LAS bf16x8*)(lds + PG8_SB(b, h) + boff + n * 2048 + k * 1024); } } } while (0)
#define PG8_MMA(ai, bj, At, Bt) do { __builtin_amdgcn_s_setprio(1); _Pragma("unroll") for (int m = 0; m < 4; ++m) _Pragma("unroll") for (int n = 0; n < 2; ++n) { \
        if constexpr (F8) acc[ai][bj][m][n] = __builtin_amdgcn_mfma_scale_f32_16x16x128_f8f6f4(Bt##8[n], At##8[m], acc[ai][bj][m][n], 0, 0, 0, 0x7f7f7f7f, 0, 0x7f7f7f7f); \
        else { _Pragma("unroll") for (int k = 0; k < 2; ++k) acc[ai][bj][m][n] = __builtin_amdgcn_mfma_f32_16x16x32_bf16(Bt[n][k], At[m][k], acc[ai][bj][m][n], 0, 0, 0); } } __builtin_amdgcn_s_setprio(0); } while (0)
#define PG8_WAIT_V(n) asm volatile("s_waitcnt vmcnt(" #n ")" ::: "memory")
#ifndef MK_F8_DRAIN
#define MK_F8_DRAIN 0
#endif
#define PG8_WAIT_VK do { if (F8 && MK_F8_DRAIN) PG8_WAIT_V(0); else PG8_WAIT_V(8); } while (0)
#define PG8_WAIT_L(n) asm volatile("s_waitcnt lgkmcnt(" #n ")" ::: "memory")
#define PG8_BAR __builtin_amdgcn_s_barrier()
#define PG8_SCHED __builtin_amdgcn_sched_barrier(0)
    Unit cur, nxt; int ui = 0;
    if (!S.next(0, cur)) return;
    f32x4 acc[2][2][4][2];
#pragma unroll
    for (int a = 0; a < 2; ++a)
#pragma unroll
        for (int b = 0; b < 2; ++b)
#pragma unroll
            for (int m = 0; m < 4; ++m)
#pragma unroll
                for (int n = 0; n < 2; ++n) acc[a][b][m][n] = (f32x4){0.f, 0.f, 0.f, 0.f};
    bf16x8 At[4][2], B0[2][2], B1[2][2]; i32x8 At8[4], B08[2], B18[2];
    S.fill(cur, rtab, tid);
    asm volatile("s_waitcnt lgkmcnt(0)" ::: "memory"); PG8_BAR; asm volatile("" ::: "memory");
    unsigned cA = cur.Ao, cB = cur.Bo;
    PG8_STAGE(PG8_SB(0, 0), cB, voffB); PG8_STAGE(PG8_SB(0, 1), cB + hstep, voffB); PG8_STAGE_A(PG8_SA(0, 0), cA, 0, 0); PG8_STAGE_A(PG8_SA(0, 1), cA, 0, 1);
    if (wr == 1) PG8_BAR;
    PG8_WAIT_V(2); PG8_BAR;
    PG8_STAGE(PG8_SB(1, 0), cB + kstep, voffB); PG8_STAGE_A(PG8_SA(1, 0), cA + kstep, 0, 0); PG8_STAGE(PG8_SB(1, 1), cB + hstep + kstep, voffB);
    PG8_WAIT_V(6); PG8_BAR;
    for (;;) {
        const bool has_next = S.next(ui + 1, nxt);
        const unsigned nA = has_next ? nxt.Ao : cA, nB = has_next ? nxt.Bo : cB;
        const int tbc = ui & 1, tbn = has_next ? (tbc ^ 1) : tbc;
        if (has_next) S.fill(nxt, rtab + tbn * 256, mk_tid(lds));
#pragma unroll 1
        for (int t = 0; t < nt; t += 2) {
            const bool last = (t == nt - 2);
            unsigned a1 = cA + (unsigned)(t + 1) * kstep;
            unsigned a2 = last ? nA : cA + (unsigned)(t + 2) * kstep, b2 = last ? nB : cB + (unsigned)(t + 2) * kstep;
            unsigned a3 = a2 + kstep, b3 = b2 + kstep;
            asm volatile("" : "+s"(a1), "+s"(a2), "+s"(a3), "+s"(b2), "+s"(b3));
            const int tb2 = last ? tbn : tbc;
            PG8_LDB(B0, 0, 0); PG8_LDB(B1, 0, 1); PG8_SCHED; PG8_LDA(At, 0, 0); PG8_STAGE_A(PG8_SA(1, 1), a1, tbc, 1);
            PG8_WAIT_VK; PG8_WAIT_L(0); PG8_BAR; PG8_MMA(0, 0, At, B0); PG8_MMA(0, 1, At, B1); PG8_BAR; PG8_SCHED;
            PG8_LDA(At, 0, 1); PG8_STAGE(PG8_SB(0, 0), b2, voffB); PG8_STAGE(PG8_SB(0, 1), b2 + hstep, voffB); PG8_STAGE_A(PG8_SA(0, 0), a2, tb2, 0);
            PG8_WAIT_VK; PG8_WAIT_L(0); PG8_BAR; PG8_MMA(1, 0, At, B0); PG8_MMA(1, 1, At, B1); PG8_BAR; PG8_SCHED;
            PG8_LDB(B0, 1, 0); PG8_LDB(B1, 1, 1); PG8_SCHED; PG8_LDA(At, 1, 0); PG8_STAGE_A(PG8_SA(0, 1), a2, tb2, 1);
            PG8_WAIT_VK; PG8_WAIT_L(0); PG8_BAR; PG8_MMA(0, 0, At, B0); PG8_MMA(0, 1, At, B1); PG8_BAR; PG8_SCHED;
            PG8_LDA(At, 1, 1); PG8_STAGE(PG8_SB(1, 0), b3, voffB); PG8_STAGE(PG8_SB(1, 1), b3 + hstep, voffB); PG8_STAGE_A(PG8_SA(1, 0), a3, tb2, 0);
            PG8_WAIT_VK; PG8_WAIT_L(0); PG8_BAR; PG8_MMA(1, 0, At, B0); PG8_MMA(1, 1, At, B1); PG8_BAR; PG8_SCHED;
        }
        if constexpr (ALIGN_EPI) { if (wr == 0) PG8_BAR; }
        { int te = mk_tid(lds); asm volatile("" : "+v"(te)); const int le = te & 63; E(acc, cur, wr, wc, le & 15, le >> 4); }
        if (!has_next) break;
        if (MK_EPI_DRAIN) PG8_WAIT_V(0);
#pragma unroll
        for (int a = 0; a < 2; ++a)
#pragma unroll
            for (int b = 0; b < 2; ++b)
#pragma unroll
                for (int m = 0; m < 4; ++m)
#pragma unroll
                    for (int n = 0; n < 2; ++n) acc[a][b][m][n] = (f32x4){0.f, 0.f, 0.f, 0.f};
        cur = nxt; cA = nA; cB = nB; ++ui;
        if constexpr (ALIGN_EPI) { if (wr == 1) PG8_BAR; }
    }
    PG8_WAIT_V(0);
    if constexpr (!ALIGN_EPI) { if (wr == 0) PG8_BAR; }
    PG8_BAR;
#undef PG8_SA
#undef PG8_SB
#undef PG8_STAGE
#undef PG8_STAGE_A
#undef PG8_LDA
#undef PG8_LDB
#undef PG8_MMA
#undef PG8_CAT8
#undef PG8_WAIT_V
#undef PG8_WAIT_VK
#undef PG8_WAIT_L
#undef PG8_BAR
#undef PG8_SCHED
}
}


namespace dattn {
using s16x4 = __attribute__((ext_vector_type(4))) short;
using f32x16 = __attribute__((ext_vector_type(16))) float;
constexpr int KVB = 64, NT = SEQ / KVB;
constexpr int L_V = 0, L_K = 32768, L_Q = 65536, L_SC = EXTRA_OFF;
#define SBAR() __builtin_amdgcn_sched_barrier(0)
#ifndef MK_ATT_SBAR
#define MK_ATT_SBAR 1
#endif
#define ABAR() do { if (MK_ATT_SBAR) __builtin_amdgcn_sched_barrier(0); } while (0)
__device__ __forceinline__ int crow(int r, int hi) { return (r & 3) + 8 * (r >> 2) + 4 * hi; }
__device__ __forceinline__ int v_rd_base(int lane) { return ((lane & 3) << 3) | (((lane >> 2) & 3) << 6) | (((lane >> 4) & 1) << 5) | (((lane >> 5) & 1) << 8); }
constexpr int v_rd_off(int d0, int ks, int half) { return d0 * 512 + ks * 4096 + half * 2048; }
template <int OFF> __device__ __forceinline__ s16x4 tr_read(int vb) { s16x4 r; asm volatile("ds_read_b64_tr_b16 %0, %1 offset:%2" : "=&v"(r) : "v"(vb), "i"(OFF) : "memory"); return r; }
__device__ __forceinline__ unsigned hk_src(int L, int colbase) { const int row = L >> 7, ch = ((L & 127) >> 4) ^ ((row >> 1) & 7); return (unsigned)(row * 1024 + colbase + ch * 8) * 2u; }
__device__ __forceinline__ unsigned v_src(int L, int colbase) { const int st = L >> 9, rem = L & 511, kk = ((st >> 2) << 3) | (rem >> 6), k = (kk & ~0xC) | ((kk & 4) << 1) | ((kk & 8) >> 1), c = (st & 3) * 32 + ((rem & 63) >> 1); return (unsigned)(k * 1024 + colbase + c) * 2u; }

#ifndef MK_QREG
#define MK_QREG 1
#endif
__device__ __forceinline__ void qk(f32x16& p0, f32x16& p1, const LAS char* Kb, const LAS char* Qh, const int (&ab)[4], const bf16x8 (&qf)[4]) {
#pragma unroll
    for (int d = 0; d < 4; ++d) {
        const bf16x8 q = MK_QREG ? qf[d] : *(const LAS bf16x8*)(Qh + ab[d]);
        const bf16x8 b0 = *(const LAS bf16x8*)(Kb + ab[d]), b1 = *(const LAS bf16x8*)(Kb + ab[d] + 4096);
        if (d == 0) { const f32x16 z = {}; p0 = __builtin_amdgcn_mfma_f32_32x32x16_bf16(b0, q, z, 0, 0, 0); p1 = __builtin_amdgcn_mfma_f32_32x32x16_bf16(b1, q, z, 0, 0, 0); }
        else { p0 = __builtin_amdgcn_mfma_f32_32x32x16_bf16(b0, q, p0, 0, 0, 0); p1 = __builtin_amdgcn_mfma_f32_32x32x16_bf16(b1, q, p1, 0, 0, 0); } }
}
__device__ __forceinline__ void sm_pack(f32x16& p0, f32x16& p1, float& l, bf16x8& a0, bf16x8& a1, bf16x8& a2, bf16x8& a3) {
#pragma unroll
    for (int r = 0; r < 16; ++r) { p0[r] = __builtin_amdgcn_exp2f(p0[r]); p1[r] = __builtin_amdgcn_exp2f(p1[r]); }
    float s0 = 0.f, s1 = 0.f;
#pragma unroll
    for (int r = 0; r < 16; ++r) { s0 += p0[r]; s1 += p1[r]; }
    l += s0 + s1;
#define PK4(P, BASE, OUT) do { const unsigned a0_ = cvt_pk_bf16(P[BASE + 0], P[BASE + 1]), a1_ = cvt_pk_bf16(P[BASE + 2], P[BASE + 3]);   \
    const unsigned b0_ = cvt_pk_bf16(P[BASE + 4], P[BASE + 5]), b1_ = cvt_pk_bf16(P[BASE + 6], P[BASE + 7]);                              \
    auto r0_ = __builtin_amdgcn_permlane32_swap(a0_, b0_, false, false); auto r1_ = __builtin_amdgcn_permlane32_swap(a1_, b1_, false, false); \
    u32x4 w_ = {r0_[0], r1_[0], r0_[1], r1_[1]}; OUT = __builtin_bit_cast(bf16x8, w_); } while (0)
    PK4(p0, 0, a0); PK4(p0, 8, a1); PK4(p1, 0, a2); PK4(p1, 8, a3);
#undef PK4
}
template <int D0> __device__ __forceinline__ void pv1(f32x16& o, int vb, bf16x8 a0, bf16x8 a1, bf16x8 a2, bf16x8 a3) {
    const s16x4 l0 = tr_read<v_rd_off(D0, 0, 0)>(vb), h0 = tr_read<v_rd_off(D0, 0, 1)>(vb), l1 = tr_read<v_rd_off(D0, 1, 0)>(vb), h1 = tr_read<v_rd_off(D0, 1, 1)>(vb);
    const s16x4 l2 = tr_read<v_rd_off(D0, 2, 0)>(vb), h2 = tr_read<v_rd_off(D0, 2, 1)>(vb), l3 = tr_read<v_rd_off(D0, 3, 0)>(vb), h3 = tr_read<v_rd_off(D0, 3, 1)>(vb);
    asm volatile("s_waitcnt lgkmcnt(0)" ::: "memory"); SBAR();
#define PK(L, H) (bf16x8){L[0], L[1], L[2], L[3], H[0], H[1], H[2], H[3]}
    o = __builtin_amdgcn_mfma_f32_32x32x16_bf16(a0, PK(l0, h0), o, 0, 0, 0); o = __builtin_amdgcn_mfma_f32_32x32x16_bf16(a1, PK(l1, h1), o, 0, 0, 0);
    o = __builtin_amdgcn_mfma_f32_32x32x16_bf16(a2, PK(l2, h2), o, 0, 0, 0); o = __builtin_amdgcn_mfma_f32_32x32x16_bf16(a3, PK(l3, h3), o, 0, 0, 0);
#undef PK
}
typedef short v4i16_t __attribute__((ext_vector_type(4)));
__device__ __forceinline__ s16x4 vtr(const LAS char* p) { return __builtin_bit_cast(s16x4, __builtin_amdgcn_ds_read_tr16_b64_v4i16((LAS v4i16_t*)p)); }
__device__ __forceinline__ void sm_half(f32x16& p, float& l, bf16x8& aL, bf16x8& aH) {
#pragma unroll
    for (int r = 0; r < 16; ++r) p[r] = __builtin_amdgcn_exp2f(p[r]);
    float s0 = 0.f;
#pragma unroll
    for (int r = 0; r < 16; ++r) s0 += p[r];
    l += s0;
#define PK4(P, BASE, OUT) do { const unsigned a0_ = cvt_pk_bf16(P[BASE + 0], P[BASE + 1]), a1_ = cvt_pk_bf16(P[BASE + 2], P[BASE + 3]);   \
    const unsigned b0_ = cvt_pk_bf16(P[BASE + 4], P[BASE + 5]), b1_ = cvt_pk_bf16(P[BASE + 6], P[BASE + 7]);                              \
    auto r0_ = __builtin_amdgcn_permlane32_swap(a0_, b0_, false, false); auto r1_ = __builtin_amdgcn_permlane32_swap(a1_, b1_, false, false); \
    u32x4 w_ = {r0_[0], r1_[0], r0_[1], r1_[1]}; OUT = __builtin_bit_cast(bf16x8, w_); } while (0)
    PK4(p, 0, aL); PK4(p, 8, aH);
#undef PK4
}
#ifndef MK_ATT_PRIO
#define MK_ATT_PRIO 0
#endif
template <int KS0> __device__ __forceinline__ void pv_half(f32x16 (&o)[4], const LAS char* vp, bf16x8 aL, bf16x8 aH) {
    if (MK_ATT_PRIO) __builtin_amdgcn_s_setprio(1);
#define PK(L, H) (bf16x8){L[0], L[1], L[2], L[3], H[0], H[1], H[2], H[3]}
#pragma unroll
    for (int d = 0; d < 4; ++d) {
        const s16x4 l0 = vtr(vp + v_rd_off(d, KS0, 0)), h0 = vtr(vp + v_rd_off(d, KS0, 1)), l1 = vtr(vp + v_rd_off(d, KS0 + 1, 0)), h1 = vtr(vp + v_rd_off(d, KS0 + 1, 1));
        o[d] = __builtin_amdgcn_mfma_f32_32x32x16_bf16(aL, PK(l0, h0), o[d], 0, 0, 0); o[d] = __builtin_amdgcn_mfma_f32_32x32x16_bf16(aH, PK(l1, h1), o[d], 0, 0, 0); }
#undef PK
    if (MK_ATT_PRIO) __builtin_amdgcn_s_setprio(0);
}
#define DGLDS(gp, loff) __builtin_amdgcn_global_load_lds((const unsigned*)(gp), (LAS unsigned*)(lds + (loff)), 16, 0, 0)

template <int CH> __device__ __forceinline__ void attn_pass(LAS unsigned char* lds, const char* Kg, const char* Vg, f32x16 (&o)[4], float& l, int wid, int lane, int h, const int (&ab)[4]) {
    unsigned ksrc, vsrc[2];
    { const int L = wid * 1024 + lane * 16; ksrc = hk_src(L, h * 128 + CH * 64); }
#pragma unroll
    for (int i = 0; i < 2; ++i) { const int L = (wid * 2 + i) * 1024 + lane * 16; vsrc[i] = v_src(L, h * 128); }
    constexpr size_t TSTEP = (size_t)KVB * 1024 * 2;
#define STAGE_K(t) DGLDS(Kg + (size_t)(t) * TSTEP + ksrc, L_K + ((t) & 1) * 8192 + wid * 1024)
#define STAGE_V(t) do { _Pragma("unroll") for (int i_ = 0; i_ < 2; ++i_) DGLDS(Vg + (size_t)(t) * TSTEP + vsrc[i_], L_V + ((t) & 1) * 16384 + (wid * 2 + i_) * 1024); } while (0)
#define TOP_BAR() do { asm volatile("s_waitcnt vmcnt(0)" ::: "memory"); __syncthreads(); } while (0)
    const LAS char* Qh = (const LAS char*)(lds + L_Q + wid * 8192 + CH * 4096);
    const LAS char* K0 = (const LAS char*)(lds + L_K); const LAS char* K1 = K0 + 8192;
    const LAS char* vb0 = (const LAS char*)(lds + L_V) + v_rd_base(lane); const LAS char* vb1 = vb0 + 16384;
    f32x16 pA0, pA1, pB0, pB1; bf16x8 a0, a1, a2, a3;
    TOP_BAR();
    STAGE_K(0); STAGE_V(0);
    TOP_BAR();
    bf16x8 qf[4];
#pragma unroll
    for (int d = 0; d < 4; ++d) qf[d] = *(const LAS bf16x8*)(Qh + ab[d]);
    qk(pA0, pA1, K0, Qh, ab, qf);
    STAGE_K(1);
#define STEP(PC0, PC1, PN0, PN1, j, KNEXT, VBUF, DO_K, DO_V) do { \
        TOP_BAR(); \
        if (DO_K) STAGE_K((j) + 2); \
        if (DO_V) { STAGE_V((j) + 1); qk(PN0, PN1, KNEXT, Qh, ab, qf); } \
        sm_half(PC0, l, a0, a1); ABAR();            \
        pv_half<0>(o, VBUF, a0, a1); \
        sm_half(PC1, l, a2, a3); ABAR();            \
        pv_half<2>(o, VBUF, a2, a3); ABAR();        \
    } while (0)
    for (int j = 0; j < NT - 2; j += 2) {
        STEP(pA0, pA1, pB0, pB1, j, K1, vb0, true, true);
        STEP(pB0, pB1, pA0, pA1, j + 1, K0, vb1, true, true);
    }
    STEP(pA0, pA1, pB0, pB1, NT - 2, K1, vb0, false, true);
    STEP(pB0, pB1, pA0, pA1, NT - 1, K0, vb1, false, false);
#undef STEP
#undef STAGE_K
#undef STAGE_V
#undef TOP_BAR
}

__device__ __forceinline__ void attn_unit(LAS unsigned char* lds, int b, int h, int qb, const bf16_t* QN, const bf16_t* KN, const bf16_t* VB, bf16_t* MIX, const float* subg, float lam) {
    int tid = mk_tid(lds); asm volatile("" : "+v"(tid));
    const int lane = tid & 63, r32 = lane & 31, hi = lane >> 5; const int wid = __builtin_amdgcn_readfirstlane(tid >> 6);
    const size_t rowbase = (size_t)b * SEQ; const int q0 = qb * 256;
    const char* Kg = (const char*)(KN + rowbase * 1024); const char* Vg = (const char*)(VB + rowbase * 1024); const char* Qg = (const char*)(QN + (rowbase + q0 + wid * 32) * 1024);
    __syncthreads();
#pragma unroll
    for (int i = 0; i < 8; ++i) { const int L = (i & 3) * 1024 + lane * 16; DGLDS(Qg + hk_src(L, h * 128 + (i >> 2) * 64), L_Q + wid * 8192 + i * 1024); }
    int ab[4];
#pragma unroll
    for (int d = 0; d < 4; ++d) ab[d] = r32 * 128 + ((d * 32 + hi * 16) ^ (((r32 >> 1) & 7) << 4));
    LAS float* sc = (LAS float*)(lds + L_SC) + wid * 64;
    f32x16 o[4]; float l = 0.f;
#pragma unroll
    for (int d = 0; d < 4; ++d) o[d] = f32x16{};
    attn_pass<0>(lds, Kg, Vg, o, l, wid, lane, h, ab);
    { auto rr = __builtin_amdgcn_permlane32_swap(__float_as_uint(l), __float_as_uint(l), false, false); l = __uint_as_float(rr[0]) + __uint_as_float(rr[1]); }
    if (hi == 0) sc[r32] = 1.f / l;
    asm volatile("s_waitcnt lgkmcnt(0)" ::: "memory");
    LAS unsigned* park0 = (LAS unsigned*)(lds + L_Q + wid * 8192) + lane;
    LAS unsigned* park1 = (LAS unsigned*)(lds + 135680 + wid * 3072) + lane;
    unsigned keep[4];
#pragma unroll
    for (int r = 0; r < 16; r += 2) { const float i0 = sc[crow(r, hi)], i1 = sc[crow(r + 1, hi)];
#pragma unroll
        for (int d = 0; d < 4; ++d) { const unsigned w = cvt_pk_bf16(o[d][r] * i0, o[d][r + 1] * i1); const int j = d * 8 + (r >> 1); if (j < 16) park0[64 * j] = w; else if (j < 28) park1[64 * (j - 16)] = w; else keep[j - 28] = w; } }
#pragma unroll
    for (int d = 0; d < 4; ++d) o[d] = f32x16{};
    l = 0.f;
    attn_pass<1>(lds, Kg, Vg, o, l, wid, lane, h, ab);
    { auto rr = __builtin_amdgcn_permlane32_swap(__float_as_uint(l), __float_as_uint(l), false, false); l = __uint_as_float(rr[0]) + __uint_as_float(rr[1]); }
    if (hi == 0) sc[32 + r32] = lam / l;
    asm volatile("s_waitcnt lgkmcnt(0)" ::: "memory");
    float ss[16];
#pragma unroll
    for (int r = 0; r < 16; ++r) { const float i2 = sc[32 + crow(r, hi)]; float s = 0.f;
#pragma unroll
        for (int d = 0; d < 4; ++d) { const int j = d * 8 + (r >> 1); const unsigned w = j < 16 ? park0[64 * j] : (j < 28 ? park1[64 * (j - 16)] : keep[j - 28]); const float o1n = (r & 1) ? bf2f(w >> 16) : bf2f(w & 0xffffu); const float v = o1n - o[d][r] * i2; o[d][r] = v; s += v * v; }
        ss[r] = s; }
#pragma unroll
    for (int r = 0; r < 16; ++r) { float s = ss[r]; s += __shfl_xor(s, 1); s += __shfl_xor(s, 2); s += __shfl_xor(s, 4); s += __shfl_xor(s, 8); s += __shfl_xor(s, 16); ss[r] = rsqrtf(s * (1.f / 128.f) + EPS) * 0.8f; }
    asm volatile("s_waitcnt lgkmcnt(0)" ::: "memory");
    LAS bf16_t* stg = (LAS bf16_t*)(lds + L_Q + wid * 8192);
#pragma unroll
    for (int d = 0; d < 4; ++d) { const float g = subg[d * 32 + r32];
#pragma unroll
        for (int r = 0; r < 16; ++r) stg[crow(r, hi) * 128 + d * 32 + r32] = (bf16_t)f2bf(o[d][r] * ss[r] * g); }
    asm volatile("s_waitcnt lgkmcnt(0)" ::: "memory");
    bf16_t* Ow = MIX + (rowbase + q0 + wid * 32) * DM + 1024 + h * 128;
#pragma unroll
    for (int i = 0; i < 8; ++i) { const int row = i * 4 + (lane >> 4), ch = lane & 15; const u32x4 v = *(const LAS u32x4*)(stg + row * 128 + ch * 8); *(u32x4*)(Ow + (size_t)row * DM + ch * 8) = v; }
    asm volatile("s_waitcnt lgkmcnt(0)" ::: "memory");
}

__device__ __forceinline__ int v_st(int k, int c) { const int kk = (k & ~0xC) | ((k & 4) << 1) | ((k & 8) >> 1); return ((kk >> 3) * 4 + (c >> 5)) * 512 + ((kk & 7) * 32 + (c & 31)) * 2; }
__device__ __forceinline__ void gmlp_pair(LAS unsigned char* lds, int pair, const bf16_t* U, const bf16_t* VG, const bf16_t* WsB, const float* lng, const float* lnb, const float* gbs, bf16_t* MIX) {
    int tid = mk_tid(lds); asm volatile("" : "+v"(tid));
    const int lane = tid & 63, r32 = lane & 31, hi = lane >> 5; const int wid = __builtin_amdgcn_readfirstlane(tid >> 6);
    const int it = pair * 2 + (wid >> 2), ib = wid & 3;
    const int h = it & 7, c = (it >> 3) & 31, b = it >> 8, t0 = b * SEQ + c * 128;
    const int img = (wid >> 2) * 32768;
    __syncthreads();
    {
        const int t = tid & 255, sr = t >> 4, sc = (t & 15) * 8;
        f32x4 g0 = *(const f32x4*)(lng + h * 128 + sc), g1 = *(const f32x4*)(lng + h * 128 + sc + 4), b0 = *(const f32x4*)(lnb + h * 128 + sc), b1 = *(const f32x4*)(lnb + h * 128 + sc + 4);
        uint4 vq[8];
#pragma unroll
        for (int k = 0; k < 8; ++k) vq[k] = *(const uint4*)(VG + (size_t)(t0 + sr + 16 * k) * 1024 + h * 128 + sc);
#pragma unroll
        for (int k = 0; k < 8; ++k) { const int row = sr + 16 * k; float f[8]; unpack8(vq[k], f);
            float s = 0.f;
#pragma unroll
            for (int i = 0; i < 8; ++i) s += f[i];
            s += __shfl_xor(s, 1); s += __shfl_xor(s, 2); s += __shfl_xor(s, 4); s += __shfl_xor(s, 8);
            const float mu = s * (1.f / 128.f); float q = 0.f;
#pragma unroll
            for (int i = 0; i < 8; ++i) { f[i] -= mu; q += f[i] * f[i]; }
            q += __shfl_xor(q, 1); q += __shfl_xor(q, 2); q += __shfl_xor(q, 4); q += __shfl_xor(q, 8);
            const float rs = rsqrtf(q * (1.f / 128.f) + EPS);
            u32x4 w; w.x = cvt_pk_bf16(f[0] * rs * g0[0] + b0[0], f[1] * rs * g0[1] + b0[1]); w.y = cvt_pk_bf16(f[2] * rs * g0[2] + b0[2], f[3] * rs * g0[3] + b0[3]);
            w.z = cvt_pk_bf16(f[4] * rs * g1[0] + b1[0], f[5] * rs * g1[1] + b1[1]); w.w = cvt_pk_bf16(f[6] * rs * g1[2] + b1[2], f[7] * rs * g1[3] + b1[3]);
            *(LAS u32x4*)(lds + img + (row >> 6) * 16384 + v_st(row & 63, sc)) = w; }
    }
    uint4 uq[8];
#pragma unroll
    for (int i = 0; i < 8; ++i) { const int row = i * 4 + (lane >> 4), ch = lane & 15; uq[i] = *(const uint4*)(U + (size_t)(t0 + ib * 32 + row) * 1024 + h * 128 + ch * 8); }
    bf16x8 pa[2][4];
#pragma unroll
    for (int tl = 0; tl < 2; ++tl)
#pragma unroll
        for (int ks = 0; ks < 4; ++ks) pa[tl][ks] = *(const bf16x8*)(WsB + (size_t)h * 16384 + (size_t)(ib * 32 + r32) * 128 + tl * 64 + ks * 16 + hi * 8);
    asm volatile("s_waitcnt lgkmcnt(0)" ::: "memory"); __syncthreads();
    f32x16 o[4];
#pragma unroll
    for (int d = 0; d < 4; ++d) o[d] = f32x16{};
    const int vb = (int)(uintptr_t)(lds + img) + v_rd_base(lane);
#pragma unroll
    for (int tl = 0; tl < 2; ++tl) { const int vbt = vb + tl * 16384;
        pv1<0>(o[0], vbt, pa[tl][0], pa[tl][1], pa[tl][2], pa[tl][3]); pv1<1>(o[1], vbt, pa[tl][0], pa[tl][1], pa[tl][2], pa[tl][3]);
        pv1<2>(o[2], vbt, pa[tl][0], pa[tl][1], pa[tl][2], pa[tl][3]); pv1<3>(o[3], vbt, pa[tl][0], pa[tl][1], pa[tl][2], pa[tl][3]); }
    LAS bf16_t* stg = (LAS bf16_t*)(lds + 65536 + wid * 8192);
#pragma unroll
    for (int r = 0; r < 16; ++r) { const float bsv = gbs[h * 128 + ib * 32 + crow(r, hi)];
#pragma unroll
        for (int d = 0; d < 4; ++d) stg[crow(r, hi) * 128 + d * 32 + r32] = (bf16_t)f2bf(o[d][r] + bsv); }
    asm volatile("s_waitcnt lgkmcnt(0)" ::: "memory");
#pragma unroll
    for (int i = 0; i < 8; ++i) { const int row = i * 4 + (lane >> 4), ch = lane & 15; const size_t trow = (size_t)(t0 + ib * 32 + row);
        float sv[8], uv[8]; { const u32x4 q_ = *(const LAS u32x4*)(stg + row * 128 + ch * 8); uint4 q2_; q2_.x = q_[0]; q2_.y = q_[1]; q2_.z = q_[2]; q2_.w = q_[3]; unpack8(q2_, sv); } unpack8(uq[i], uv);
#pragma unroll
        for (int e = 0; e < 8; ++e) sv[e] *= uv[e];
        *(uint4*)(MIX + trow * DM + h * 128 + ch * 8) = pack8(sv); }
    asm volatile("s_waitcnt lgkmcnt(0)" ::: "memory");
}
#undef DGLDS
#undef SBAR
}

struct MkArgs { const float* in[23]; float* out; unsigned char* ws; int ph_lo, ph_hi; };
typedef const __attribute__((address_space(4))) MkArgs* kargp_t;
constexpr int RTAB_OFF = EXTRA_OFF;
constexpr int CNTL_OFF = EXTRA_OFF + 2048;
constexpr int MISC_OFF = EXTRA_OFF + 4096;

#define XB_TMO      128
#define XB_XCNT(j)  (256  + 64 * (j))
#define XB_XSUB(j)  (1280 + 64 * (j))
#define XB_XGEN(j)  (2304 + 64 * (j))
#define XB_TOP      3328
#define XB_TOPGEN   3392
#define XCD_BAR_WORDS 3456
#define XB_SPIN_CAP (1u << 18)
#ifndef MK_SETTLE2_MASK
#define MK_SETTLE2_MASK 0x6F
#endif
#define MK_REL_DELAY_DEFAULT 1
constexpr int CW_BAR = 4096;
__device__ __forceinline__ unsigned xb_ld(unsigned* p)              { return __hip_atomic_load(p, __ATOMIC_RELAXED, __HIP_MEMORY_SCOPE_AGENT); }
__device__ __forceinline__ unsigned xb_add(unsigned* p, unsigned v) { return __hip_atomic_fetch_add(p, v, __ATOMIC_RELAXED, __HIP_MEMORY_SCOPE_AGENT); }
__device__ __forceinline__ unsigned xb_xcc_id() { return (unsigned)__builtin_amdgcn_s_getreg((3 << 11) | 20) & 0xFu; }
#define XB_SPIN(cond, bar) do { unsigned _sp = 0; while (cond) { __builtin_amdgcn_s_sleep(1); \
    if ((++_sp & 255u) == 0u) { if (xb_ld(&(bar)[XB_TMO])) break; if (_sp > XB_SPIN_CAP) { atomicAdd(&(bar)[XB_TMO], 1u); break; } } } } while (0)
__device__ __forceinline__ void xcd_barrier_complete(unsigned* bar, unsigned x, unsigned& nloc, unsigned& nx) {
    const unsigned G = gridDim.x * gridDim.y * gridDim.z;
    unsigned sum, cnt, mine, sp = 0u;
    for (;;) {
        sum = 0u; cnt = 0u; mine = 0u;
#pragma unroll
        for (unsigned j = 0; j < 16; ++j) { const unsigned c = xb_ld(&bar[XB_XCNT(j)]); sum += c; cnt += (c > 0u) ? 1u : 0u; mine = (j == x) ? c : mine; }
        if (sum == G) break;
        __builtin_amdgcn_s_sleep(1);
        if ((++sp & 255u) == 0u) { if (xb_ld(&bar[XB_TMO])) break; if (sp > XB_SPIN_CAP) { atomicAdd(&bar[XB_TMO], 1u); break; } }
    }
    nloc = mine > 0u ? mine : 1u; nx = cnt > 0u ? cnt : 1u;
}
#ifndef MK_BAR_STRONG
#define MK_BAR_STRONG 0
#endif
__device__ __forceinline__ void xcd_barrier(unsigned* bar, volatile LAS unsigned* st, bool leader  , int settle = MK_REL_DELAY_DEFAULT) {
    if (MK_BAR_STRONG) __builtin_amdgcn_fence(__ATOMIC_RELEASE, "agent");
    asm volatile("s_waitcnt vmcnt(0)" ::: "memory");
    __syncthreads();
    if (leader) {
        __builtin_amdgcn_s_waitcnt(0);
#ifndef MK_EARLY_WB
#define MK_EARLY_WB 0
#endif
        if (MK_EARLY_WB) asm volatile("buffer_wbl2 sc1" ::: "memory");
        const unsigned x = xb_xcc_id();
        unsigned nloc = st[0], nx = st[1];
        if (nloc == 0u) { xcd_barrier_complete(bar, x, nloc, nx); st[0] = nloc; st[1] = nx; }
        const unsigned old = xb_add(&bar[XB_XSUB(x)], 1u);
        const unsigned gen = old / nloc;
        if (old + 1u == (gen + 1u) * nloc) {
#ifndef MK_SYS_ACQ
#define MK_SYS_ACQ 0
#endif
#ifndef MK_SYS_REL
#define MK_SYS_REL 1
#endif
            if (MK_SYS_REL) __builtin_amdgcn_fence(__ATOMIC_RELEASE, ""); else __builtin_amdgcn_fence(__ATOMIC_RELEASE, "agent");
            asm volatile("s_waitcnt vmcnt(0)" ::: "memory");
#ifndef MK_REL_DELAY
#define MK_REL_DELAY 0
#endif
            if (settle > 0) {
#pragma unroll 1
                for (int i_ = 0; i_ < settle; ++i_) __builtin_amdgcn_s_sleep(127); }
            if (MK_REL_DELAY == -1) { asm volatile("buffer_wbl2 sc1\n\ts_waitcnt vmcnt(0)" ::: "memory"); }
            if (MK_REL_DELAY == -2) __builtin_amdgcn_s_sleep(32);
            const unsigned og = xb_add(&bar[XB_TOP], 1u);
            const unsigned tg = og / nx;
            if (og + 1u == (tg + 1u) * nx) xb_add(&bar[XB_TOPGEN], 1u);
            else XB_SPIN((int)(xb_ld(&bar[XB_TOPGEN]) - (tg + 1u)) < 0, bar);
            if (MK_SYS_ACQ) __builtin_amdgcn_fence(__ATOMIC_ACQUIRE, ""); else __builtin_amdgcn_fence(__ATOMIC_ACQUIRE, "agent");
            xb_add(&bar[XB_XGEN(x)], 1u);
            asm volatile("s_waitcnt vmcnt(0)" ::: "memory");
        } else {
            XB_SPIN((int)(xb_ld(&bar[XB_XGEN(x)]) - (gen + 1u)) < 0, bar);
            if (MK_SYS_ACQ) __builtin_amdgcn_fence(__ATOMIC_ACQUIRE, ""); else __builtin_amdgcn_fence(__ATOMIC_ACQUIRE, "agent");
            asm volatile("s_waitcnt vmcnt(0)" ::: "memory");
        }
    }
    __syncthreads();
    if (MK_BAR_STRONG) { __builtin_amdgcn_fence(__ATOMIC_ACQUIRE, "agent"); asm volatile("s_waitcnt vmcnt(0)" ::: "memory"); }
}

#ifndef MK_P0_B8
#define MK_P0_B8 1
#endif
#ifndef MK_P0_W64
#define MK_P0_W64 1
#endif
constexpr int P0_SCR = MK_P0_W64 ? 16640 : 16384;
struct P0Item { const float* W; bf16_t* WT; const float* gk; int K, N, mode, k0, n0; float f8s; };
template <bool WIDE> __device__ __forceinline__ void p0_load(const P0Item& d, int lane, f32x4 (&v)[16]) {
    if constexpr (WIDE) { const int c = lane & 15, rr = lane >> 4;
#pragma unroll
        for (int i = 0; i < 16; ++i) v[i] = __builtin_nontemporal_load((const f32x4*)(d.W + (size_t)(d.k0 + (MK_P0_B8 ? 16 * (i >> 2) + 4 * rr + (i & 3) : rr + 4 * i)) * d.N + d.n0 + 4 * c));
    } else {
    const int c = lane & 7, rr = lane >> 3;
#pragma unroll
#ifndef MK_P0_NT
#define MK_P0_NT 1
#endif
    for (int i = 0; i < 8; ++i) { const f32x4* q_ = (const f32x4*)(d.W + (size_t)(d.k0 + rr + 8 * i) * d.N + d.n0 + 4 * c); v[i] = MK_P0_NT ? __builtin_nontemporal_load(q_) : *q_; }
    }
}
template <bool WIDE> __device__ __forceinline__ void p0_process(const P0Item& d, int lane, const f32x4 (&v)[16], LAS float* scr) {
    if constexpr (WIDE && MK_P0_B8) {
        const int c = lane & 15, rr = lane >> 4; LAS unsigned* t8 = (LAS unsigned*)scr;
#pragma unroll
        for (int g = 0; g < 4; ++g) { f32x4 sc = d.gk ? *(const f32x4*)(d.gk + d.k0 + 16 * g + 4 * rr) : (f32x4){1.f, 1.f, 1.f, 1.f}; sc = sc * d.f8s;
#pragma unroll
            for (int j = 0; j < 4; ++j) t8[(4 * c + j) * 17 + 4 * g + rr] = pk4_fp8(v[4 * g + 0][j] * sc[0], v[4 * g + 1][j] * sc[1], v[4 * g + 2][j] * sc[2], v[4 * g + 3][j] * sc[3]); }
        LDS_WAIT(); asm volatile("" ::: "memory");
        const int c4 = lane >> 4, nl = lane & 15;
#pragma unroll
        for (int j = 0; j < 4; ++j) { const int n = nl + 16 * j; const LAS unsigned* s8 = t8 + n * 17 + 4 * c4; u32x4 o; o.x = s8[0]; o.y = s8[1]; o.z = s8[2]; o.w = s8[3];
            *(u32x4*)((unsigned char*)d.WT + (size_t)map_row(d.mode, d.n0 + n) * d.K + d.k0 + 16 * c4) = o; }
        LDS_WAIT(); asm volatile("" ::: "memory");
    } else if constexpr (WIDE) {
        { const int c = lane & 15, rr = lane >> 4;
#pragma unroll
          for (int i = 0; i < 16; ++i) { LAS float* q = scr + (rr + 4 * i) * 65 + 4 * c; q[0] = v[i][0]; q[1] = v[i][1]; q[2] = v[i][2]; q[3] = v[i][3]; } }
        LDS_WAIT(); asm volatile("" ::: "memory");
        const int c4 = lane & 3, nl = lane >> 2; f32x4 g[4];
#pragma unroll
        for (int q = 0; q < 4; ++q) { g[q] = d.gk ? *(const f32x4*)(d.gk + d.k0 + 16 * c4 + 4 * q) : (f32x4){1.f, 1.f, 1.f, 1.f}; g[q] = g[q] * d.f8s; }
#pragma unroll
        for (int j = 0; j < 4; ++j) { const int n = nl + 16 * j; const LAS float* s = scr + (16 * c4) * 65 + n; u32x4 o;
            o.x = pk4_fp8(s[0 * 65] * g[0][0], s[1 * 65] * g[0][1], s[2 * 65] * g[0][2], s[3 * 65] * g[0][3]); o.y = pk4_fp8(s[4 * 65] * g[1][0], s[5 * 65] * g[1][1], s[6 * 65] * g[1][2], s[7 * 65] * g[1][3]);
            o.z = pk4_fp8(s[8 * 65] * g[2][0], s[9 * 65] * g[2][1], s[10 * 65] * g[2][2], s[11 * 65] * g[2][3]); o.w = pk4_fp8(s[12 * 65] * g[3][0], s[13 * 65] * g[3][1], s[14 * 65] * g[3][2], s[15 * 65] * g[3][3]);
            *(u32x4*)((unsigned char*)d.WT + (size_t)map_row(d.mode, d.n0 + n) * d.K + d.k0 + 16 * c4) = o; }
        LDS_WAIT(); asm volatile("" ::: "memory");
    } else {
    const int c = lane & 7, rr = lane >> 3;
#pragma unroll
    for (int i = 0; i < 8; ++i) { LAS float* q = scr + (rr + 8 * i) * 33 + 4 * c; q[0] = v[i][0]; q[1] = v[i][1]; q[2] = v[i][2]; q[3] = v[i][3]; }
    LDS_WAIT(); asm volatile("" ::: "memory");
    if (d.f8s != 0.f) {
        const int c4 = lane & 3, nl = lane >> 2; f32x4 g[4];
#pragma unroll
        for (int q = 0; q < 4; ++q) { g[q] = d.gk ? *(const f32x4*)(d.gk + d.k0 + 16 * c4 + 4 * q) : (f32x4){1.f, 1.f, 1.f, 1.f}; g[q] = g[q] * d.f8s; }
#pragma unroll
        for (int j = 0; j < 2; ++j) { const int n = nl + 16 * j; const LAS float* s = scr + (16 * c4) * 33 + n; u32x4 o;
            o.x = pk4_fp8(s[0 * 33] * g[0][0], s[1 * 33] * g[0][1], s[2 * 33] * g[0][2], s[3 * 33] * g[0][3]); o.y = pk4_fp8(s[4 * 33] * g[1][0], s[5 * 33] * g[1][1], s[6 * 33] * g[1][2], s[7 * 33] * g[1][3]);
            o.z = pk4_fp8(s[8 * 33] * g[2][0], s[9 * 33] * g[2][1], s[10 * 33] * g[2][2], s[11 * 33] * g[2][3]); o.w = pk4_fp8(s[12 * 33] * g[3][0], s[13 * 33] * g[3][1], s[14 * 33] * g[3][2], s[15 * 33] * g[3][3]);
            *(u32x4*)((unsigned char*)d.WT + (size_t)map_row(d.mode, d.n0 + n) * d.K + d.k0 + 16 * c4) = o;
#if MK_ST2
            asm volatile("" ::: "memory"); __builtin_nontemporal_store(o, (u32x4*)((unsigned char*)d.WT + (size_t)map_row(d.mode, d.n0 + n) * d.K + d.k0 + 16 * c4));
#endif
            }
    } else {
        f32x4 g0 = {1.f, 1.f, 1.f, 1.f}, g1 = g0;
        if (d.gk) { g0 = *(const f32x4*)(d.gk + d.k0 + 8 * c); g1 = *(const f32x4*)(d.gk + d.k0 + 8 * c + 4); }
#pragma unroll
        for (int j = 0; j < 4; ++j) { const int n = rr + 8 * j; const LAS float* s = scr + (8 * c) * 33 + n;
            u32x4 o; o.x = pk2(s[0 * 33] * g0[0], s[1 * 33] * g0[1]); o.y = pk2(s[2 * 33] * g0[2], s[3 * 33] * g0[3]); o.z = pk2(s[4 * 33] * g1[0], s[5 * 33] * g1[1]); o.w = pk2(s[6 * 33] * g1[2], s[7 * 33] * g1[3]);
            *(u32x4*)(d.WT + (size_t)map_row(d.mode, d.n0 + n) * d.K + d.k0 + 8 * c) = o; }
    }
    LDS_WAIT(); asm volatile("" ::: "memory");
    }
}

constexpr int P0_I_IN = (DM / 64) * (INW / 32), P0_I_OUT = (DM / 64) * (DM / 32), P0_XW = (MK_F8 && MK_P0_W64) ? 64 : 32, P0_I_G = (DM / 64) * (DE / P0_XW), P0_I_D = (DE / 64) * (DM / P0_XW);
constexpr int P0_DENSE = P0_I_IN + P0_I_OUT, P0_EXPERT = NE * (2 * P0_I_G + P0_I_D), P0_NITEMS = P0_DENSE + P0_EXPERT;
struct P0Dec {
    const float *w_in, *attn_g, *w_out, *ffn_g, *wgate, *wup, *wdown; unsigned char* ws;
    __device__ __forceinline__ void operator()(int it, P0Item& d) const {
        int r = it; int item; bf16_t* Wgu = (bf16_t*)(ws + WS_WGU); bf16_t* Wd = (bf16_t*)(ws + WS_WD);
        d.f8s = 0.f;
        if (r < P0_I_IN) { d.W = w_in; d.WT = (bf16_t*)(ws + WS_WIN); d.gk = attn_g; d.K = DM; d.N = INW; d.mode = 1; item = r; if (MK_F8_P1) d.f8s = F8_SWI; }
        else if ((r -= P0_I_IN) < P0_I_OUT) { d.W = w_out; d.WT = (bf16_t*)(ws + WS_WOUT); d.gk = nullptr; d.K = DM; d.N = DM; d.mode = 0; item = r; }
        else { r -= P0_I_OUT; const int e = r / (2 * P0_I_G + P0_I_D); r -= e * (2 * P0_I_G + P0_I_D);
            const size_t egu = MK_F8 ? (size_t)e * 2048 * 2048 / 2 : (size_t)e * 2048 * 2048, ed = MK_F8 ? (size_t)e * 2048 * 1024 / 2 : (size_t)e * 2048 * 1024;
            if (r < P0_I_G) { d.W = wgate + (size_t)e * DM * DE; d.WT = Wgu + egu; d.gk = ffn_g; d.K = DM; d.N = DE; d.mode = 2; item = r; if (MK_F8) d.f8s = F8_SW; }
            else if ((r -= P0_I_G) < P0_I_G) { d.W = wup + (size_t)e * DM * DE; d.WT = Wgu + egu; d.gk = ffn_g; d.K = DM; d.N = DE; d.mode = 3; item = r; if (MK_F8) d.f8s = F8_SW; }
            else { r -= P0_I_G; d.W = wdown + (size_t)e * DE * DM; d.WT = Wd + ed; d.gk = nullptr; d.K = DE; d.N = DM; d.mode = 0; item = r; if (MK_F8) d.f8s = F8_SD; } }
        const int wn = (MK_P0_W64 && d.f8s != 0.f) ? 64 : 32, nblk = d.N / wn; d.k0 = 64 * (item / nblk); d.n0 = wn * (item % nblk);
    }
};
#ifndef MK_ST2
#define MK_ST2 0
#endif
#ifndef MK_P0_AHEAD
#define MK_P0_AHEAD 2
#endif
template <bool WIDE> __device__ __forceinline__ void p0_run(const P0Dec& decode, int it0, int stride, int itEnd, int lane, LAS float* scr) {
#if MK_P0_AHEAD == 4
    f32x4 v0[16], v1[16], v2[16], v3[16], v4[16];
    int it = it0;
#define P0_LD(OFF, VN) { if (it + (OFF) * stride < itEnd) { P0Item dl; decode(it + (OFF) * stride, dl); p0_load<WIDE>(dl, lane, VN); } }
    P0_LD(0, v0) P0_LD(1, v1) P0_LD(2, v2) P0_LD(3, v3)
#define P0_STEP(VN, VC) { P0_LD(4, VN) { P0Item dp; decode(it, dp); p0_process<WIDE>(dp, lane, VC, scr); } it += stride; if (it >= itEnd) break; }
    while (it < itEnd) {
        P0_STEP(v4, v0) P0_STEP(v0, v1) P0_STEP(v1, v2) P0_STEP(v2, v3) P0_STEP(v3, v4)
    }
#undef P0_STEP
#undef P0_LD
#else
    f32x4 v0[16], v1[16];
    int it = it0;
#define P0_LD(OFF, VN) { if (it + (OFF) * stride < itEnd) { P0Item dl; decode(it + (OFF) * stride, dl); p0_load<WIDE>(dl, lane, VN); } }
    P0_LD(0, v0)
#define P0_STEP(VN, VC) { P0_LD(1, VN) { P0Item dp; decode(it, dp); p0_process<WIDE>(dp, lane, VC, scr); } it += stride; if (it >= itEnd) break; }
    while (it < itEnd) {
        P0_STEP(v1, v0) P0_STEP(v0, v1)
    }
#undef P0_STEP
#undef P0_LD
#endif
}
#ifndef MK_XROW
#define MK_XROW 0
#endif
constexpr int XS_PER_E = 64 + 64 + 64, XS_TOTAL = NE * XS_PER_E;
struct XSItem { const float* W; unsigned char* WT; const float* gk; int K, N, mode, k0, n0; float f8s; };
struct XSDec {
    const float *ffn_g, *wgate, *wup, *wdown; unsigned char* ws;
    __device__ __forceinline__ void operator()(int si, XSItem& d) const {
        const int e = si / XS_PER_E; int r = si - e * XS_PER_E;
        unsigned char* Wgu = ws + WS_WGU + (size_t)e * 2048 * 2048; unsigned char* Wd = ws + WS_WD + (size_t)e * 2048 * 1024;
        if (r < 64) { d.W = wgate + (size_t)e * DM * DE; d.WT = Wgu; d.gk = ffn_g; d.K = DM; d.N = DE; d.mode = 2; d.f8s = F8_SW; d.n0 = (r >> 4) * 256; d.k0 = (r & 15) * 128; }
        else if (r < 128) { r -= 64; d.W = wup + (size_t)e * DM * DE; d.WT = Wgu; d.gk = ffn_g; d.K = DM; d.N = DE; d.mode = 3; d.f8s = F8_SW; d.n0 = (r >> 4) * 256; d.k0 = (r & 15) * 128; }
        else { r -= 128; d.W = wdown + (size_t)e * DE * DM; d.WT = Wd; d.gk = nullptr; d.K = DE; d.N = DM; d.mode = 0; d.f8s = F8_SD; d.n0 = (r >> 3) * 256; d.k0 = (r & 7) * 128; }
    }
};
__device__ __forceinline__ void xs_load(const XSItem& d, int j, int lane, f32x4 (&v)[16]) {
    const f32x4* src = (const f32x4*)(d.W + (size_t)(d.k0 + 16 * j) * d.N + d.n0) + lane;
#pragma unroll
    for (int i = 0; i < 16; ++i) v[i] = __builtin_nontemporal_load(src + (size_t)i * (d.N / 4));
}
__device__ __forceinline__ void xs_process(const XSItem& d, int j, int lane, const f32x4 (&v)[16], LAS float* scr) {
#pragma unroll
    for (int i = 0; i < 16; ++i) *(LAS f32x4*)(scr + i * 256 + 4 * lane) = v[i];
    LDS_WAIT(); asm volatile("" ::: "memory");
    const int k = d.k0 + 16 * j; float g[16];
#pragma unroll
    for (int i = 0; i < 16; ++i) g[i] = d.gk ? d.gk[k + i] * d.f8s : d.f8s;
#pragma unroll
    for (int q = 0; q < 4; ++q) { const int n = lane + 64 * q; const LAS float* s = scr + n; u32x4 o;
        o.x = pk4_fp8(s[0 * 256] * g[0], s[1 * 256] * g[1], s[2 * 256] * g[2], s[3 * 256] * g[3]); o.y = pk4_fp8(s[4 * 256] * g[4], s[5 * 256] * g[5], s[6 * 256] * g[6], s[7 * 256] * g[7]);
        o.z = pk4_fp8(s[8 * 256] * g[8], s[9 * 256] * g[9], s[10 * 256] * g[10], s[11 * 256] * g[11]); o.w = pk4_fp8(s[12 * 256] * g[12], s[13 * 256] * g[13], s[14 * 256] * g[14], s[15 * 256] * g[15]);
        *(u32x4*)(d.WT + (size_t)map_row(d.mode, d.n0 + n) * d.K + k) = o; }
    LDS_WAIT(); asm volatile("" ::: "memory");
}
__device__ __forceinline__ void xs_run(const XSDec& decode, int it0, int stride, int itEnd, int lane, LAS float* scr) {
    const int nsup = it0 < itEnd ? (itEnd - 1 - it0) / stride + 1 : 0, nf = nsup * 8;
    XSItem d, dn; f32x4 va[16], vb[16];
    if (nf > 0) { decode(it0, d); xs_load(d, 0, lane, va); }
#pragma unroll 1
    for (int f = 0; f < nf; f += 2) {
        xs_load(d, (f + 1) & 7, lane, vb);
        xs_process(d, f & 7, lane, va, scr);
        dn = d;
        if (f + 2 < nf) { if (((f + 2) & 7) == 0) decode(it0 + ((f + 2) >> 3) * stride, dn); xs_load(dn, (f + 2) & 7, lane, va); }
        xs_process(d, (f + 1) & 7, lane, vb, scr);
        d = dn;
    }
}
#ifndef MK_XCONV
#define MK_XCONV 1
#endif

#ifndef MK_POISON_CHECK
#define MK_POISON_CHECK 0
#endif
#ifndef MK_P4_PAD
#define MK_P4_PAD 0
#endif
#ifndef MK_XN_FIRST
#define MK_XN_FIRST 1
#endif
#ifndef MK_XN16
#define MK_XN16 0
#endif
#ifndef MK_DETSLOT
#define MK_DETSLOT 0
#endif
#ifndef MK_REP
#define MK_REP -1
#endif
#define REPS(k) ((MK_REP == (k)) ? 2 : 1)
#ifndef MK_PROBE
#define MK_PROBE -1
#endif
#ifndef MK_USE_CG
#define MK_USE_CG 0
#endif
#define PHASE_VARS() kargp_t ap = (kargp_t)__builtin_amdgcn_kernarg_segment_ptr(); asm volatile("" : "+s"(ap)); \
    int tid = mk_tid(lds); asm volatile("" : "+v"(tid)); const int lane = tid & 63, wave = __builtin_amdgcn_readfirstlane(tid >> 6); \
    const int G = gridDim.x, vcu = (blockIdx.x % 8) * (G / 8) + blockIdx.x / 8; unsigned char* ws = ap->ws; (void)lane; (void)wave; (void)vcu; (void)ws

__global__ void __launch_bounds__(NTHR, 2) mk_fwd(MkArgs args) {
    extern __shared__ __attribute__((aligned(16))) unsigned char lds_raw[];
    LAS unsigned char* const lds = (LAS unsigned char*)lds_raw;
    const int lo = args.ph_lo, hi = args.ph_hi;
    {
        const int t0_ = threadIdx.x; if (t0_ < 32) ((LAS unsigned*)(lds + MISC_OFF))[t0_] = 0u;
        if ((t0_ & 63) == 0) ((volatile LAS unsigned char*)(lds + WTAB_OFF))[mk_hwslot()] = (unsigned char)(t0_ >> 6);
        __syncthreads(); }
    if (hi - lo > 1 && mk_tid(lds) == 0) (void)xb_add((unsigned*)(args.ws + WS_CTL) + CW_BAR + XB_XCNT(xb_xcc_id()), 1u);
#define IN(k) (lo <= (k) && (k) < hi)
#define STAMP(i) do { if (MK_PROBE >= 0 && blockIdx.x == 0 && mk_tid(lds) == 0) __hip_atomic_store((unsigned long long*)(args.ws + WS_LAM + 1024) + (i), __builtin_amdgcn_s_memrealtime(), __ATOMIC_RELAXED, __HIP_MEMORY_SCOPE_AGENT); } while (0)
    STAMP(0);
#ifndef MK_GAP_SEAM
#define MK_GAP_SEAM -1
#endif
#ifndef MK_GAP_POS
#define MK_GAP_POS 1
#endif
#define MK_GAP() do { _Pragma("unroll 1") for (int g_ = 0; g_ < 80; ++g_) __builtin_amdgcn_s_sleep(127); } while (0)
#define SEAM_XCD(k) do { if (IN(k) && IN((k) + 1)) { kargp_t ap_ = (kargp_t)__builtin_amdgcn_kernarg_segment_ptr(); asm volatile("" : "+s"(ap_)); if ((k) == MK_GAP_SEAM && MK_GAP_POS == 0) MK_GAP(); \
        for (int sr_ = 0; sr_ < REPS(9); ++sr_) xcd_barrier((unsigned*)(ap_->ws + WS_CTL) + CW_BAR, (volatile LAS unsigned*)(lds + MISC_OFF) + 8, mk_tid(lds) == 0, MK_REL_DELAY * (((MK_SETTLE2_MASK >> (k)) & 1) ? 2 : 1)); if ((k) == MK_GAP_SEAM && MK_GAP_POS == 1) MK_GAP(); } } while (0)

    if (IN(0)) for (int rep_ = 0; rep_ < REPS(0); ++rep_) {
        PHASE_VARS();
        const int gw = vcu * NWAVES + wave, NGW = G * NWAVES, gtid = blockIdx.x * NTHR + tid, NGT = G * NTHR;
        const float* ffn_g = ap->in[15];
        LAS float* scr = (LAS float*)(lds + wave * P0_SCR);
        const P0Dec dec{ap->in[2], ap->in[1], ap->in[14], ffn_g, ap->in[20], ap->in[21], ap->in[22], ws};
        static_assert(!(MK_P0_W64 && MK_F8) || MK_XCONV, "wide fp8 items need the expert conversion outside the prologue");
        if (!MK_XN_FIRST) p0_run<false>(dec, gw, NGW, (MK_XCONV || (MK_XROW && MK_F8)) ? P0_DENSE : P0_NITEMS, lane, scr);
        if (MK_XROW && MK_F8 && !MK_XCONV) { const XSDec xdec{ffn_g, ap->in[20], ap->in[21], ap->in[22], ws}; xs_run(xdec, gw, NGW, XS_TOTAL, lane, scr); }
        float2* rope = (float2*)(ws + WS_ROPE); bf16_t* WsB = (bf16_t*)(ws + WS_WSB);
        for (int i = gtid; i < 4096 * 8; i += NGT) { const int pos = i >> 3, f = i & 7; const float inv = 1.0f / powf(500000.0f, (float)(2 * f) / 16.0f); const float ang = (float)pos * inv; rope[i] = make_float2(cosf(ang), sinf(ang)); }
        { const float* wgrp = ap->in[16]; const float* wrt = ap->in[18]; bf16_t* WrH = (bf16_t*)(ws + WS_WRH); bf16_t* WrL = WrH + 48 * 2048;
          for (int i = gtid; i < 48 * 2048; i += NGT) { const int c = i / 2048, k = i % 2048; float w = 0.f; if (c < 36) w = (c < 4 ? wgrp[k * 4 + c] : wrt[k * 32 + (c - 4)]) * ffn_g[k];
              const unsigned hb = f2bf(w); WrH[i] = (bf16_t)hb; WrL[i] = (bf16_t)f2bf(w - bf2f(hb)); } }
        { const float* gws = ap->in[5]; for (int i = gtid; i < 8 * 128 * 128; i += NGT) WsB[i] = (bf16_t)f2bf(gws[i]); }
        if (gtid == 0) { float a = 0.f, b = 0.f; for (int i = 0; i < 64; ++i) { a += ap->in[9][i] * ap->in[10][i]; b += ap->in[11][i] * ap->in[12][i]; } ((float*)(ws + WS_LAM))[0] = expf(a) - expf(b) + 0.2f; }
        const float* x = ap->in[0]; bf16_t* XN = (bf16_t*)(ws + WS_XN);
        for (int m = gw; m < T; m += NGW) {
#if MK_XN16
            const f32x4* xr = (const f32x4*)(x + (size_t)m * DM) + 2 * lane; f32x4 v[8]; float s = 0.f;
#pragma unroll
            for (int j = 0; j < 4; ++j) { v[2 * j] = xr[128 * j]; v[2 * j + 1] = xr[128 * j + 1]; }
#pragma unroll
            for (int j = 0; j < 8; ++j) s += (v[j][0] * v[j][0] + v[j][1] * v[j][1]) + (v[j][2] * v[j][2] + v[j][3] * v[j][3]);
            const float rs = rsqrtf(wave_sum(s) * (1.f / DM) + EPS);
            if (MK_F8_P1) { u32x2* o4 = (u32x2*)((unsigned char*)XN + (size_t)m * DM) + lane; const float r8 = rs * F8_SXN;
#pragma unroll
                for (int j = 0; j < 4; ++j) { u32x2 w; w.x = pk4_fp8(v[2 * j][0] * r8, v[2 * j][1] * r8, v[2 * j][2] * r8, v[2 * j][3] * r8); w.y = pk4_fp8(v[2 * j + 1][0] * r8, v[2 * j + 1][1] * r8, v[2 * j + 1][2] * r8, v[2 * j + 1][3] * r8); o4[64 * j] = w; }
            } else {
            u32x4* o16 = (u32x4*)(XN + (size_t)m * DM) + lane;
#pragma unroll
            for (int j = 0; j < 4; ++j) { u32x4 w; w.x = pk2(v[2 * j][0] * rs, v[2 * j][1] * rs); w.y = pk2(v[2 * j][2] * rs, v[2 * j][3] * rs); w.z = pk2(v[2 * j + 1][0] * rs, v[2 * j + 1][1] * rs); w.w = pk2(v[2 * j + 1][2] * rs, v[2 * j + 1][3] * rs); o16[64 * j] = w; } }
#else
            const f32x4* xr = (const f32x4*)(x + (size_t)m * DM) + lane; f32x4 v[8]; float s = 0.f;
#pragma unroll
            for (int j = 0; j < 8; ++j) { v[j] = xr[64 * j]; s += (v[j][0] * v[j][0] + v[j][1] * v[j][1]) + (v[j][2] * v[j][2] + v[j][3] * v[j][3]); }
            const float rs = rsqrtf(wave_sum(s) * (1.f / DM) + EPS);
            u32x2* o8 = (u32x2*)(XN + (size_t)m * DM) + lane;
#pragma unroll
            for (int j = 0; j < 8; ++j) { u32x2 w; w.x = pk2(v[j][0] * rs, v[j][1] * rs); w.y = pk2(v[j][2] * rs, v[j][3] * rs); o8[64 * j] = w; }
#endif
        }
        if (MK_XN_FIRST) p0_run<false>(dec, gw, NGW, (MK_XCONV || (MK_XROW && MK_F8)) ? P0_DENSE : P0_NITEMS, lane, scr);
    }
#if MK_USE_CG
    if (IN(0) && IN(1)) cg::this_grid().sync();
#else
    SEAM_XCD(0);
#endif
    STAMP(1);
    if (IN(1)) {
        PHASE_VARS();
        pg8::StaticOrder S; S.init(ws + WS_XN, ws + WS_WIN, T, INW, DM, G, (int)blockIdx.x, MK_F8_P1 ? 1 : 2);
        pg8::EpiG1 E{(bf16_t*)(ws + WS_U), ap->in[7], ap->in[8], (const float2*)(ws + WS_ROPE)};
        for (int rep_ = 0; rep_ < REPS(1); ++rep_) pg8::gemm_phase<pg8::EpiG1, pg8::StaticOrder, true, MK_F8_P1 != 0>(lds, (LAS unsigned*)(lds + RTAB_OFF), DM, S, E);
    }
    SEAM_XCD(1);
    STAMP(2);
    if (IN(2)) {
        PHASE_VARS();
        bf16_t* U = (bf16_t*)(ws + WS_U); bf16_t* VG = U + (size_t)T * 1024; bf16_t* QN = VG + (size_t)T * 1024; bf16_t* KN = QN + (size_t)T * 1024; bf16_t* VB = KN + (size_t)T * 1024;
        bf16_t* MIX = (bf16_t*)(ws + WS_MIX);
        {
            const float* subg = ap->in[13]; const float lamv = ((const float*)(ws + WS_LAM))[0];
            const P0Dec dec{ap->in[2], ap->in[1], ap->in[14], ap->in[15], ap->in[20], ap->in[21], ap->in[22], ws};
            const int gw = vcu * NWAVES + wave, NGW = G * NWAVES, cls = vcu & 1; LAS float* scr = (LAS float*)(lds + wave * P0_SCR);
            constexpr int PER_WAVE = (P0_EXPERT + 2047) / 2048, HALFW = (PER_WAVE + 1) / 2;
#define XS_CHUNK(r) do { kargp_t aq = (kargp_t)__builtin_amdgcn_kernarg_segment_ptr(); asm volatile("" : "+s"(aq)); const XSDec xdec{aq->in[15], aq->in[20], aq->in[21], aq->in[22], aq->ws}; \
                const int t_ = mk_tid(lds), gw_ = ((blockIdx.x % 8) * (gridDim.x / 8) + blockIdx.x / 8) * NWAVES + (t_ >> 6), ngw_ = gridDim.x * NWAVES, xper = (XS_TOTAL + ngw_ - 1) / ngw_, xh = (xper + 1) / 2; \
                const int x0 = gw_ + ((r) == 0 ? 0 : xh) * ngw_, x1 = (r) == 0 ? (xh * ngw_ < XS_TOTAL ? xh * ngw_ : XS_TOTAL) : XS_TOTAL; \
                xs_run(xdec, x0, ngw_, x1, t_ & 63, (LAS float*)(lds + (t_ >> 6) * P0_SCR)); } while (0)
#define P0_CHUNK(r) do { kargp_t aq = (kargp_t)__builtin_amdgcn_kernarg_segment_ptr(); asm volatile("" : "+s"(aq)); const P0Dec dq{aq->in[2], aq->in[1], aq->in[14], aq->in[15], aq->in[20], aq->in[21], aq->in[22], aq->ws}; \
                const int t_ = mk_tid(lds), gw_ = ((blockIdx.x % 8) * (gridDim.x / 8) + blockIdx.x / 8) * NWAVES + (t_ >> 6), ngw_ = gridDim.x * NWAVES; \
                const int c0_ = P0_DENSE + gw_ + ((r) * HALFW) * ngw_, c1_ = P0_DENSE + gw_ + (((r) + 1) * HALFW < PER_WAVE ? ((r) + 1) * HALFW : PER_WAVE) * ngw_; \
                p0_run<(MK_P0_W64 && MK_F8)>(dq, c0_, ngw_, c1_ < P0_NITEMS ? c1_ : P0_NITEMS, t_ & 63, (LAS float*)(lds + (t_ >> 6) * P0_SCR)); } while (0)
#ifndef MK_XCLS
#define MK_XCLS 3
#endif
#define P0_ALL() do { kargp_t aq = (kargp_t)__builtin_amdgcn_kernarg_segment_ptr(); asm volatile("" : "+s"(aq)); const P0Dec dq{aq->in[2], aq->in[1], aq->in[14], aq->in[15], aq->in[20], aq->in[21], aq->in[22], aq->ws}; \
                const int t_ = mk_tid(lds), gw_ = ((blockIdx.x % 8) * (gridDim.x / 8) + blockIdx.x / 8) * NWAVES + (t_ >> 6), ngw_ = gridDim.x * NWAVES; \
                p0_run<(MK_P0_W64 && MK_F8)>(dq, P0_DENSE + gw_, ngw_, P0_NITEMS, t_ & 63, (LAS float*)(lds + (t_ >> 6) * P0_SCR)); } while (0)
            __syncthreads();
            int rnd = 0;
            if (MK_XCLS == 3) {
                const int cls3 = vcu % 3; bool conv_done = !MK_XCONV;
                for (int rep_ = 0; rep_ < REPS(21); ++rep_) for (int un = vcu; un < NB * 8 * 16; un += G, ++rnd) { const int bh = un >> 4, qb = un & 15;
                    if (!conv_done && cls3 == rnd) { __syncthreads(); for (int rc_ = 0; rc_ < REPS(22); ++rc_) P0_ALL(); __syncthreads(); conv_done = true; }
                    dattn::attn_unit(lds, bh >> 3, bh & 7, qb, QN, KN, VB, MIX, subg, lamv);
                }
                if (!conv_done) { __syncthreads(); for (int rc_ = 0; rc_ < REPS(22); ++rc_) P0_ALL(); __syncthreads(); }
            } else {
            for (int rep_ = 0; rep_ < REPS(21); ++rep_) for (int un = vcu; un < NB * 8 * 16; un += G, ++rnd) { const int bh = un >> 4, qb = un & 15;
                const int c0 = P0_DENSE + gw + (rnd * HALFW) * NGW, c1 = P0_DENSE + gw + ((rnd + 1) * HALFW < PER_WAVE ? (rnd + 1) * HALFW : PER_WAVE) * NGW;
                if (MK_XCONV && cls == 0 && rnd < 2 && rep_ == 0) { __syncthreads(); if (MK_XROW && MK_F8) XS_CHUNK(rnd); else { for (int rc_ = 0; rc_ < REPS(22); ++rc_) P0_CHUNK(rnd); } __syncthreads(); }
                dattn::attn_unit(lds, bh >> 3, bh & 7, qb, QN, KN, VB, MIX, subg, lamv);
                if (MK_XCONV && cls == 1 && rnd < 2 && rep_ == 0) { __syncthreads(); if (MK_XROW && MK_F8) XS_CHUNK(rnd); else { for (int rc_ = 0; rc_ < REPS(22); ++rc_) P0_CHUNK(rnd); } __syncthreads(); }
            }
            }
        }
        {
            kargp_t ag = (kargp_t)__builtin_amdgcn_kernarg_segment_ptr(); asm volatile("" : "+s"(ag));
            const bf16_t* WsB = (const bf16_t*)(ag->ws + WS_WSB); bf16_t* U2 = (bf16_t*)(ag->ws + WS_U); bf16_t* VG2 = U2 + (size_t)T * 1024; bf16_t* MIX2 = (bf16_t*)(ag->ws + WS_MIX);
            __syncthreads();
            for (int pr = blockIdx.x; pr < (NB * 32 * 8 / 2) * REPS(20); pr += gridDim.x) dattn::gmlp_pair(lds, pr & (NB * 32 * 8 / 2 - 1), U2, VG2, WsB, ag->in[3], ag->in[4], ag->in[6], MIX2);
        }
    }
    SEAM_XCD(2);
    STAMP(3);
    if (IN(3)) {
        PHASE_VARS();
        pg8::StaticOrder S; S.init(ws + WS_MIX, ws + WS_WOUT, T, DM, DM, G, (int)blockIdx.x);
        pg8::EpiG2 E{ap->in[0], ap->out, (bf16_t*)(ws + WS_XN), 0};
#ifndef MK_REPNS
#define MK_REPNS 0
#endif
        for (int rep_ = 0; rep_ < REPS(3); ++rep_) { if (MK_REPNS) { int sk = rep_ * MK_REPNS; asm volatile("" : "+s"(sk)); E.skip = sk; } pg8::gemm_phase<pg8::EpiG2, pg8::StaticOrder, true>(lds, (LAS unsigned*)(lds + RTAB_OFF), DM, S, E); }
    }
#ifndef MK_DELAY3
#define MK_DELAY3 0
#endif
    if (MK_DELAY3) {
#pragma unroll 1
        for (int i_ = 0; i_ < MK_DELAY3; ++i_) __builtin_amdgcn_s_sleep(127); }
    SEAM_XCD(3);
    STAMP(4);
    if (IN(4)) {
        PHASE_VARS();
        const float* out = ap->out; const bf16_t* WrH = (const bf16_t*)(ws + WS_WRH); const bf16_t* WrL = WrH + 48 * 2048; const float* bgrp = ap->in[17]; const float* brt = ap->in[19];
        unsigned* cnt = (unsigned*)(ws + WS_CTL); int2* list = (int2*)(ws + MK_WS_LIST); int4* rec = (int4*)(ws + WS_REC);
        LAS float* part = (LAS float*)lds;
        const int mt = wave & 3, kh = wave >> 2, row = lane & 15, kq = lane >> 4;
        for (int rp_ = 0; rp_ < REPS(4); ++rp_) for (int un = blockIdx.x; un < T / 64; un += G) {
            const int t0 = un * 64 + mt * 16;
            const float* xr = out + (size_t)(t0 + row) * DM + kh * 1024 + kq * 8;
            const bf16_t* wh = WrH + (size_t)row * 2048 + kh * 1024 + kq * 8; const bf16_t* wl = WrL + (size_t)row * 2048 + kh * 1024 + kq * 8;
            f32x4 acc[3]; float ss = 0.f;
#pragma unroll
            for (int n = 0; n < 3; ++n) acc[n] = (f32x4){0.f, 0.f, 0.f, 0.f};
            bf16x8 bhA[2][3], blA[2][3], bhB[2][3], blB[2][3]; f32x4 xA[2][2], xB[2][2];
#define P4_LOAD(BH, BL, X, KS) do { _Pragma("unroll") for (int u = 0; u < 2; ++u) { _Pragma("unroll") for (int n = 0; n < 3; ++n) { BH[u][n] = *(const bf16x8*)(wh + (size_t)n * 16 * 2048 + ((KS) + u) * 32); BL[u][n] = *(const bf16x8*)(wl + (size_t)n * 16 * 2048 + ((KS) + u) * 32); } \
                    X[u][0] = *(const f32x4*)(xr + ((KS) + u) * 32); X[u][1] = *(const f32x4*)(xr + ((KS) + u) * 32 + 4); } } while (0)
#define P4_COMP(BH, BL, X) do { _Pragma("unroll") for (int u = 0; u < 2; ++u) { const f32x4 x0 = X[u][0], x1 = X[u][1]; \
                    ss += (x0[0] * x0[0] + x0[1] * x0[1]) + (x0[2] * x0[2] + x0[3] * x0[3]) + (x1[0] * x1[0] + x1[1] * x1[1]) + (x1[2] * x1[2] + x1[3] * x1[3]); \
                    u32x4 hp, lp; \
                    hp.x = cvt_pk_bf16(x0[0], x0[1]); hp.y = cvt_pk_bf16(x0[2], x0[3]); hp.z = cvt_pk_bf16(x1[0], x1[1]); hp.w = cvt_pk_bf16(x1[2], x1[3]); \
                    lp.x = cvt_pk_bf16(x0[0] - bf2f(hp.x & 0xffffu), x0[1] - bf2f(hp.x >> 16)); lp.y = cvt_pk_bf16(x0[2] - bf2f(hp.y & 0xffffu), x0[3] - bf2f(hp.y >> 16)); \
                    lp.z = cvt_pk_bf16(x1[0] - bf2f(hp.z & 0xffffu), x1[1] - bf2f(hp.z >> 16)); lp.w = cvt_pk_bf16(x1[2] - bf2f(hp.w & 0xffffu), x1[3] - bf2f(hp.w >> 16)); \
                    const bf16x8 ah = __builtin_bit_cast(bf16x8, hp), al = __builtin_bit_cast(bf16x8, lp); \
                    if (MK_P4_PAD) { __builtin_amdgcn_sched_barrier(0); asm volatile("s_nop 7" ::: "memory"); __builtin_amdgcn_sched_barrier(0); } \
                    _Pragma("unroll") for (int n = 0; n < 3; ++n) { \
                        acc[n] = __builtin_amdgcn_mfma_f32_16x16x32_bf16(ah, BH[u][n], acc[n], 0, 0, 0); acc[n] = __builtin_amdgcn_mfma_f32_16x16x32_bf16(al, BH[u][n], acc[n], 0, 0, 0); acc[n] = __builtin_amdgcn_mfma_f32_16x16x32_bf16(ah, BL[u][n], acc[n], 0, 0, 0); } \
                    if (MK_P4_PAD) { __builtin_amdgcn_sched_barrier(0); asm volatile("s_nop 15\n\ts_nop 15\n\ts_nop 15" ::: "memory"); __builtin_amdgcn_sched_barrier(0); } } } while (0)
            P4_LOAD(bhA, blA, xA, 0);
#pragma unroll 1
            for (int ks = 0; ks < 32; ks += 4) {
                P4_LOAD(bhB, blB, xB, ks + 2);
                __builtin_amdgcn_sched_barrier(0);
                P4_COMP(bhA, blA, xA);
                __builtin_amdgcn_sched_barrier(0);
                if (ks + 4 < 32) P4_LOAD(bhA, blA, xA, ks + 4);
                __builtin_amdgcn_sched_barrier(0);
                P4_COMP(bhB, blB, xB);
                __builtin_amdgcn_sched_barrier(0);
            }
#undef P4_LOAD
#undef P4_COMP
            ss += __shfl_xor(ss, 16); ss += __shfl_xor(ss, 32);
            __syncthreads();
            LAS float* pb = part + (kh * 4 + mt) * 16 * 52;
#pragma unroll
            for (int n = 0; n < 3; ++n)
#pragma unroll
                for (int r = 0; r < 4; ++r) pb[(kq * 4 + r) * 52 + n * 16 + row] = acc[n][r];
            if (kq == 0) pb[row * 52 + 48] = ss;
            __syncthreads();
            if (kh == 0 && lane < 16 && rp_ == REPS(4) - 1) {
                const LAS float* p0 = part + (mt * 16 + lane) * 52; const LAS float* p1 = p0 + 4 * 16 * 52; const int t = t0 + lane;
#define TOT(c) (p0[c] + p1[c])
                const float rs = rsqrtf(TOT(48) * (1.f / DM) + EPS);
                int gi = 0; float lgm = TOT(0) * rs + bgrp[0];
                for (int g = 1; g < 4; ++g) { const float l = TOT(g) * rs + bgrp[g]; if (l > lgm) { lgm = l; gi = g; } }
                float den = 0.f; for (int g = 0; g < 4; ++g) den += expf(TOT(g) * rs + bgrp[g] - lgm); const float gwt = 1.f / den;
                int e0 = 0, e1 = 0; float l0 = -3.0e38f, l1 = -3.0e38f;
                for (int j = 0; j < 8; ++j) { const float l = TOT(4 + gi * 8 + j) * rs + brt[gi * 8 + j]; if (l > l0) { l1 = l0; e1 = e0; l0 = l; e0 = j; } else if (l > l1) { l1 = l; e1 = j; } }
#undef TOT
                const float w0 = 1.f / (1.f + expf(l1 - l0)), w1 = 1.f - w0;
                const int E0 = gi * 8 + e0, E1 = gi * 8 + e1;
#if MK_DETSLOT
                rec[t] = make_int4(E0 << 16, E1 << 16, __float_as_int(gwt * w0), __float_as_int(gwt * w1)); ((float*)(ws + 596 * MiB))[t] = rs;
                if (MK_DETSLOT == 2) { LAS int* eb = (LAS int*)(lds + 32768); eb[(mt * 16 + lane) * 2] = E0; eb[(mt * 16 + lane) * 2 + 1] = E1; }
#else
                const unsigned q0 = atomicAdd(&cnt[E0], 1u), q1 = atomicAdd(&cnt[E1], 1u);
                if (MK_LIST_SYS) { const unsigned long long ent = ((unsigned long long)(unsigned)__float_as_int(rs) << 32) | (unsigned)t;
                    __hip_atomic_store((unsigned long long*)((char*)list + ((size_t)E0 * T + q0) * LIST_ESZ), ent, __ATOMIC_RELAXED, __HIP_MEMORY_SCOPE_SYSTEM); __hip_atomic_store((unsigned long long*)((char*)list + ((size_t)E1 * T + q1) * LIST_ESZ), ent, __ATOMIC_RELAXED, __HIP_MEMORY_SCOPE_SYSTEM); }
                else if (MK_ST16 || MK_LIST_LINE) { *(int4*)((char*)list + ((size_t)E0 * T + q0) * LIST_ESZ) = make_int4(t, __float_as_int(rs), 0, 0); *(int4*)((char*)list + ((size_t)E1 * T + q1) * LIST_ESZ) = make_int4(t, __float_as_int(rs), 0, 0); }
                else { list[(size_t)E0 * T + q0] = make_int2(t, __float_as_int(rs)); list[(size_t)E1 * T + q1] = make_int2(t, __float_as_int(rs)); }
                rec[t] = make_int4((E0 << 16) | (int)q0, (E1 << 16) | (int)q1, __float_as_int(gwt * w0), __float_as_int(gwt * w1));
#endif
            }
#if MK_DETSLOT == 2
            __syncthreads();
            if (tid < 32 && rp_ == REPS(4) - 1) { const LAS int* eb = (const LAS int*)(lds + 32768); int c = 0; for (int j = 0; j < 64; ++j) c += (eb[2 * j] == tid) + (eb[2 * j + 1] == tid); ((int*)(ws + 597 * MiB))[un * 32 + tid] = c; }
#endif
        }
    }
    SEAM_XCD(4);
#if MK_DETSLOT
    if (IN(4) && IN(5)) {
        PHASE_VARS();
#if MK_DETSLOT == 2
        {
            const int* hist = (const int*)(ws + 597 * MiB); LAS int* sm = (LAS int*)(lds + 32768); LAS int* eb = sm + 2048; const float* rsv = (const float*)(ws + 596 * MiB);
            int* recw = (int*)(ws + WS_REC); char* list = (char*)(ws + MK_WS_LIST);
            const int myun = (int)blockIdx.x, e_ = tid & 31, part = tid >> 5;
            { int sb = 0, st = 0;
#pragma unroll 4
              for (int q = 0; q < 16; ++q) { const int uu = part * 16 + q; const int h = hist[uu * 32 + e_]; st += h; sb += (uu < myun) ? h : 0; }
              sm[part * 32 + e_] = sb; sm[512 + part * 32 + e_] = st; }
            __syncthreads();
            if (tid < 32) { int b = 0, tt = 0; for (int q = 0; q < 16; ++q) { b += sm[q * 32 + tid]; tt += sm[512 + q * 32 + tid]; } sm[1024 + tid] = b; sm[1056 + tid] = tt; }
            if (myun < T / 64 && tid < 64) { const int4 r = ((const int4*)recw)[myun * 64 + tid]; eb[2 * tid] = r.x >> 16; eb[2 * tid + 1] = r.y >> 16; }
            __syncthreads();
            if (myun < T / 64 && tid < 64) { const int t = myun * 64 + tid, E0 = eb[2 * tid], E1 = eb[2 * tid + 1]; int r0 = 0, r1 = 0;
                for (int j = 0; j < tid; ++j) { const int a = eb[2 * j], b = eb[2 * j + 1]; r0 += (a == E0) + (b == E0); r1 += (a == E1) + (b == E1); }
                const int p0 = sm[1024 + E0] + r0, p1 = sm[1024 + E1] + r1; const int rsb = __float_as_int(rsv[t]);
                *(int4*)(list + ((size_t)E0 * T + p0) * LIST_ESZ) = make_int4(t, rsb, 0, 0); *(int4*)(list + ((size_t)E1 * T + p1) * LIST_ESZ) = make_int4(t, rsb, 0, 0);
                recw[4 * t] = (E0 << 16) | p0; recw[4 * t + 1] = (E1 << 16) | p1; }
            if (tid < 32) { volatile LAS int* cntl0 = (volatile LAS int*)(lds + CNTL_OFF); cntl0[tid] = sm[1056 + tid]; }
            __syncthreads();
        }
#else
        if (blockIdx.x == 0) {
            int* recw = (int*)(ws + WS_REC); const float* rsv = (const float*)(ws + 596 * MiB); unsigned* cnt = (unsigned*)(ws + WS_CTL); char* list = (char*)(ws + MK_WS_LIST);
            for (int eb = 0; eb < 4; ++eb) { const int e = wave * 4 + eb; int c = 0;
#pragma unroll 1
                for (int k = 0; k < T / 64; ++k) { const int t = 64 * k + lane; const int rx = __hip_atomic_load(recw + 4 * t, __ATOMIC_RELAXED, __HIP_MEMORY_SCOPE_AGENT), ry = __hip_atomic_load(recw + 4 * t + 1, __ATOMIC_RELAXED, __HIP_MEMORY_SCOPE_AGENT);
                    const bool m0 = (rx >> 16) == e, m1 = (ry >> 16) == e, m = m0 || m1;
                    const unsigned long long bal = __ballot(m); const int pre = (int)__builtin_amdgcn_mbcnt_hi((unsigned)(bal >> 32), __builtin_amdgcn_mbcnt_lo((unsigned)bal, 0u));
                    if (m) { const int pos = c + pre; *(int4*)(list + ((size_t)e * T + pos) * LIST_ESZ) = make_int4(t, __float_as_int(rsv[t]), 0, 0); recw[4 * t + (m0 ? 0 : 1)] = (e << 16) | pos; }
                    c += __popcll(bal); }
                if (lane == 0) __hip_atomic_store(cnt + e, (unsigned)c, __ATOMIC_RELAXED, __HIP_MEMORY_SCOPE_AGENT); }
        }
#endif
        xcd_barrier((unsigned*)(ws + WS_CTL) + CW_BAR, (volatile LAS unsigned*)(lds + MISC_OFF) + 8, tid == 0, MK_REL_DELAY);
    }
#endif
    STAMP(5);
    if (IN(5) || IN(6) || IN(7)) {
        PHASE_VARS();
        volatile LAS int* cntl = (volatile LAS int*)(lds + CNTL_OFF); unsigned* cnt = (unsigned*)(ws + WS_CTL);
        __syncthreads();
        if (MK_DETSLOT != 2 && tid < NE) cntl[tid] = (int)__hip_atomic_load(cnt + tid, __ATOMIC_RELAXED, __HIP_MEMORY_SCOPE_AGENT);
        __syncthreads();
        if (tid == 0) { int s = 0; for (int i = 0; i < NE; ++i) { cntl[32 + i] = s; s += (cntl[i] + 255) & ~255; } }
        __syncthreads();
        if (tid < 160) { const int slot0 = tid * 256; int e = -1, p0 = 0; for (int j = 0; j < NE; ++j) { const int ps = cntl[32 + j], pad = (cntl[j] + 255) & ~255; if (slot0 >= ps && slot0 < ps + pad) { e = j; p0 = slot0 - ps; } } cntl[64 + tid] = e; cntl[224 + tid] = p0; }
        __syncthreads();
    }
    if (IN(5)) {
        PHASE_VARS();
        constexpr int ESZ = MK_F8 ? 1 : 2;
        pg8::MoeOrder<true, DM, ESZ> S{(const volatile LAS int*)(lds + CNTL_OFF), G, vcu, (const char*)(ws + WS_XN), (const char*)(ws + WS_WGU), (const int2*)(ws + MK_WS_LIST)};
        pg8::EpiGLU E{(bf16_t*)(ws + WS_H), (const int2*)(ws + MK_WS_LIST)};
        for (int rep_ = 0; rep_ < REPS(5); ++rep_) pg8::gemm_phase<pg8::EpiGLU, pg8::MoeOrder<true, DM, ESZ>, true, MK_F8 != 0>(lds, (LAS unsigned*)(lds + RTAB_OFF), DM, S, E);
    }
    SEAM_XCD(5);
    STAMP(6);
    if (IN(6)) {
        PHASE_VARS();
        constexpr int ESZ = MK_F8 ? 1 : 2;
        pg8::MoeOrder<false, DE, ESZ> S{(const volatile LAS int*)(lds + CNTL_OFF), G, vcu, (const char*)(ws + WS_H), (const char*)(ws + WS_WD), nullptr};
        pg8::EpiY E{(bf16_t*)(ws + WS_Y), 0};
        for (int rep_ = 0; rep_ < REPS(6); ++rep_) { if (MK_REPNS) { int sk = (rep_ + 1 < REPS(6)) ? 1 : 0; asm volatile("" : "+s"(sk)); E.skip = sk; } pg8::gemm_phase<pg8::EpiY, pg8::MoeOrder<false, DE, ESZ>, true, MK_F8 != 0>(lds, (LAS unsigned*)(lds + RTAB_OFF), DE, S, E); }
    }
    SEAM_XCD(6);
    STAMP(7);
    if (IN(7)) {
        PHASE_VARS();
        const int gw = vcu * NWAVES + wave, NGW = G * NWAVES;
        volatile LAS int* cntl = (volatile LAS int*)(lds + CNTL_OFF); float* out = ap->out; const bf16_t* Y = (const bf16_t*)(ws + WS_Y); const int4* rec = (const int4*)(ws + WS_REC);
        for (int ps_ = 0; ps_ < (MK_REP == 7 ? 3 : 1); ++ps_) {
        const float sg_ = (ps_ == 1) ? -1.f : 1.f; if (ps_) asm volatile("s_waitcnt vmcnt(0)" ::: "memory");
        int4 rn = rec[gw < T ? gw : 0];
        for (int t = gw; t < T; t += NGW) {
            const int4 r = rn; if (t + NGW < T) rn = rec[t + NGW];
            const int s0 = cntl[32 + (r.x >> 16)] + (r.x & 0xffff), s1 = cntl[32 + (r.y >> 16)] + (r.y & 0xffff); const float w0 = __int_as_float(r.z), w1 = __int_as_float(r.w);
            f32x4* o = (f32x4*)(out + (size_t)t * DM) + lane; const u32x2* y0 = (const u32x2*)(Y + (size_t)s0 * 2048) + lane; const u32x2* y1 = (const u32x2*)(Y + (size_t)s1 * 2048) + lane;
            f32x4 v[8]; u32x2 a[8], b[8];
#if MK_Y8
            { const unsigned* z0 = (const unsigned*)((const unsigned char*)Y + (size_t)s0 * 2048) + lane; const unsigned* z1 = (const unsigned*)((const unsigned char*)Y + (size_t)s1 * 2048) + lane; unsigned a8[8], b8[8];
#pragma unroll
              for (int j = 0; j < 8; ++j) { v[j] = o[64 * j]; a8[j] = z0[64 * j]; b8[j] = z1[64 * j]; }
              __builtin_amdgcn_sched_barrier(0);
              const float u0 = w0 * (sg_ / pg8::F8_SY), u1 = w1 * (sg_ / pg8::F8_SY);
#pragma unroll
              for (int j = 0; j < 8; ++j) { const auto al = __builtin_amdgcn_cvt_pk_f32_fp8((int)a8[j], false), ah = __builtin_amdgcn_cvt_pk_f32_fp8((int)a8[j], true), bl = __builtin_amdgcn_cvt_pk_f32_fp8((int)b8[j], false), bh = __builtin_amdgcn_cvt_pk_f32_fp8((int)b8[j], true);
                  v[j][0] += u0 * al[0] + u1 * bl[0]; v[j][1] += u0 * al[1] + u1 * bl[1]; v[j][2] += u0 * ah[0] + u1 * bh[0]; v[j][3] += u0 * ah[1] + u1 * bh[1]; o[64 * j] = v[j]; }
              continue; }
#endif
#pragma unroll
            for (int j = 0; j < 8; ++j) { v[j] = o[64 * j]; a[j] = y0[64 * j]; b[j] = y1[64 * j]; }
            __builtin_amdgcn_sched_barrier(0);
#pragma unroll
            for (int j = 0; j < 8; ++j) {
                v[j][0] += w0 * bf2f(a[j].x & 0xffffu) + w1 * bf2f(b[j].x & 0xffffu); v[j][1] += w0 * bf2f(a[j].x >> 16) + w1 * bf2f(b[j].x >> 16);
                v[j][2] += w0 * bf2f(a[j].y & 0xffffu) + w1 * bf2f(b[j].y & 0xffffu); v[j][3] += w0 * bf2f(a[j].y >> 16) + w1 * bf2f(b[j].y >> 16); o[64 * j] = v[j]; }
        }
        }
    }
#if MK_PROBE >= 0
    { kargp_t ap_ = (kargp_t)__builtin_amdgcn_kernarg_segment_ptr(); asm volatile("" : "+s"(ap_)); xcd_barrier((unsigned*)(ap_->ws + WS_CTL) + CW_BAR, (volatile LAS unsigned*)(lds + MISC_OFF) + 8, mk_tid(lds) == 0); }
    STAMP(8);
    { kargp_t ap_ = (kargp_t)__builtin_amdgcn_kernarg_segment_ptr(); asm volatile("" : "+s"(ap_)); xcd_barrier((unsigned*)(ap_->ws + WS_CTL) + CW_BAR, (volatile LAS unsigned*)(lds + MISC_OFF) + 8, mk_tid(lds) == 0); }
    { PHASE_VARS();
      const unsigned long long* ts = (const unsigned long long*)(ws + WS_LAM + 1024);
      const unsigned long long t0 = __hip_atomic_load(ts + 0, __ATOMIC_RELAXED, __HIP_MEMORY_SCOPE_AGENT), ta = __hip_atomic_load(ts + MK_PROBE, __ATOMIC_RELAXED, __HIP_MEMORY_SCOPE_AGENT), tb = __hip_atomic_load(ts + MK_PROBE + 1, __ATOMIC_RELAXED, __HIP_MEMORY_SCOPE_AGENT), te = __hip_atomic_load(ts + 8, __ATOMIC_RELAXED, __HIP_MEMORY_SCOPE_AGENT);
      const float f = (float)(tb - ta) / (float)(te - t0), sc = 1.f - f;
      f32x4* o = (f32x4*)ap->out; for (size_t i = (size_t)blockIdx.x * NTHR + tid; i < (size_t)T * DM / 4; i += (size_t)G * NTHR) { f32x4 v = o[i]; v = v * sc; o[i] = v; } }
#endif
#undef IN
#undef SEAM_XCD
}

#ifndef MK_PLAN
#define MK_PLAN 0
#endif
extern "C" void kernel_launch(void* const* d_in, const int* in_sizes, int n_in, void* d_out, int out_size, void* d_ws, size_t ws_size, hipStream_t stream) {
    static int ok = 0, grid = 0;
    if (ok == 0) {
        if (n_in != 23 || in_sizes[0] != T * DM || out_size != T * DM || ws_size < WS_END) { fprintf(stderr, "kernel_launch: unexpected shapes (n_in %d, in0 %d, out %d, ws %zu)\n", n_in, n_in > 0 ? in_sizes[0] : -1, out_size, ws_size); ok = -1; return; }
        if (hipFuncSetAttribute((const void*)k_gmlp, hipFuncAttributeMaxDynamicSharedMemorySize, (128 * 129 + 128 * 128) * 4) != hipSuccess) { fprintf(stderr, "kernel_launch: hipFuncSetAttribute failed\n"); ok = -1; return; }
        if (hipFuncSetAttribute((const void*)mk_fwd, hipFuncAttributeMaxDynamicSharedMemorySize, LDS_BYTES) != hipSuccess) { fprintf(stderr, "kernel_launch: hipFuncSetAttribute(mk_fwd) failed\n"); ok = -1; return; }
        int dev = 0, cus = 0, per_cu = 0;
        (void)hipGetDevice(&dev); (void)hipDeviceGetAttribute(&cus, hipDeviceAttributeMultiprocessorCount, dev);
        if (hipOccupancyMaxActiveBlocksPerMultiprocessor(&per_cu, (const void*)mk_fwd, NTHR, LDS_BYTES) != hipSuccess || per_cu < 1) { fprintf(stderr, "kernel_launch: occupancy query says %d blocks per CU\n", per_cu); per_cu = 1; }
        (void)hipGetLastError();
        grid = cus;
        if (grid % 8 != 0 || grid <= 0) { fprintf(stderr, "kernel_launch: unexpected CU count %d\n", cus); ok = -1; return; }
        ok = 1;
    }
    if (ok < 0) return;
    const float* x = (const float*)d_in[0]; const float* attn_g = (const float*)d_in[1]; const float* w_in = (const float*)d_in[2];
    const float* lng = (const float*)d_in[3]; const float* lnb = (const float*)d_in[4]; const float* gws = (const float*)d_in[5]; const float* gbs = (const float*)d_in[6];
    const float* qg = (const float*)d_in[7]; const float* kg = (const float*)d_in[8];
    const float* lq1 = (const float*)d_in[9]; const float* lk1 = (const float*)d_in[10]; const float* lq2 = (const float*)d_in[11]; const float* lk2 = (const float*)d_in[12];
    const float* subg = (const float*)d_in[13]; const float* w_out = (const float*)d_in[14]; const float* ffn_g = (const float*)d_in[15];
    const float* wgrp = (const float*)d_in[16]; const float* bgrp = (const float*)d_in[17]; const float* wrt = (const float*)d_in[18]; const float* brt = (const float*)d_in[19];
    const float* wgate = (const float*)d_in[20]; const float* wup = (const float*)d_in[21]; const float* wdown = (const float*)d_in[22];
    char* ws = (char*)d_ws; float* out = (float*)d_out;
    unsigned* cnt = (unsigned*)(ws + WS_CTL); float2* rope = (float2*)(ws + WS_ROPE); float* WrT = (float*)(ws + WS_WRT); bf16_t* WsB = (bf16_t*)(ws + WS_WSB); float* lam = (float*)(ws + WS_LAM);
    int2* list = (int2*)(ws + WS_LIST); int4* rec = (int4*)(ws + WS_REC);
    bf16_t* Win = (bf16_t*)(ws + WS_WIN); bf16_t* Wout = (bf16_t*)(ws + WS_WOUT); bf16_t* Wgu = (bf16_t*)(ws + WS_WGU); bf16_t* Wd = (bf16_t*)(ws + WS_WD);
    bf16_t* XN = (bf16_t*)(ws + WS_XN); bf16_t* MIX = (bf16_t*)(ws + WS_MIX); bf16_t* Z = (bf16_t*)(ws + WS_Z);
    bf16_t* U = (bf16_t*)(ws + WS_U); bf16_t* VG = U + (size_t)T * 1024; bf16_t* QN = VG + (size_t)T * 1024; bf16_t* KN = QN + (size_t)T * 1024; bf16_t* VB = KN + (size_t)T * 1024;
    bf16_t* H = (bf16_t*)(ws + WS_H); bf16_t* Y = (bf16_t*)(ws + WS_Y); bf16_t* GU = Y;
    (void)Z; (void)GU; (void)H; (void)rec; (void)list; (void)WsB;

    (void)hipMemsetAsync(ws + WS_CTL, 0, 32768, stream);
    MkArgs a{}; for (int i = 0; i < 23; ++i) a.in[i] = (const float*)d_in[i]; a.out = out; a.ws = (unsigned char*)d_ws;
    auto MK = [&](int lo, int hi) { a.ph_lo = lo; a.ph_hi = hi; hipLaunchKernelGGL(mk_fwd, dim3(grid), dim3(NTHR), LDS_BYTES, stream, a); };
#if MK_PLAN == 0
    a.ph_lo = 0; a.ph_hi = 8; void* kargs[] = {&a};
    const hipError_t ce = hipLaunchCooperativeKernel((const void*)mk_fwd, dim3(grid), dim3(NTHR), kargs, LDS_BYTES, stream);
    if (ce != hipSuccess) fprintf(stderr, "kernel_launch: cooperative launch failed: %s (grid %d)\n", hipGetErrorString(ce), grid);
#else
    auto V1_PRO = [&]() {
        k_transpose<<<dim3(INW / 32, DM / 32, 1), 256, 0, stream>>>(w_in, DM, INW, Win, attn_g, 1, 0, 0);
        k_transpose<<<dim3(DM / 32, DM / 32, 1), 256, 0, stream>>>(w_out, DM, DM, Wout, nullptr, 0, 0, 0);
        k_transpose<<<dim3(DE / 32, DM / 32, NE), 256, 0, stream>>>(wgate, DM, DE, Wgu, ffn_g, 2, (size_t)DM * DE, (size_t)2048 * 2048);
        k_transpose<<<dim3(DE / 32, DM / 32, NE), 256, 0, stream>>>(wup, DM, DE, Wgu, ffn_g, 3, (size_t)DM * DE, (size_t)2048 * 2048);
        k_transpose<<<dim3(DM / 32, DE / 32, NE), 256, 0, stream>>>(wdown, DE, DM, Wd, nullptr, 0, (size_t)DE * DM, (size_t)2048 * 1024);
        k_tables<<<256, 256, 0, stream>>>(rope, WrT, WsB, lam, wgrp, wrt, ffn_g, gws, lq1, lk1, lq2, lk2);
        k_xnorm<<<T, 256, 0, stream>>>(x, XN); };
    auto V1_G1 = [&]() { P_G1 p{XN, Win, Z}; k_gemm128<P_G1><<<dim3(INW / 128, T / 128), 256, 16384, stream>>>(p); k_post<<<T, 256, 0, stream>>>(Z, U, VG, QN, KN, VB, qg, kg, rope); };
    auto V1_MIX = [&]() { k_gmlp<<<NB * 32 * 8, 256, (128 * 129 + 128 * 128) * 4, stream>>>(U, VG, lng, lnb, gws, gbs, MIX); k_attn_simple<<<NB * 8 * 256, 256, 0, stream>>>(QN, KN, VB, subg, lam, MIX); };
    auto V1_G2 = [&]() { P_G2 p{MIX, Wout, x, out, XN}; k_gemm128<P_G2><<<dim3(DM / 128, T / 128), 256, 16384, stream>>>(p); };
    auto V1_ROUTE = [&]() { k_route<<<T, 256, 0, stream>>>(out, WrT, bgrp, brt, cnt, list, rec); };
    auto V1_GU = [&]() { P_GU p{XN, Wgu, cnt, list, GU}; k_gemm128<P_GU><<<dim3(2048 / 128, SLOTS / 128), 256, 16384, stream>>>(p); k_glu<<<SLOTS, 256, 0, stream>>>(GU, cnt, list, H); };
    auto V1_DN = [&]() { P_DN p{H, Wd, cnt, Y}; k_gemm128<P_DN><<<dim3(2048 / 128, SLOTS / 128), 256, 16384, stream>>>(p); };
    auto V1_COMB = [&]() { k_combine<<<T, 256, 0, stream>>>(out, Y, cnt, rec); };
    (void)V1_PRO; (void)V1_G1; (void)V1_MIX; (void)V1_G2; (void)V1_ROUTE; (void)V1_GU; (void)V1_DN; (void)V1_COMB;
#if MK_PLAN == 1
    V1_PRO(); MK(1, 2); V1_MIX(); MK(3, 4); V1_ROUTE(); MK(5, 6); MK(6, 7); V1_COMB();
#elif MK_PLAN == 2
    for (int p = 0; p < 8; ++p) MK(p, p + 1);
#endif
#endif
    const hipError_t le = hipPeekAtLastError();
    if (le != hipSuccess) fprintf(stderr, "kernel_launch: launch failed: %s\n", hipGetErrorName(le));
}
```

```cpp
#include <hip/hip_runtime.h>
#include <cstdio>
#include <cstdint>

typedef unsigned short bf16_t;
typedef short bf16x8 __attribute__((ext_vector_type(8)));
typedef float f32x4 __attribute__((ext_vector_type(4)));

constexpr int NB = 4, SEQ = 4096, T = NB * SEQ, DM = 2048, INW = 5120;
constexpr int NE = 32, DE = 1024, SLOTS = 40960;
constexpr float EPS = 1e-6f;
constexpr float C2 = 0.125f * 1.4426950408889634f;

constexpr size_t MiB = 1u << 20;
constexpr size_t WS_CTL = 0;
constexpr size_t WS_ROPE = 1 * MiB;
constexpr size_t WS_WRT = WS_ROPE + 512 * 1024;
constexpr size_t WS_WSB = 2 * MiB;
constexpr size_t WS_WRH = 2 * MiB + 256 * 1024;
constexpr size_t WS_LAM = 3 * MiB;
constexpr size_t WS_LIST = 4 * MiB;
constexpr size_t WS_REC = 8 * MiB;
constexpr size_t WS_WIN = 12 * MiB;
constexpr size_t WS_WOUT = 32 * MiB;
constexpr size_t WS_WGU = 40 * MiB;
constexpr size_t WS_WD = 296 * MiB;
constexpr size_t WS_XN = 424 * MiB;
constexpr size_t WS_MIX = 488 * MiB;
constexpr size_t WS_Z = 552 * MiB;
constexpr size_t WS_U = 712 * MiB;
constexpr size_t WS_H = 552 * MiB;
constexpr size_t WS_Y = 632 * MiB;
constexpr size_t WS_END = 944 * MiB;

__device__ __forceinline__ unsigned f2bf(float f) { unsigned u = __builtin_bit_cast(unsigned, f); return (u + 0x7fffu + ((u >> 16) & 1u)) >> 16; }
__device__ __forceinline__ float bf2f(unsigned h) { return __builtin_bit_cast(float, h << 16); }
__device__ __forceinline__ unsigned pk2(float lo, float hi) { return f2bf(lo) | (f2bf(hi) << 16); }
__device__ __forceinline__ float wave_sum(float v) {
#pragma unroll
    for (int o = 1; o < 64; o <<= 1) v += __shfl_xor(v, o);
    return v;
}
__device__ __forceinline__ float gelu_tanh(float x) { const float u = 0.7978845608028654f * (x + 0.044715f * x * x * x); return 0.5f * x * (1.f + tanhf(u)); }
__device__ __forceinline__ void unpack8(uint4 r, float* f) {
    f[0] = bf2f(r.x & 0xffffu); f[1] = bf2f(r.x >> 16); f[2] = bf2f(r.y & 0xffffu); f[3] = bf2f(r.y >> 16);
    f[4] = bf2f(r.z & 0xffffu); f[5] = bf2f(r.z >> 16); f[6] = bf2f(r.w & 0xffffu); f[7] = bf2f(r.w >> 16);
}
__device__ __forceinline__ uint4 pack8(const float* f) { uint4 r; r.x = pk2(f[0], f[1]); r.y = pk2(f[2], f[3]); r.z = pk2(f[4], f[5]); r.w = pk2(f[6], f[7]); return r; }

__device__ __forceinline__ int map_row(int mode, int n) {
    if (mode == 1) { const int pn = n >> 8, r = n & 255, wc = r >> 6, bj = (r >> 5) & 1, j = r & 31; return (pn << 8) + (bj << 7) + (wc << 5) + j; }
    if (mode == 2) return ((n >> 7) << 8) + (n & 127);
    if (mode == 3) return ((n >> 7) << 8) + 128 + (n & 127);
    return n;
}
__device__ __forceinline__ int win_logical(int np) { const int pn = np >> 8, r = np & 255, bj = r >> 7, wc = (r >> 5) & 3, j = r & 31; return (pn << 8) + (wc << 6) + (bj << 5) + j; }

__global__ __launch_bounds__(256) void k_transpose(const float* __restrict__ W, int K, int N, bf16_t* __restrict__ WT, const float* __restrict__ gk, int mode, size_t wes, size_t wtes) {
    __shared__ float t[32][33];
    const int tx = threadIdx.x & 31, ty = threadIdx.x >> 5;
    const int k0 = blockIdx.y * 32, n0 = blockIdx.x * 32; const size_t e = blockIdx.z;
    const float* Wp = W + e * wes; bf16_t* WTp = WT + e * wtes;
#pragma unroll
    for (int i = 0; i < 4; ++i) { const int kk = ty + 8 * i; const float g = gk ? gk[k0 + kk] : 1.f; t[kk][tx] = Wp[(size_t)(k0 + kk) * N + n0 + tx] * g; }
    __syncthreads();
#pragma unroll
    for (int i = 0; i < 4; ++i) { const int nn = ty + 8 * i; const int np = map_row(mode, n0 + nn); WTp[(size_t)np * K + k0 + tx] = (bf16_t)f2bf(t[tx][nn]); }
}

__device__ __forceinline__ float block_sum256(float v, float* red) {
    v = wave_sum(v); const int wid = threadIdx.x >> 6;
    if ((threadIdx.x & 63) == 0) red[wid] = v;
    __syncthreads(); const float r = red[0] + red[1] + red[2] + red[3]; __syncthreads(); return r;
}

__global__ __launch_bounds__(256) void k_xnorm(const float* __restrict__ x, bf16_t* __restrict__ XN) {
    __shared__ float red[4];
    const int t = blockIdx.x, tid = threadIdx.x;
    const float4* xr = (const float4*)(x + (size_t)t * DM) + tid * 2; const float4 a = xr[0], b = xr[1];
    float ss = a.x * a.x + a.y * a.y + a.z * a.z + a.w * a.w + b.x * b.x + b.y * b.y + b.z * b.z + b.w * b.w;
    ss = block_sum256(ss, red);
    const float rs = rsqrtf(ss * (1.f / DM) + EPS);
    uint4 o; o.x = pk2(a.x * rs, a.y * rs); o.y = pk2(a.z * rs, a.w * rs); o.z = pk2(b.x * rs, b.y * rs); o.w = pk2(b.z * rs, b.w * rs);
    *(uint4*)(XN + (size_t)t * DM + tid * 8) = o;
}

__global__ __launch_bounds__(256) void k_tables(float2* rope, float* WrT, bf16_t* WsB, float* lam, const float* wgrp, const float* wrt, const float* fng, const float* ws,
                                                const float* lq1, const float* lk1, const float* lq2, const float* lk2) {
    const int gid = blockIdx.x * 256 + threadIdx.x, gsz = gridDim.x * 256;
    for (int i = gid; i < 4096 * 8; i += gsz) { const int pos = i >> 3, f = i & 7; const float inv = 1.0f / powf(500000.0f, (float)(2 * f) / 16.0f); const float ang = (float)pos * inv; rope[i] = make_float2(cosf(ang), sinf(ang)); }
    for (int i = gid; i < 36 * 2048; i += gsz) { const int c = i / 2048, k = i % 2048; const float w = c < 4 ? wgrp[k * 4 + c] : wrt[k * 32 + (c - 4)]; WrT[i] = w * fng[k]; }
    for (int i = gid; i < 8 * 128 * 128; i += gsz) WsB[i] = (bf16_t)f2bf(ws[i]);
    if (gid == 0) { float a = 0.f, b = 0.f; for (int i = 0; i < 64; ++i) { a += lq1[i] * lk1[i]; b += lq2[i] * lk2[i]; } lam[0] = expf(a) - expf(b) + 0.2f; }
}

struct TileBase { const bf16_t* Bt; int K; };
template <class P> __global__ __launch_bounds__(256, 2) void k_gemm128(P p) {
    extern __shared__ __attribute__((aligned(16))) bf16_t shm[];
    typename P::Tile ti; if (!p.tile(ti)) return;
    const int tid = threadIdx.x, wid = tid >> 6, lane = tid & 63, wr = wid >> 1, wc = wid & 1, fr = lane & 15, fq = lane >> 4;
    bf16_t* SA = shm; bf16_t* SB = shm + 4096;
    const int sr = tid >> 2, scol = (tid & 3) * 8; const int K = ti.K;
    const bf16_t* a0 = p.arow(ti, sr) + scol; const bf16_t* a1 = p.arow(ti, sr + 64) + scol;
    const bf16_t* b0 = ti.Bt + (size_t)sr * K + scol; const bf16_t* b1 = ti.Bt + (size_t)(sr + 64) * K + scol;
    f32x4 acc[4][4];
#pragma unroll
    for (int m = 0; m < 4; ++m)
#pragma unroll
        for (int n = 0; n < 4; ++n) acc[m][n] = (f32x4){0.f, 0.f, 0.f, 0.f};
    bf16x8 At[4], Bl[4];
    for (int t = 0; t < K / 32; ++t) {
        __builtin_amdgcn_global_load_lds((const unsigned*)(a0 + t * 32), (unsigned*)((char*)SA + tid * 16), 16, 0, 0);
        __builtin_amdgcn_global_load_lds((const unsigned*)(a1 + t * 32), (unsigned*)((char*)SA + tid * 16 + 4096), 16, 0, 0);
        __builtin_amdgcn_global_load_lds((const unsigned*)(b0 + t * 32), (unsigned*)((char*)SB + tid * 16), 16, 0, 0);
        __builtin_amdgcn_global_load_lds((const unsigned*)(b1 + t * 32), (unsigned*)((char*)SB + tid * 16 + 4096), 16, 0, 0);
        asm volatile("s_waitcnt vmcnt(0)" ::: "memory"); __syncthreads();
#pragma unroll
        for (int m = 0; m < 4; ++m) At[m] = *reinterpret_cast<const bf16x8*>((char*)SA + (wr * 64 + m * 16 + fr) * 64 + fq * 16);
#pragma unroll
        for (int n = 0; n < 4; ++n) Bl[n] = *reinterpret_cast<const bf16x8*>((char*)SB + (wc * 64 + n * 16 + fr) * 64 + fq * 16);
        asm volatile("s_waitcnt lgkmcnt(0)" ::: "memory"); __builtin_amdgcn_sched_barrier(0);
#pragma unroll
        for (int m = 0; m < 4; ++m)
#pragma unroll
            for (int n = 0; n < 4; ++n) acc[m][n] = __builtin_amdgcn_mfma_f32_16x16x32_bf16(At[m], Bl[n], acc[m][n], 0, 0, 0);
        __syncthreads();
    }
#pragma unroll
    for (int m = 0; m < 4; ++m)
#pragma unroll
        for (int n = 0; n < 4; ++n)
#pragma unroll
            for (int j = 0; j < 4; ++j) p.store(ti, wr * 64 + m * 16 + fq * 4 + j, wc * 64 + n * 16 + fr, acc[m][n][j]);
}

struct P_G1 {
    struct Tile : TileBase { int brow, bcol; };
    const bf16_t* A; const bf16_t* Bt; bf16_t* Z;
    __device__ bool tile(Tile& ti) const { ti.brow = blockIdx.y * 128; ti.bcol = blockIdx.x * 128; ti.Bt = Bt + (size_t)ti.bcol * DM; ti.K = DM; return true; }
    __device__ const bf16_t* arow(const Tile& ti, int r) const { return A + (size_t)(ti.brow + r) * DM; }
    __device__ void store(const Tile& ti, int r, int c, float v) const { Z[(size_t)(ti.brow + r) * INW + win_logical(ti.bcol + c)] = (bf16_t)f2bf(v); }
};
struct P_G2 {
    struct Tile : TileBase { int brow, bcol; };
    const bf16_t* A; const bf16_t* Bt; const float* x; float* out; bf16_t* X1B;
    __device__ bool tile(Tile& ti) const { ti.brow = blockIdx.y * 128; ti.bcol = blockIdx.x * 128; ti.Bt = Bt + (size_t)ti.bcol * DM; ti.K = DM; return true; }
    __device__ const bf16_t* arow(const Tile& ti, int r) const { return A + (size_t)(ti.brow + r) * DM; }
    __device__ void store(const Tile& ti, int r, int c, float v) const { const size_t o = (size_t)(ti.brow + r) * DM + ti.bcol + c; const float x1 = v + x[o]; out[o] = x1; X1B[o] = (bf16_t)f2bf(x1); }
};
__device__ __forceinline__ bool find_expert(const unsigned* cnt, int slot0, int& e, int& pos0, int& ce) {
    int ps = 0;
    for (int i = 0; i < NE; ++i) { const int c = (int)cnt[i]; const int pad = (c + 255) & ~255; if (slot0 < ps + pad) { e = i; pos0 = slot0 - ps; ce = c; return true; } ps += pad; }
    return false;
}
struct P_GU {
    struct Tile : TileBase { int slot0, bcol, e, pos0, ce; };
    const bf16_t* X1B; const bf16_t* Wgu; const unsigned* cnt; const int2* list; bf16_t* GU;
    __device__ bool tile(Tile& ti) const { ti.slot0 = blockIdx.y * 128; ti.bcol = blockIdx.x * 128; if (!find_expert(cnt, ti.slot0, ti.e, ti.pos0, ti.ce)) return false;
        ti.Bt = Wgu + (size_t)ti.e * 2048 * 2048 + (size_t)ti.bcol * DM; ti.K = DM; return true; }
    __device__ const bf16_t* arow(const Tile& ti, int r) const { const int pos = ti.pos0 + r; const int tok = pos < ti.ce ? list[(size_t)ti.e * T + pos].x : 0; return X1B + (size_t)tok * DM; }
    __device__ void store(const Tile& ti, int r, int c, float v) const { GU[(size_t)(ti.slot0 + r) * 2048 + ti.bcol + c] = (bf16_t)f2bf(v); }
};
struct P_DN {
    struct Tile : TileBase { int slot0, bcol, e, pos0, ce; };
    const bf16_t* H; const bf16_t* Wd; const unsigned* cnt; bf16_t* Y;
    __device__ bool tile(Tile& ti) const { ti.slot0 = blockIdx.y * 128; ti.bcol = blockIdx.x * 128; if (!find_expert(cnt, ti.slot0, ti.e, ti.pos0, ti.ce)) return false;
        ti.Bt = Wd + (size_t)ti.e * 2048 * 1024 + (size_t)ti.bcol * DE; ti.K = DE; return true; }
    __device__ const bf16_t* arow(const Tile& ti, int r) const { return H + (size_t)(ti.slot0 + r) * DE; }
    __device__ void store(const Tile& ti, int r, int c, float v) const { Y[(size_t)(ti.slot0 + r) * 2048 + ti.bcol + c] = (bf16_t)f2bf(v); }
};

__global__ __launch_bounds__(256) void k_post(const bf16_t* __restrict__ Z, bf16_t* U, bf16_t* VG, bf16_t* QN, bf16_t* KN, bf16_t* VB, const float* qg, const float* kg, const float2* rope) {
    const int t = blockIdx.x, tid = threadIdx.x, pos = t & (SEQ - 1);
    const bf16_t* z = Z + (size_t)t * INW; float f[8];
    { unpack8(*(const uint4*)(z + tid * 8), f);
#pragma unroll
      for (int i = 0; i < 8; ++i) f[i] = gelu_tanh(f[i]);
      const uint4 o = pack8(f); if (tid < 128) *(uint4*)(U + (size_t)t * 1024 + tid * 8) = o; else *(uint4*)(VG + (size_t)t * 1024 + (tid - 128) * 8) = o; }
    if (tid < 128) *(uint4*)(VB + (size_t)t * 1024 + tid * 8) = *(const uint4*)(z + 4096 + tid * 8);
    { const bool isk = tid >= 128; const int col = (tid * 8) & 1023, d0 = col & 63, sub = d0 >> 3;
      unpack8(*(const uint4*)(z + 2048 + tid * 8), f);
      float ss = 0.f;
#pragma unroll
      for (int i = 0; i < 8; ++i) ss += f[i] * f[i];
      ss += __shfl_xor(ss, 1); ss += __shfl_xor(ss, 2); ss += __shfl_xor(ss, 4);
      const float rs = rsqrtf(ss * (1.f / 64.f) + EPS); const float* g = isk ? kg : qg;
      float y[8], pr[8];
#pragma unroll
      for (int i = 0; i < 8; ++i) y[i] = f[i] * rs * g[d0 + i];
#pragma unroll
      for (int i = 0; i < 8; ++i) pr[i] = __shfl_xor(y[i], 1);
      if (sub < 2) {
#pragma unroll
          for (int i = 0; i < 8; ++i) { const float2 cs = rope[pos * 8 + i]; y[i] = sub == 0 ? y[i] * cs.x - pr[i] * cs.y : y[i] * cs.x + pr[i] * cs.y; } }
      if (!isk) {
#pragma unroll
          for (int i = 0; i < 8; ++i) y[i] *= C2; }
      *(uint4*)((isk ? KN : QN) + (size_t)t * 1024 + col) = pack8(y); }
}

__global__ __launch_bounds__(256) void k_gmlp(const bf16_t* __restrict__ U, const bf16_t* __restrict__ VG, const float* lng, const float* lnb, const float* Ws, const float* bs, bf16_t* MIX) {
    extern __shared__ __attribute__((aligned(16))) float sm[];
    float* vln = sm; float* wsl = sm + 128 * 129;
    const int blk = blockIdx.x, h = blk & 7, c = (blk >> 3) & 31, b = blk >> 8, t0 = b * SEQ + c * 128;
    const int tid = threadIdx.x, wid = tid >> 6, lane = tid & 63;
    for (int i = tid; i < 128 * 128; i += 256) wsl[i] = Ws[(size_t)h * 16384 + i];
    for (int jj = 0; jj < 32; ++jj) { const int j = wid * 32 + jj; const bf16_t* vr = VG + (size_t)(t0 + j) * 1024 + h * 128;
        const float a = bf2f(vr[lane]), b2 = bf2f(vr[lane + 64]); const float mu = wave_sum(a + b2) * (1.f / 128.f); const float da = a - mu, db = b2 - mu;
        const float rs = rsqrtf(wave_sum(da * da + db * db) * (1.f / 128.f) + EPS);
        vln[j * 129 + lane] = da * rs * lng[h * 128 + lane] + lnb[h * 128 + lane]; vln[j * 129 + lane + 64] = db * rs * lng[h * 128 + lane + 64] + lnb[h * 128 + lane + 64]; }
    __syncthreads();
    const int d = tid & 127, ih = tid >> 7; float acc[64];
#pragma unroll
    for (int i = 0; i < 64; ++i) acc[i] = 0.f;
    for (int j = 0; j < 128; ++j) { const float v = vln[j * 129 + d];
#pragma unroll
        for (int i = 0; i < 64; ++i) acc[i] += wsl[(ih * 64 + i) * 128 + j] * v; }
#pragma unroll
    for (int i = 0; i < 64; ++i) { const int row = t0 + ih * 64 + i; const float s = acc[i] + bs[h * 128 + ih * 64 + i];
        const float u = bf2f(U[(size_t)row * 1024 + h * 128 + d]); MIX[(size_t)row * DM + h * 128 + d] = (bf16_t)f2bf(u * s); }
}

__global__ __launch_bounds__(256) void k_attn_simple(const bf16_t* __restrict__ QN, const bf16_t* __restrict__ KN, const bf16_t* __restrict__ VB, const float* subg, const float* lamp, bf16_t* MIX) {
    const int tid = threadIdx.x, part = tid & 15, qr = tid >> 4;
    const int blk = blockIdx.x, qb = blk & 255, h = (blk >> 8) & 7, b = blk >> 11;
    const int t = b * SEQ + qb * 16 + qr;
    float q1[4], q2[4];
    { const uint2 a = *(const uint2*)(QN + (size_t)t * 1024 + h * 128 + part * 4), c = *(const uint2*)(QN + (size_t)t * 1024 + h * 128 + 64 + part * 4);
      q1[0] = bf2f(a.x & 0xffffu); q1[1] = bf2f(a.x >> 16); q1[2] = bf2f(a.y & 0xffffu); q1[3] = bf2f(a.y >> 16);
      q2[0] = bf2f(c.x & 0xffffu); q2[1] = bf2f(c.x >> 16); q2[2] = bf2f(c.y & 0xffffu); q2[3] = bf2f(c.y >> 16); }
    float o1[8], o2[8], l1 = 0.f, l2 = 0.f;
#pragma unroll
    for (int e = 0; e < 8; ++e) { o1[e] = 0.f; o2[e] = 0.f; }
    const bf16_t* Kb = KN + (size_t)(b * SEQ) * 1024 + h * 128; const bf16_t* Vb = VB + (size_t)(b * SEQ) * 1024 + h * 128;
#pragma unroll 4
    for (int j = 0; j < SEQ; ++j) {
        const uint2 ka = *(const uint2*)(Kb + (size_t)j * 1024 + part * 4), kc = *(const uint2*)(Kb + (size_t)j * 1024 + 64 + part * 4); const uint4 vr = *(const uint4*)(Vb + (size_t)j * 1024 + part * 8);
        float s1 = q1[0] * bf2f(ka.x & 0xffffu) + q1[1] * bf2f(ka.x >> 16) + q1[2] * bf2f(ka.y & 0xffffu) + q1[3] * bf2f(ka.y >> 16);
        float s2 = q2[0] * bf2f(kc.x & 0xffffu) + q2[1] * bf2f(kc.x >> 16) + q2[2] * bf2f(kc.y & 0xffffu) + q2[3] * bf2f(kc.y >> 16);
        s1 += __shfl_xor(s1, 1); s2 += __shfl_xor(s2, 1); s1 += __shfl_xor(s1, 2); s2 += __shfl_xor(s2, 2); s1 += __shfl_xor(s1, 4); s2 += __shfl_xor(s2, 4); s1 += __shfl_xor(s1, 8); s2 += __shfl_xor(s2, 8);
        const float p1 = exp2f(s1), p2 = exp2f(s2); l1 += p1; l2 += p2; float v[8]; unpack8(vr, v);
#pragma unroll
        for (int e = 0; e < 8; ++e) { o1[e] += p1 * v[e]; o2[e] += p2 * v[e]; }
    }
    const float lam = lamp[0], i1 = 1.f / l1, i2 = lam / l2; float o[8], ss = 0.f;
#pragma unroll
    for (int e = 0; e < 8; ++e) { o[e] = o1[e] * i1 - o2[e] * i2; ss += o[e] * o[e]; }
    ss += __shfl_xor(ss, 1); ss += __shfl_xor(ss, 2); ss += __shfl_xor(ss, 4); ss += __shfl_xor(ss, 8);
    const float rs = rsqrtf(ss * (1.f / 128.f) + EPS);
#pragma unroll
    for (int e = 0; e < 8; ++e) o[e] = o[e] * rs * subg[part * 8 + e] * 0.8f;
    *(uint4*)(MIX + (size_t)t * DM + 1024 + h * 128 + part * 8) = pack8(o);
}

__global__ __launch_bounds__(256) void k_route(const float* __restrict__ x1, const float* __restrict__ WrT, const float* bg, const float* br, unsigned* cnt, int2* list, int4* rec) {
    __shared__ float red[4][40];
    const int t = blockIdx.x, tid = threadIdx.x, lane = tid & 63, wid = tid >> 6;
    float xv[8]; { const float4* xr = (const float4*)(x1 + (size_t)t * DM) + tid * 2; const float4 a = xr[0], b = xr[1]; xv[0] = a.x; xv[1] = a.y; xv[2] = a.z; xv[3] = a.w; xv[4] = b.x; xv[5] = b.y; xv[6] = b.z; xv[7] = b.w; }
    float ss = 0.f;
#pragma unroll
    for (int i = 0; i < 8; ++i) ss += xv[i] * xv[i];
    ss = wave_sum(ss); if (lane == 0) red[wid][36] = ss;
    for (int c = 0; c < 36; ++c) { const float4* wr = (const float4*)(WrT + (size_t)c * DM) + tid * 2; const float4 a = wr[0], b = wr[1];
        float p = xv[0] * a.x + xv[1] * a.y + xv[2] * a.z + xv[3] * a.w + xv[4] * b.x + xv[5] * b.y + xv[6] * b.z + xv[7] * b.w; p = wave_sum(p); if (lane == 0) red[wid][c] = p; }
    __syncthreads();
    if (tid < 37) red[0][tid] = red[0][tid] + red[1][tid] + red[2][tid] + red[3][tid];
    __syncthreads();
    if (tid == 0) {
        const float* tot = red[0];
        const float rs = rsqrtf(tot[36] * (1.f / DM) + EPS);
        int gi = 0; float lgm = tot[0] * rs + bg[0];
        for (int g = 1; g < 4; ++g) { const float l = tot[g] * rs + bg[g]; if (l > lgm) { lgm = l; gi = g; } }
        float den = 0.f; for (int g = 0; g < 4; ++g) den += expf(tot[g] * rs + bg[g] - lgm); const float gw = 1.f / den;
        float* le = red[1]; for (int j = 0; j < 8; ++j) le[j] = tot[4 + gi * 8 + j] * rs + br[gi * 8 + j];
        int e0 = 0; for (int j = 1; j < 8; ++j) if (le[j] > le[e0]) e0 = j;
        int e1 = e0 == 0 ? 1 : 0; for (int j = 0; j < 8; ++j) if (j != e0 && le[j] > le[e1]) e1 = j;
        const float w0 = 1.f / (1.f + expf(le[e1] - le[e0])), w1 = 1.f - w0;
        const int E0 = gi * 8 + e0, E1 = gi * 8 + e1;
        const unsigned p0 = atomicAdd(&cnt[E0], 1u), p1 = atomicAdd(&cnt[E1], 1u);
        list[(size_t)E0 * T + p0] = make_int2(t, __float_as_int(rs)); list[(size_t)E1 * T + p1] = make_int2(t, __float_as_int(rs));
        rec[t] = make_int4((E0 << 16) | (int)p0, (E1 << 16) | (int)p1, __float_as_int(gw * w0), __float_as_int(gw * w1));
    }
}

__global__ __launch_bounds__(256) void k_glu(const bf16_t* __restrict__ GU, const unsigned* cnt, const int2* list, bf16_t* H) {
    const int slot = blockIdx.x, tid = threadIdx.x; int e, pos, ce; if (!find_expert(cnt, slot, e, pos, ce)) return;
    const float rs = pos < ce ? __int_as_float(list[(size_t)e * T + pos].y) : 0.f;
    const int c = tid * 4, base = ((c >> 7) << 8) + (c & 127);
    const uint2 g = *(const uint2*)(GU + (size_t)slot * 2048 + base), u = *(const uint2*)(GU + (size_t)slot * 2048 + base + 128);
    float gv[4] = {bf2f(g.x & 0xffffu), bf2f(g.x >> 16), bf2f(g.y & 0xffffu), bf2f(g.y >> 16)}, uv[4] = {bf2f(u.x & 0xffffu), bf2f(u.x >> 16), bf2f(u.y & 0xffffu), bf2f(u.y >> 16)}, hv[4];
#pragma unroll
    for (int i = 0; i < 4; ++i) { const float a = gv[i] * rs; hv[i] = a / (1.f + expf(-a)) * (uv[i] * rs); }
    uint2 o; o.x = pk2(hv[0], hv[1]); o.y = pk2(hv[2], hv[3]); *(uint2*)(H + (size_t)slot * DE + c) = o;
}

__global__ __launch_bounds__(256) void k_combine(float* out, const bf16_t* __restrict__ Y, const unsigned* cnt, const int4* rec) {
    __shared__ int ps[NE];
    const int t = blockIdx.x, tid = threadIdx.x;
    if (tid == 0) { int s = 0; for (int i = 0; i < NE; ++i) { ps[i] = s; s += ((int)cnt[i] + 255) & ~255; } }
    __syncthreads();
    const int4 r = rec[t]; const int s0 = ps[r.x >> 16] + (r.x & 0xffff), s1 = ps[r.y >> 16] + (r.y & 0xffff); const float w0 = __int_as_float(r.z), w1 = __int_as_float(r.w);
    float a[8], b[8]; unpack8(*(const uint4*)(Y + (size_t)s0 * 2048 + tid * 8), a); unpack8(*(const uint4*)(Y + (size_t)s1 * 2048 + tid * 8), b);
    float4* o = (float4*)(out + (size_t)t * DM) + tid * 2; float4 x0 = o[0], x1 = o[1];
    x0.x += w0 * a[0] + w1 * b[0]; x0.y += w0 * a[1] + w1 * b[1]; x0.z += w0 * a[2] + w1 * b[2]; x0.w += w0 * a[3] + w1 * b[3];
    x1.x += w0 * a[4] + w1 * b[4]; x1.y += w0 * a[5] + w1 * b[5]; x1.z += w0 * a[6] + w1 * b[6]; x1.w += w0 * a[7] + w1 * b[7];
    o[0] = x0; o[1] = x1;
}


#include <hip/hip_cooperative_groups.h>
namespace cg = cooperative_groups;
#define LAS __attribute__((address_space(3)))
#define GAS __attribute__((address_space(1)))
typedef unsigned u32x4 __attribute__((ext_vector_type(4)));
typedef unsigned u32x2 __attribute__((ext_vector_type(2)));
typedef float f32x2 __attribute__((ext_vector_type(2)));
#define LDS_WAIT() asm volatile("s_waitcnt lgkmcnt(0)" ::: "memory")
#define VM_WAIT() asm volatile("s_waitcnt vmcnt(0)" ::: "memory")

#ifndef MK_F8
#define MK_F8 1
#endif
#ifndef MK_TBO
#define MK_TBO 1
#endif
#ifndef MK_ST16
#define MK_ST16 0
#endif
#ifndef MK_LIST_LINE
#define MK_LIST_LINE 0
#endif
constexpr size_t MK_WS_LIST = MK_LIST_LINE ? 880 * MiB : (MK_ST16 ? 600 * MiB : WS_LIST);
#ifndef MK_LIST_SYS
#define MK_LIST_SYS 0
#endif
constexpr int LIST_ESZ = MK_LIST_LINE ? 128 : (MK_ST16 ? 16 : 8);
#ifndef MK_F8_P1
#define MK_F8_P1 0
#endif
constexpr float F8_SXN = 16.f, F8_SWI = 256.f;
constexpr float F8_SX = 16.f, F8_SW = 256.f, F8_SH = 8.f, F8_SD = 128.f;
typedef int i32x4 __attribute__((ext_vector_type(4)));
typedef int i32x8 __attribute__((ext_vector_type(8)));
constexpr int NWAVES = 8, NTHR = 512;
constexpr int RING_BYTES = 131072, EXTRA_OFF = RING_BYTES, LDS_BYTES = 163840;
typedef __bf16 bf16x2_t __attribute__((ext_vector_type(2)));
__device__ __forceinline__ unsigned cvt_pk_bf16(float lo, float hi) { const f32x2 v = {lo, hi}; const bf16x2_t b = __builtin_convertvector(v, bf16x2_t); return __builtin_bit_cast(unsigned, b); }
__device__ __forceinline__ float fast_gelu(float x) { const float e = __builtin_amdgcn_exp2f(-2.302208198f * (x + 0.044715f * x * x * x)); return x * __builtin_amdgcn_rcpf(1.f + e); }
__device__ __forceinline__ float clamp448(float x) { return __builtin_fminf(__builtin_fmaxf(x, -448.f), 448.f); }
__device__ __forceinline__ unsigned pk4_fp8(float a, float b, float c, float d) { int w = 0; w = __builtin_amdgcn_cvt_pk_fp8_f32(clamp448(a), clamp448(b), w, false); w = __builtin_amdgcn_cvt_pk_fp8_f32(clamp448(c), clamp448(d), w, true); return (unsigned)w; }
__device__ __forceinline__ float fast_silu(float a) { return a * __builtin_amdgcn_rcpf(1.f + __builtin_amdgcn_exp2f(-1.4426950408889634f * a)); }

constexpr int WTAB_OFF = EXTRA_OFF + 4096 + 256;
__device__ __forceinline__ unsigned mk_hwslot() { return (unsigned)__builtin_amdgcn_s_getreg((5 << 11) | 4) & 63u; }
#ifndef MK_HWTID
#define MK_HWTID 1
#endif
__device__ __forceinline__ int mk_tid(LAS unsigned char* lds) {
    if (!MK_HWTID) { int t = threadIdx.x; asm volatile("" : "+v"(t)); return t; }
    const int w = __builtin_amdgcn_readfirstlane((int)((volatile LAS unsigned char*)(lds + WTAB_OFF))[mk_hwslot()]);
    int l; asm volatile("v_mbcnt_lo_u32_b32 %0, -1, 0\n\tv_mbcnt_hi_u32_b32 %0, -1, %0" : "=v"(l));
    return w * 64 + l;
}
namespace pg8 {
constexpr int BM = 256, BK = 64, HALF = 128, HTB = HALF * BK * 2, STAGE_BYTES = 8 * HTB, NXCD = 8, WGM = 8;
__host__ __device__ __forceinline__ int lds_byte(int r, int c) { const int st = (r >> 4) * 2 + (c >> 5), rr = r & 15, cc = c & 31, ob = rr * 64 + cc * 2; return st * 1024 + (ob ^ (((ob >> 9) & 1) << 5)); }
__host__ __device__ __forceinline__ void stage_rc(int b, int& R, int& C) { const int st = b / 1024, sb = b % 1024, swz = sb ^ (((sb >> 9) & 1) << 5); R = (st >> 1) * 16 + swz / 64; C = (st & 1) * 32 + (swz % 64) / 2; }
__host__ __device__ __forceinline__ int perm32(int rho) { const int n = rho >> 4, i = rho & 15; return 8 * (i >> 2) + 4 * n + (i & 3); }

struct Unit { unsigned Ao, Bo; int pm, pn, e, pos0, ce; };

struct StaticOrder {
    int nM, nN, nwg, G, c, K, esz; const char* A; const char* Bt;
    __device__ void init(const void* A_, const void* Bt_, int M, int N, int K_, int G_, int c_, int esz_ = 2) { A = (const char*)A_; Bt = (const char*)Bt_; nM = M / BM; nN = N / BM; nwg = nM * nN; G = G_; c = c_; K = K_; esz = esz_; }
    __device__ bool next(int i, Unit& u) const {
        const long L = (long)i * G + c; if (L >= nwg) return false;
        int wgid = (int)L; { const int q = nwg / NXCD, r = nwg % NXCD, xcd = wgid % NXCD, off = wgid / NXCD; wgid = (xcd < r ? xcd * (q + 1) : r * (q + 1) + (xcd - r) * q) + off; }
        const int nig = WGM * nN, gid = wgid / nig, fm = gid * WGM, gsz = (nM - fm) < WGM ? (nM - fm) : WGM;
        u.pm = fm + ((wgid % nig) % gsz); u.pn = (wgid % nig) / gsz; u.e = 0; u.pos0 = 0; u.ce = 0;
        u.Ao = (unsigned)u.pm * BM * K * (unsigned)esz; u.Bo = (unsigned)u.pn * BM * K * (unsigned)esz; return true;
    }
    __device__ __forceinline__ void fill(const Unit&, LAS unsigned* dst, int tid) const { if (tid < BM) dst[tid] = (unsigned)(tid * K) * (unsigned)esz; }
};
template <bool GATHER, int KK, int ESZ> struct MoeOrder {
    const volatile LAS int* cntl; int G, vcu; const char* A; const char* Bt; const int2* list;
    static constexpr int nN = 8;
    __device__ bool next(int i, Unit& u) const {
        const int q = i * G + vcu; const int rt = q / nN, pn = q - rt * nN;
        if (rt >= 160) return false;
        const int e = __builtin_amdgcn_readfirstlane(cntl[64 + rt]); if (e < 0) return false;
        u.pm = rt; u.pn = pn; u.e = e; u.pos0 = __builtin_amdgcn_readfirstlane(cntl[224 + rt]); u.ce = __builtin_amdgcn_readfirstlane(cntl[e]);
        u.Bo = (unsigned)(e * 2048 + pn * BM) * (unsigned)(KK * ESZ); u.Ao = GATHER ? 0u : (unsigned)rt * (unsigned)(BM * KK * ESZ); return true;
    }
    __device__ __forceinline__ void fill(const Unit& u, LAS unsigned* dst, int tid) const {
        if (tid < BM) { if (GATHER) { const int pos = u.pos0 + tid; int tok = 0; if (pos < u.ce) tok = MK_LIST_SYS ? (int)__hip_atomic_load((const unsigned*)((const char*)list + ((size_t)u.e * T + pos) * LIST_ESZ), __ATOMIC_RELAXED, __HIP_MEMORY_SCOPE_SYSTEM) : *(const int*)((const char*)list + ((size_t)u.e * T + pos) * LIST_ESZ); dst[tid] = (unsigned)(tok * KK) * (unsigned)ESZ; } else dst[tid] = (unsigned)(tid * KK) * (unsigned)ESZ; }
    }
};

#ifndef MK_WT
#define MK_WT 0
#endif
struct EpiG1 {
    static constexpr bool PERM = true;
    bf16_t* U5; const float* qg; const float* kg; const float2* rope;
    __device__ __forceinline__ void operator()(const f32x4 (&acc)[2][2][4][2], const Unit& u, int wr, int wc, int fr, int fq) const {
        const int kind = u.pn >> 2, lc0 = (u.pn & 3) * 256 + wc * 64 + 8 * fq, row0 = u.pm * BM + wr * 64 + fr;
        const int lx_ = (fq * 16 + fr) << 2;
#define SX(v, m) __int_as_float(__builtin_amdgcn_ds_bpermute(lx_ ^ ((m) << 2), __float_as_int(v)))
        const __amdgpu_buffer_rsrc_t rsU = __builtin_amdgcn_make_buffer_rsrc((void*)U5, (short)0, 0x7fffffff, 0x00020000);
        constexpr float DS = MK_F8_P1 ? 1.f / (F8_SXN * F8_SWI) : 1.f;
        if (kind == 2 || kind == 3) {
            const float* g = kind == 2 ? qg : kg; const float sc = kind == 2 ? C2 : 1.f;
            f32x4 gv[2][2];
#pragma unroll
            for (int bj = 0; bj < 2; ++bj)
#pragma unroll
                for (int n = 0; n < 2; ++n) gv[bj][n] = *(const f32x4*)(g + 32 * bj + 8 * fq + 4 * n);
#pragma unroll
            for (int ai = 0; ai < 2; ++ai)
#pragma unroll
                for (int m = 0; m < 4; ++m) {
                    const int row = row0 + ai * HALF + m * 16, pos = row & (SEQ - 1);
                    float ss = 0.f;
#pragma unroll
                    for (int bj = 0; bj < 2; ++bj)
#pragma unroll
                        for (int n = 0; n < 2; ++n) { const f32x4 x = acc[ai][bj][m][n] * DS; ss += (x[0] * x[0] + x[1] * x[1]) + (x[2] * x[2] + x[3] * x[3]); }
                    ss += SX(ss, 16); ss += SX(ss, 32);
                    const float rs = rsqrtf(ss * (1.f / 64.f) + EPS) * sc;
                    f32x4 y[2][2];
#pragma unroll
                    for (int bj = 0; bj < 2; ++bj)
#pragma unroll
                        for (int n = 0; n < 2; ++n) y[bj][n] = acc[ai][bj][m][n] * (rs * DS) * gv[bj][n];
                    f32x4 pr[2];
#pragma unroll
                    for (int n = 0; n < 2; ++n)
#pragma unroll
                        for (int e = 0; e < 4; ++e) pr[n][e] = SX(y[0][n][e], 16);
                    if (fq < 2) {
#pragma unroll
                        for (int n = 0; n < 2; ++n) { const f32x4 c01 = *(const f32x4*)(rope + pos * 8 + 4 * n), c23 = *(const f32x4*)(rope + pos * 8 + 4 * n + 2);
                            const float cs[4] = {c01[0], c01[2], c23[0], c23[2]}, sn[4] = {c01[1], c01[3], c23[1], c23[3]};
#pragma unroll
                            for (int e = 0; e < 4; ++e) y[0][n][e] = fq == 0 ? y[0][n][e] * cs[e] - pr[n][e] * sn[e] : y[0][n][e] * cs[e] + pr[n][e] * sn[e]; }
                    }
                    const int vo = ((kind * T + row) * 1024 + lc0) * 2;
#pragma unroll
                    for (int bj = 0; bj < 2; ++bj) { u32x4 w; w.x = cvt_pk_bf16(y[bj][0][0], y[bj][0][1]); w.y = cvt_pk_bf16(y[bj][0][2], y[bj][0][3]); w.z = cvt_pk_bf16(y[bj][1][0], y[bj][1][1]); w.w = cvt_pk_bf16(y[bj][1][2], y[bj][1][3]);
                        __builtin_amdgcn_raw_buffer_store_b128(w, rsU, vo + 64 * bj, 0, MK_WT ? 16 : 0); }
                }
        } else {
#pragma unroll
            for (int ai = 0; ai < 2; ++ai)
#pragma unroll
                for (int m = 0; m < 4; ++m) { const int vo = ((kind * T + row0 + ai * HALF + m * 16) * 1024 + lc0) * 2;
#pragma unroll
                    for (int bj = 0; bj < 2; ++bj) { f32x4 v0 = acc[ai][bj][m][0] * DS, v1 = acc[ai][bj][m][1] * DS;
                        if (kind != 4) {
#pragma unroll
                            for (int e = 0; e < 4; ++e) { v0[e] = fast_gelu(v0[e]); v1[e] = fast_gelu(v1[e]); } }
                        u32x4 w; w.x = cvt_pk_bf16(v0[0], v0[1]); w.y = cvt_pk_bf16(v0[2], v0[3]); w.z = cvt_pk_bf16(v1[0], v1[1]); w.w = cvt_pk_bf16(v1[2], v1[3]);
                        __builtin_amdgcn_raw_buffer_store_b128(w, rsU, vo + 64 * bj, 0, MK_WT ? 16 : 0); } }
        }
    }
};
#undef SX
struct EpiG2 {
    static constexpr bool PERM = false;
    const float* x; float* out; bf16_t* X1B; int skip;
    __device__ __forceinline__ void operator()(const f32x4 (&acc)[2][2][4][2], const Unit& u, int wr, int wc, int fr, int fq) const {
        if (skip == 3) return;
        const __amdgpu_buffer_rsrc_t rsO = __builtin_amdgcn_make_buffer_rsrc((void*)out, (short)0, 0x7fffffff, 0x00020000);
        const int col0 = u.pn * BM + wc * 32 + 4 * fq;
#pragma unroll
        for (int ai = 0; ai < 2; ++ai) {
            f32x4 xv[4][2][2];
#pragma unroll
            for (int m = 0; m < 4; ++m) { const size_t off = (size_t)(u.pm * BM + ai * HALF + wr * 64 + m * 16 + fr) * DM + col0;
#pragma unroll
                for (int bj = 0; bj < 2; ++bj)
#pragma unroll
                    for (int n = 0; n < 2; ++n) xv[m][bj][n] = *(const f32x4*)(x + off + bj * HALF + n * 16); }
            __builtin_amdgcn_sched_barrier(0);
#pragma unroll
            for (int m = 0; m < 4; ++m) { const size_t off = (size_t)(u.pm * BM + ai * HALF + wr * 64 + m * 16 + fr) * DM + col0;
#pragma unroll
                for (int bj = 0; bj < 2; ++bj)
#pragma unroll
                    for (int n = 0; n < 2; ++n) { const size_t o = off + bj * HALF + n * 16;
                        f32x4 v = acc[ai][bj][m][n] + xv[m][bj][n];
                        if (skip == 4) { const f32x4 pv = *(const f32x4*)(out + o); if (pv[0] != v[0] || pv[1] != v[1] || pv[2] != v[2] || pv[3] != v[3]) v[0] += 1.0e6f; }
                        if (!(skip & 1)) { if (MK_WT) __builtin_amdgcn_raw_buffer_store_b128(__builtin_bit_cast(u32x4, v), rsO, (int)(o * 4), 0, 16); else *(f32x4*)(out + o) = v; }
                        if (MK_F8) { if (!(skip & 2)) *(unsigned*)((unsigned char*)X1B + o) = pk4_fp8(v[0] * F8_SX, v[1] * F8_SX, v[2] * F8_SX, v[3] * F8_SX); }
                        else { u32x2 w; w.x = cvt_pk_bf16(v[0], v[1]); w.y = cvt_pk_bf16(v[2], v[3]); *(u32x2*)(X1B + o) = w; } } }
        }
    }
};
#ifndef MK_EPI_DRAIN
#define MK_EPI_DRAIN 1
#endif
#ifndef MK_EPI_BUF
#define MK_EPI_BUF 1
#endif
struct EpiGLU {
    static constexpr bool PERM = true;
    bf16_t* H; const int2* list;
    __device__ __forceinline__ void operator()(const f32x4 (&acc)[2][2][4][2], const Unit& u, int wr, int wc, int fr, int fq) const {
        const __amdgpu_buffer_rsrc_t rsL = __builtin_amdgcn_make_buffer_rsrc((void*)list, (short)0, 0x7fffffff, 0x00020000), rsH = __builtin_amdgcn_make_buffer_rsrc((void*)H, (short)0, 0x7fffffff, 0x00020000);
        constexpr int ESZ = MK_F8 ? 1 : 2;
        const int r0 = wr * 64 + fr, soL = u.e * T * LIST_ESZ, soH = (u.pm * BM * DE + u.pn * 128) * ESZ;
#if MK_F8 && MK_ST16
#pragma unroll
        for (int ai = 0; ai < 2; ++ai)
#pragma unroll
            for (int mp = 0; mp < 4; mp += 2) { u32x2 ch[2];
#pragma unroll
                for (int q = 0; q < 2; ++q) { const int m = mp + q, r = r0 + ai * HALF + m * 16, pos = u.pos0 + r;
                    float rs = __uint_as_float(__builtin_amdgcn_raw_buffer_load_b32(rsL, pos * LIST_ESZ + 4, soL, MK_LIST_SYS ? 17 : 0)); rs = pos < u.ce ? rs : 0.f; rs *= 1.f / (F8_SX * F8_SW);
                    f32x4 h0, h1;
#pragma unroll
                    for (int e = 0; e < 4; ++e) { h0[e] = fast_silu(acc[ai][0][m][0][e] * rs) * (acc[ai][1][m][0][e] * rs); h1[e] = fast_silu(acc[ai][0][m][1][e] * rs) * (acc[ai][1][m][1][e] * rs); }
                    ch[q].x = pk4_fp8(h0[0] * F8_SH, h0[1] * F8_SH, h0[2] * F8_SH, h0[3] * F8_SH); ch[q].y = pk4_fp8(h1[0] * F8_SH, h1[1] * F8_SH, h1[2] * F8_SH, h1[3] * F8_SH); __builtin_amdgcn_sched_barrier(0); }
                const auto sx = __builtin_amdgcn_permlane16_swap(ch[0].x, ch[1].x, false, false), sy = __builtin_amdgcn_permlane16_swap(ch[0].y, ch[1].y, false, false);
                u32x4 w = {sx[0], sy[0], sx[1], sy[1]};
                const int rw = r0 + ai * HALF + (mp + (fq & 1)) * 16;
                __builtin_amdgcn_raw_buffer_store_b128(w, rsH, rw * DE + wc * 32 + 16 * (fq >> 1) + soH, 0, 0);
                __builtin_amdgcn_sched_barrier(0); }
        return;
#endif
#pragma unroll
        for (int ai = 0; ai < 2; ++ai)
#pragma unroll
            for (int m = 0; m < 4; ++m) { const int r = r0 + ai * HALF + m * 16, pos = u.pos0 + r;
                float rs; if (MK_EPI_BUF) { rs = __uint_as_float(__builtin_amdgcn_raw_buffer_load_b32(rsL, pos * LIST_ESZ + 4, soL, MK_LIST_SYS ? 17 : 0)); rs = pos < u.ce ? rs : 0.f; } else rs = pos < u.ce ? __int_as_float(list[(size_t)u.e * T + pos].y) : 0.f;
                if (MK_F8) rs *= 1.f / (F8_SX * F8_SW);
                f32x4 h0, h1;
#pragma unroll
                for (int e = 0; e < 4; ++e) { h0[e] = fast_silu(acc[ai][0][m][0][e] * rs) * (acc[ai][1][m][0][e] * rs); h1[e] = fast_silu(acc[ai][0][m][1][e] * rs) * (acc[ai][1][m][1][e] * rs); }
                const int vo = (r * DE + wc * 32 + 8 * fq) * ESZ;
                if (MK_F8) { u32x2 w; w.x = pk4_fp8(h0[0] * F8_SH, h0[1] * F8_SH, h0[2] * F8_SH, h0[3] * F8_SH); w.y = pk4_fp8(h1[0] * F8_SH, h1[1] * F8_SH, h1[2] * F8_SH, h1[3] * F8_SH);
                    if (MK_EPI_BUF) __builtin_amdgcn_raw_buffer_store_b64(w, rsH, vo + soH, 0, 0); else *(u32x2*)((unsigned char*)H + (size_t)(u.pm * BM + r) * DE + u.pn * 128 + wc * 32 + 8 * fq) = w; }
                else { u32x4 w; w.x = cvt_pk_bf16(h0[0], h0[1]); w.y = cvt_pk_bf16(h0[2], h0[3]); w.z = cvt_pk_bf16(h1[0], h1[1]); w.w = cvt_pk_bf16(h1[2], h1[3]);
                    if (MK_EPI_BUF) __builtin_amdgcn_raw_buffer_store_b128(w, rsH, vo + soH, 0, 0); else *(u32x4*)(H + (size_t)(u.pm * BM + r) * DE + u.pn * 128 + wc * 32 + 8 * fq) = w; } }
    }
};
#ifndef MK_Y8
#define MK_Y8 1
#endif
constexpr float F8_SY = 64.f;
struct EpiY {
    static constexpr bool PERM = true;
    bf16_t* Y; int skip;
    __device__ __forceinline__ void operator()(const f32x4 (&acc)[2][2][4][2], const Unit& u, int wr, int wc, int fr, int fq) const {
        if (skip) return;
        const __amdgpu_buffer_rsrc_t rsY = __builtin_amdgcn_make_buffer_rsrc((void*)Y, (short)0, 0x7fffffff, 0x00020000);
        const int soY = (u.pm * BM * 2048 + u.pn * BM) * 2; const float sc = MK_F8 ? 1.f / (F8_SH * F8_SD) : 1.f;
#if MK_Y8 && MK_ST16
        {   constexpr float s8 = (MK_F8 ? 1.f / (F8_SH * F8_SD) : 1.f) * F8_SY;
#pragma unroll
            for (int ai = 0; ai < 2; ++ai)
#pragma unroll
                for (int mp = 0; mp < 4; mp += 2)
#pragma unroll
                    for (int bj = 0; bj < 2; ++bj) {
                        unsigned sxa, sxb, sya, syb;
                        { const f32x4 p0 = acc[ai][bj][mp][0], p1 = acc[ai][bj][mp + 1][0];
                          const auto sx = __builtin_amdgcn_permlane16_swap(pk4_fp8(p0[0] * s8, p0[1] * s8, p0[2] * s8, p0[3] * s8), pk4_fp8(p1[0] * s8, p1[1] * s8, p1[2] * s8, p1[3] * s8), false, false); sxa = sx[0]; sxb = sx[1]; }
                        __builtin_amdgcn_sched_barrier(0);
                        { const f32x4 p0 = acc[ai][bj][mp][1], p1 = acc[ai][bj][mp + 1][1];
                          const auto sy = __builtin_amdgcn_permlane16_swap(pk4_fp8(p0[0] * s8, p0[1] * s8, p0[2] * s8, p0[3] * s8), pk4_fp8(p1[0] * s8, p1[1] * s8, p1[2] * s8, p1[3] * s8), false, false); sya = sy[0]; syb = sy[1]; }
                        u32x4 w = {sxa, sya, sxb, syb};
                        const int rw = ai * HALF + wr * 64 + (mp + (fq & 1)) * 16 + fr;
                        __builtin_amdgcn_raw_buffer_store_b128(w, rsY, rw * 2048 + wc * 32 + 16 * (fq >> 1) + bj * HALF + (soY >> 1), 0, 0);
                        __builtin_amdgcn_sched_barrier(0); }
            return; }
#endif
#pragma unroll
        for (int ai = 0; ai < 2; ++ai)
#pragma unroll
            for (int m = 0; m < 4; ++m) { const int vo = ((ai * HALF + wr * 64 + m * 16 + fr) * 2048 + wc * 32 + 8 * fq) * 2;
#pragma unroll
                for (int bj = 0; bj < 2; ++bj) {
                    if (MK_Y8) { constexpr float s8 = (MK_F8 ? 1.f / (F8_SH * F8_SD) : 1.f) * F8_SY; const f32x4 a0 = acc[ai][bj][m][0], a1 = acc[ai][bj][m][1];
                        u32x2 w8; w8.x = pk4_fp8(a0[0] * s8, a0[1] * s8, a0[2] * s8, a0[3] * s8); w8.y = pk4_fp8(a1[0] * s8, a1[1] * s8, a1[2] * s8, a1[3] * s8);
                        __builtin_amdgcn_raw_buffer_store_b64(w8, rsY, (vo >> 1) + bj * HALF + (soY >> 1), 0, 0);
                        __builtin_amdgcn_sched_barrier(0);
                    } else { const f32x4 v0 = acc[ai][bj][m][0] * sc, v1 = acc[ai][bj][m][1] * sc;
                    u32x4 w; w.x = cvt_pk_bf16(v0[0], v0[1]); w.y = cvt_pk_bf16(v0[2], v0[3]); w.z = cvt_pk_bf16(v1[0], v1[1]); w.w = cvt_pk_bf16(v1[2], v1[3]);
                    if (MK_EPI_BUF) __builtin_amdgcn_raw_buffer_store_b128(w, rsY, vo + bj * HALF * 2 + soY, 0, 0); else *(u32x4*)(Y + (size_t)(u.pm * BM + ai * HALF + wr * 64 + m * 16 + fr) * 2048 + u.pn * BM + wc * 32 + 8 * fq + bj * HALF) = w; } } }
    }
};

template <class Epi, class Sched, bool ALIGN_EPI, bool F8 = false>
__device__ __forceinline__ void gemm_phase(LAS unsigned char* lds, LAS unsigned* rtab  , const int K, const Sched& S, const Epi& E) {
    const int tid = mk_tid(lds), wid = __builtin_amdgcn_readfirstlane(tid >> 6), lane = tid & 63, wr = wid >> 2, wc = wid & 3, fr = lane & 15, fq = lane >> 4;
    const int nt = F8 ? K / 128 : K / BK;
    unsigned voffB[2], rcA[2];
#pragma unroll
    for (int i = 0; i < 2; ++i) { int R, C; stage_rc(tid * 16 + i * 8192, R, C); const int Rb = Epi::PERM ? ((R & ~31) + perm32(R & 31)) : R; voffB[i] = F8 ? (unsigned)(Rb * K + 2 * C) : (unsigned)(Rb * K + C) * 2u; rcA[i] = (unsigned)(R * 4) | ((unsigned)(C * 2) << 16); }
    const unsigned kstep = (unsigned)(BK * 2), hstep = F8 ? (unsigned)(HALF * K) : (unsigned)(HALF * K * 2);
    const unsigned ldsw = (unsigned)wid * 1024u;
    const int aoff = F8 ? lds_byte(wr * 64 + fr, fq * 16) : lds_byte(wr * 64 + fr, fq * 8), boff = F8 ? lds_byte(wc * 32 + fr, fq * 16) : lds_byte(wc * 32 + fr, fq * 8);
#define PG8_SA(b, h) (((b) * 2 + (h)) * HTB)
#define PG8_SB(b, h) ((4 + (b) * 2 + (h)) * HTB)
#define PG8_STAGE(bufoff, so, voff) do { const char* _gb = (const char*)S.Bt + (so); asm volatile("" : "+s"(_gb)); _Pragma("unroll") for (int _i = 0; _i < 2; ++_i) { unsigned _vb = (voff)[_i]; asm volatile("" : "+v"(_vb)); \
        __builtin_amdgcn_global_load_lds((const unsigned*)(_gb + _vb), (LAS unsigned*)(lds + (bufoff) + ldsw + _i * 8192), 16, 0, 0); } } while (0)
#define PG8_STAGE_A(bufoff, so, tb, h) do { const char* _ga = (const char*)S.A + (so); asm volatile("" : "+s"(_ga)); unsigned _tbo = (unsigned)((tb) * 1024 + (h) * 512); if (MK_TBO) asm volatile("" : "+s"(_tbo));        \
        _Pragma("unroll") for (int _i = 0; _i < 2; ++_i) { \
        const unsigned _ro = *(const LAS unsigned*)((const LAS unsigned char*)rtab + _tbo + (rcA[_i] & 0xffffu)) + (rcA[_i] >> 16); \
        __builtin_amdgcn_global_load_lds((const unsigned*)(_ga + _ro), (LAS unsigned*)(lds + (bufoff) + ldsw + _i * 8192), 16, 0, 0); } } while (0)
#define PG8_CAT8(lo, hi) __builtin_shufflevector(__builtin_bit_cast(i32x4, lo), __builtin_bit_cast(i32x4, hi), 0, 1, 2, 3, 4, 5, 6, 7)
#define PG8_LDA(dst, b, h) do { _Pragma("unroll") for (int m = 0; m < 4; ++m) { if constexpr (F8) dst##8[m] = PG8_CAT8(*(const LAS bf16x8*)(lds + PG8_SA(b, h) + aoff + m * 2048), *(const LAS bf16x8*)(lds + PG8_SA(b, h) + aoff + m * 2048 + 16)); \
        else { _Pragma("unroll") for (int k = 0; k < 2; ++k) dst[m][k] = *(const LAS bf16x8*)(lds + PG8_SA(b, h) + aoff + m * 2048 + k * 1024); } } } while (0)
#define PG8_LDB(dst, b, h) do { _Pragma("unroll") for (int n = 0; n < 2; ++n) { if constexpr (F8) dst##8[n] = PG8_CAT8(*(const LAS bf16x8*)(lds + PG8_SB(b, h) + boff + n * 2048), *(const LAS bf16x8*)(lds + PG8_SB(b, h) + boff + n * 2048 + 16)); \
        else { _Pragma("unroll") for (int k = 0; k < 2; ++k) dst[n][k] = *(const LAS bf16x8*)(lds + PG8_SB(b, h) + boff + n * 2048 + k * 1024); } } } while (0)
#define PG8_MMA(ai, bj, At, Bt) do { __builtin_amdgcn_s_setprio(1); _Pragma("unroll") for (int m = 0; m < 4; ++m) _Pragma("unroll") for (int n = 0; n < 2; ++n) { \
        if constexpr (F8) acc[ai][bj][m][n] = __builtin_amdgcn_mfma_scale_f32_16x16x128_f8f6f4(Bt##8[n], At##8[m], acc[ai][bj][m][n], 0, 0, 0, 0x7f7f7f7f, 0, 0x7f7f7f7f); \
        else { _Pragma("unroll") for (int k = 0; k < 2; ++k) acc[ai][bj][m][n] = __builtin_amdgcn_mfma_f32_16x16x32_bf16(Bt[n][k], At[m][k], acc[ai][bj][m][n], 0, 0, 0); } } __builtin_amdgcn_s_setprio(0); } while (0)
#define PG8_WAIT_V(n) asm volatile("s_waitcnt vmcnt(" #n ")" ::: "memory")
#ifndef MK_F8_DRAIN
#define MK_F8_DRAIN 0
#endif
#define PG8_WAIT_VK do { if (F8 && MK_F8_DRAIN) PG8_WAIT_V(0); else PG8_WAIT_V(8); } while (0)
#define PG8_WAIT_L(n) asm volatile("s_waitcnt lgkmcnt(" #n ")" ::: "memory")
#define PG8_BAR __builtin_amdgcn_s_barrier()
#define PG8_SCHED __builtin_amdgcn_sched_barrier(0)
    Unit cur, nxt; int ui = 0;
    if (!S.next(0, cur)) return;
    f32x4 acc[2][2][4][2];
#pragma unroll
    for (int a = 0; a < 2; ++a)
#pragma unroll
        for (int b = 0; b < 2; ++b)
#pragma unroll
            for (int m = 0; m < 4; ++m)
#pragma unroll
                for (int n = 0; n < 2; ++n) acc[a][b][m][n] = (f32x4){0.f, 0.f, 0.f, 0.f};
    bf16x8 At[4][2], B0[2][2], B1[2][2]; i32x8 At8[4], B08[2], B18[2];
    S.fill(cur, rtab, tid);
    asm volatile("s_waitcnt lgkmcnt(0)" ::: "memory"); PG8_BAR; asm volatile("" ::: "memory");
    unsigned cA = cur.Ao, cB = cur.Bo;
    PG8_STAGE(PG8_SB(0, 0), cB, voffB); PG8_STAGE(PG8_SB(0, 1), cB + hstep, voffB); PG8_STAGE_A(PG8_SA(0, 0), cA, 0, 0); PG8_STAGE_A(PG8_SA(0, 1), cA, 0, 1);
    if (wr == 1) PG8_BAR;
    PG8_WAIT_V(2); PG8_BAR;
    PG8_STAGE(PG8_SB(1, 0), cB + kstep, voffB); PG8_STAGE_A(PG8_SA(1, 0), cA + kstep, 0, 0); PG8_STAGE(PG8_SB(1, 1), cB + hstep + kstep, voffB);
    PG8_WAIT_V(6); PG8_BAR;
    for (;;) {
        const bool has_next = S.next(ui + 1, nxt);
        const unsigned nA = has_next ? nxt.Ao : cA, nB = has_next ? nxt.Bo : cB;
        const int tbc = ui & 1, tbn = has_next ? (tbc ^ 1) : tbc;
        if (has_next) S.fill(nxt, rtab + tbn * 256, mk_tid(lds));
#pragma unroll 1
        for (int t = 0; t < nt; t += 2) {
            const bool last = (t == nt - 2);
            unsigned a1 = cA + (unsigned)(t + 1) * kstep;
            unsigned a2 = last ? nA : cA + (unsigned)(t + 2) * kstep, b2 = last ? nB : cB + (unsigned)(t + 2) * kstep;
            unsigned a3 = a2 + kstep, b3 = b2 + kstep;
            asm volatile("" : "+s"(a1), "+s"(a2), "+s"(a3), "+s"(b2), "+s"(b3));
            const int tb2 = last ? tbn : tbc;
            PG8_LDB(B0, 0, 0); PG8_LDB(B1, 0, 1); PG8_SCHED; PG8_LDA(At, 0, 0); PG8_STAGE_A(PG8_SA(1, 1), a1, tbc, 1);
            PG8_WAIT_VK; PG8_WAIT_L(0); PG8_BAR; PG8_MMA(0, 0, At, B0); PG8_MMA(0, 1, At, B1); PG8_BAR; PG8_SCHED;
            PG8_LDA(At, 0, 1); PG8_STAGE(PG8_SB(0, 0), b2, voffB); PG8_STAGE(PG8_SB(0, 1), b2 + hstep, voffB); PG8_STAGE_A(PG8_SA(0, 0), a2, tb2, 0);
            PG8_WAIT_VK; PG8_WAIT_L(0); PG8_BAR; PG8_MMA(1, 0, At, B0); PG8_MMA(1, 1, At, B1); PG8_BAR; PG8_SCHED;
            PG8_LDB(B0, 1, 0); PG8_LDB(B1, 1, 1); PG8_SCHED; PG8_LDA(At, 1, 0); PG8_STAGE_A(PG8_SA(0, 1), a2, tb2, 1);
            PG8_WAIT_VK; PG8_WAIT_L(0); PG8_BAR; PG8_MMA(0, 0, At, B0); PG8_MMA(0, 1, At, B1); PG8_BAR; PG8_SCHED;
            PG8_LDA(At, 1, 1); PG8_STAGE(PG8_SB(1, 0), b3, voffB); PG8_STAGE(PG8_SB(1, 1), b3 + hstep, voffB); PG8_STAGE_A(PG8_SA(1, 0), a3, tb2, 0);
            PG8_WAIT_VK; PG8_WAIT_L(0); PG8_BAR; PG8_MMA(1, 0, At, B0); PG8_MMA(1, 1, At, B1); PG8_BAR; PG8_SCHED;
        }
        if constexpr (ALIGN_EPI) { if (wr == 0) PG8_BAR; }
        { int te = mk_tid(lds); asm volatile("" : "+v"(te)); const int le = te & 63; E(acc, cur, wr, wc, le & 15, le >> 4); }
        if (!has_next) break;
        if (MK_EPI_DRAIN) PG8_WAIT_V(0);
#pragma unroll
        for (int a = 0; a < 2; ++a)
#pragma unroll
            for (int b = 0; b < 2; ++b)
#pragma unroll
                for (int m = 0; m < 4; ++m)
#pragma unroll
                    for (int n = 0; n < 2; ++n) acc[a][b][m][n] = (f32x4){0.f, 0.f, 0.f, 0.f};
        cur = nxt; cA = nA; cB = nB; ++ui;
        if constexpr (ALIGN_EPI) { if (wr == 1) PG8_BAR; }
    }
    PG8_WAIT_V(0);
    if constexpr (!ALIGN_EPI) { if (wr == 0) PG8_BAR; }
    PG8_BAR;
#undef PG8_SA
#undef PG8_SB
#undef PG8_STAGE
#undef PG8_STAGE_A
#undef PG8_LDA
#undef PG8_LDB
#undef PG8_MMA
#undef PG8_CAT8
#undef PG8_WAIT_V
#undef PG8_WAIT_VK
#undef PG8_WAIT_L
#undef PG8_BAR
#undef PG8_SCHED
}
}


namespace dattn {
using s16x4 = __attribute__((ext_vector_type(4))) short;
using f32x16 = __attribute__((ext_vector_type(16))) float;
constexpr int KVB = 64, NT = SEQ / KVB;
constexpr int L_V = 0, L_K = 32768, L_Q = 65536, L_SC = EXTRA_OFF;
#define SBAR() __builtin_amdgcn_sched_barrier(0)
#ifndef MK_ATT_SBAR
#define MK_ATT_SBAR 1
#endif
#define ABAR() do { if (MK_ATT_SBAR) __builtin_amdgcn_sched_barrier(0); } while (0)
__device__ __forceinline__ int crow(int r, int hi) { return (r & 3) + 8 * (r >> 2) + 4 * hi; }
__device__ __forceinline__ int v_rd_base(int lane) { return ((lane & 3) << 3) | (((lane >> 2) & 3) << 6) | (((lane >> 4) & 1) << 5) | (((lane >> 5) & 1) << 8); }
constexpr int v_rd_off(int d0, int ks, int half) { return d0 * 512 + ks * 4096 + half * 2048; }
template <int OFF> __device__ __forceinline__ s16x4 tr_read(int vb) { s16x4 r; asm volatile("ds_read_b64_tr_b16 %0, %1 offset:%2" : "=&v"(r) : "v"(vb), "i"(OFF) : "memory"); return r; }
__device__ __forceinline__ unsigned hk_src(int L, int colbase) { const int row = L >> 7, ch = ((L & 127) >> 4) ^ ((row >> 1) & 7); return (unsigned)(row * 1024 + colbase + ch * 8) * 2u; }
__device__ __forceinline__ unsigned v_src(int L, int colbase) { const int st = L >> 9, rem = L & 511, kk = ((st >> 2) << 3) | (rem >> 6), k = (kk & ~0xC) | ((kk & 4) << 1) | ((kk & 8) >> 1), c = (st & 3) * 32 + ((rem & 63) >> 1); return (unsigned)(k * 1024 + colbase + c) * 2u; }

#ifndef MK_QREG
#define MK_QREG 1
#endif
__device__ __forceinline__ void qk(f32x16& p0, f32x16& p1, const LAS char* Kb, const LAS char* Qh, const int (&ab)[4], const bf16x8 (&qf)[4]) {
#pragma unroll
    for (int d = 0; d < 4; ++d) {
        const bf16x8 q = MK_QREG ? qf[d] : *(const LAS bf16x8*)(Qh + ab[d]);
        const bf16x8 b0 = *(const LAS bf16x8*)(Kb + ab[d]), b1 = *(const LAS bf16x8*)(Kb + ab[d] + 4096);
        if (d == 0) { const f32x16 z = {}; p0 = __builtin_amdgcn_mfma_f32_32x32x16_bf16(b0, q, z, 0, 0, 0); p1 = __builtin_amdgcn_mfma_f32_32x32x16_bf16(b1, q, z, 0, 0, 0); }
        else { p0 = __builtin_amdgcn_mfma_f32_32x32x16_bf16(b0, q, p0, 0, 0, 0); p1 = __builtin_amdgcn_mfma_f32_32x32x16_bf16(b1, q, p1, 0, 0, 0); } }
}
__device__ __forceinline__ void sm_pack(f32x16& p0, f32x16& p1, float& l, bf16x8& a0, bf16x8& a1, bf16x8& a2, bf16x8& a3) {
#pragma unroll
    for (int r = 0; r < 16; ++r) { p0[r] = __builtin_amdgcn_exp2f(p0[r]); p1[r] = __builtin_amdgcn_exp2f(p1[r]); }
    float s0 = 0.f, s1 = 0.f;
#pragma unroll
    for (int r = 0; r < 16; ++r) { s0 += p0[r]; s1 += p1[r]; }
    l += s0 + s1;
#define PK4(P, BASE, OUT) do { const unsigned a0_ = cvt_pk_bf16(P[BASE + 0], P[BASE + 1]), a1_ = cvt_pk_bf16(P[BASE + 2], P[BASE + 3]);   \
    const unsigned b0_ = cvt_pk_bf16(P[BASE + 4], P[BASE + 5]), b1_ = cvt_pk_bf16(P[BASE + 6], P[BASE + 7]);                              \
    auto r0_ = __builtin_amdgcn_permlane32_swap(a0_, b0_, false, false); auto r1_ = __builtin_amdgcn_permlane32_swap(a1_, b1_, false, false); \
    u32x4 w_ = {r0_[0], r1_[0], r0_[1], r1_[1]}; OUT = __builtin_bit_cast(bf16x8, w_); } while (0)
    PK4(p0, 0, a0); PK4(p0, 8, a1); PK4(p1, 0, a2); PK4(p1, 8, a3);
#undef PK4
}
template <int D0> __device__ __forceinline__ void pv1(f32x16& o, int vb, bf16x8 a0, bf16x8 a1, bf16x8 a2, bf16x8 a3) {
    const s16x4 l0 = tr_read<v_rd_off(D0, 0, 0)>(vb), h0 = tr_read<v_rd_off(D0, 0, 1)>(vb), l1 = tr_read<v_rd_off(D0, 1, 0)>(vb), h1 = tr_read<v_rd_off(D0, 1, 1)>(vb);
    const s16x4 l2 = tr_read<v_rd_off(D0, 2, 0)>(vb), h2 = tr_read<v_rd_off(D0, 2, 1)>(vb), l3 = tr_read<v_rd_off(D0, 3, 0)>(vb), h3 = tr_read<v_rd_off(D0, 3, 1)>(vb);
    asm volatile("s_waitcnt lgkmcnt(0)" ::: "memory"); SBAR();
#define PK(L, H) (bf16x8){L[0], L[1], L[2], L[3], H[0], H[1], H[2], H[3]}
    o = __builtin_amdgcn_mfma_f32_32x32x16_bf16(a0, PK(l0, h0), o, 0, 0, 0); o = __builtin_amdgcn_mfma_f32_32x32x16_bf16(a1, PK(l1, h1), o, 0, 0, 0);
    o = __builtin_amdgcn_mfma_f32_32x32x16_bf16(a2, PK(l2, h2), o, 0, 0, 0); o = __builtin_amdgcn_mfma_f32_32x32x16_bf16(a3, PK(l3, h3), o, 0, 0, 0);
#undef PK
}
typedef short v4i16_t __attribute__((ext_vector_type(4)));
__device__ __forceinline__ s16x4 vtr(const LAS char* p) { return __builtin_bit_cast(s16x4, __builtin_amdgcn_ds_read_tr16_b64_v4i16((LAS v4i16_t*)p)); }
__device__ __forceinline__ void sm_half(f32x16& p, float& l, bf16x8& aL, bf16x8& aH) {
#pragma unroll
    for (int r = 0; r < 16; ++r) p[r] = __builtin_amdgcn_exp2f(p[r]);
    float s0 = 0.f;
#pragma unroll
    for (int r = 0; r < 16; ++r) s0 += p[r];
    l += s0;
#define PK4(P, BASE, OUT) do { const unsigned a0_ = cvt_pk_bf16(P[BASE + 0], P[BASE + 1]), a1_ = cvt_pk_bf16(P[BASE + 2], P[BASE + 3]);   \
    const unsigned b0_ = cvt_pk_bf16(P[BASE + 4], P[BASE + 5]), b1_ = cvt_pk_bf16(P[BASE + 6], P[BASE + 7]);                              \
    auto r0_ = __builtin_amdgcn_permlane32_swap(a0_, b0_, false, false); auto r1_ = __builtin_amdgcn_permlane32_swap(a1_, b1_, false, false); \
    u32x4 w_ = {r0_[0], r1_[0], r0_[1], r1_[1]}; OUT = __builtin_bit_cast(bf16x8, w_); } while (0)
    PK4(p, 0, aL); PK4(p, 8, aH);
#undef PK4
}
#ifndef MK_ATT_PRIO
#define MK_ATT_PRIO 0
#endif
template <int KS0> __device__ __forceinline__ void pv_half(f32x16 (&o)[4], const LAS char* vp, bf16x8 aL, bf16x8 aH) {
    if (MK_ATT_PRIO) __builtin_amdgcn_s_setprio(1);
#define PK(L, H) (bf16x8){L[0], L[1], L[2], L[3], H[0], H[1], H[2], H[3]}
#pragma unroll
    for (int d = 0; d < 4; ++d) {
        const s16x4 l0 = vtr(vp + v_rd_off(d, KS0, 0)), h0 = vtr(vp + v_rd_off(d, KS0, 1)), l1 = vtr(vp + v_rd_off(d, KS0 + 1, 0)), h1 = vtr(vp + v_rd_off(d, KS0 + 1, 1));
        o[d] = __builtin_amdgcn_mfma_f32_32x32x16_bf16(aL, PK(l0, h0), o[d], 0, 0, 0); o[d] = __builtin_amdgcn_mfma_f32_32x32x16_bf16(aH, PK(l1, h1), o[d], 0, 0, 0); }
#undef PK
    if (MK_ATT_PRIO) __builtin_amdgcn_s_setprio(0);
}
#define DGLDS(gp, loff) __builtin_amdgcn_global_load_lds((const unsigned*)(gp), (LAS unsigned*)(lds + (loff)), 16, 0, 0)

template <int CH> __device__ __forceinline__ void attn_pass(LAS unsigned char* lds, const char* Kg, const char* Vg, f32x16 (&o)[4], float& l, int wid, int lane, int h, const int (&ab)[4]) {
    unsigned ksrc, vsrc[2];
    { const int L = wid * 1024 + lane * 16; ksrc = hk_src(L, h * 128 + CH * 64); }
#pragma unroll
    for (int i = 0; i < 2; ++i) { const int L = (wid * 2 + i) * 1024 + lane * 16; vsrc[i] = v_src(L, h * 128); }
    constexpr size_t TSTEP = (size_t)KVB * 1024 * 2;
#define STAGE_K(t) DGLDS(Kg + (size_t)(t) * TSTEP + ksrc, L_K + ((t) & 1) * 8192 + wid * 1024)
#define STAGE_V(t) do { _Pragma("unroll") for (int i_ = 0; i_ < 2; ++i_) DGLDS(Vg + (size_t)(t) * TSTEP + vsrc[i_], L_V + ((t) & 1) * 16384 + (wid * 2 + i_) * 1024); } while (0)
#define TOP_BAR() do { asm volatile("s_waitcnt vmcnt(0)" ::: "memory"); __syncthreads(); } while (0)
    const LAS char* Qh = (const LAS char*)(lds + L_Q + wid * 8192 + CH * 4096);
    const LAS char* K0 = (const LAS char*)(lds + L_K); const LAS char* K1 = K0 + 8192;
    const LAS char* vb0 = (const LAS char*)(lds + L_V) + v_rd_base(lane); const LAS char* vb1 = vb0 + 16384;
    f32x16 pA0, pA1, pB0, pB1; bf16x8 a0, a1, a2, a3;
    TOP_BAR();
    STAGE_K(0); STAGE_V(0);
    TOP_BAR();
    bf16x8 qf[4];
#pragma unroll
    for (int d = 0; d < 4; ++d) qf[d] = *(const LAS bf16x8*)(Qh + ab[d]);
    qk(pA0, pA1, K0, Qh, ab, qf);
    STAGE_K(1);
#define STEP(PC0, PC1, PN0, PN1, j, KNEXT, VBUF, DO_K, DO_V) do { \
        TOP_BAR(); \
        if (DO_K) STAGE_K((j) + 2); \
        if (DO_V) { STAGE_V((j) + 1); qk(PN0, PN1, KNEXT, Qh, ab, qf); } \
        sm_half(PC0, l, a0, a1); ABAR();            \
        pv_half<0>(o, VBUF, a0, a1); \
        sm_half(PC1, l, a2, a3); ABAR();            \
        pv_half<2>(o, VBUF, a2, a3); ABAR();        \
    } while (0)
    for (int j = 0; j < NT - 2; j += 2) {
        STEP(pA0, pA1, pB0, pB1, j, K1, vb0, true, true);
        STEP(pB0, pB1, pA0, pA1, j + 1, K0, vb1, true, true);
    }
    STEP(pA0, pA1, pB0, pB1, NT - 2, K1, vb0, false, true);
    STEP(pB0, pB1, pA0, pA1, NT - 1, K0, vb1, false, false);
#undef STEP
#undef STAGE_K
#undef STAGE_V
#undef TOP_BAR
}

__device__ __forceinline__ void attn_unit(LAS unsigned char* lds, int b, int h, int qb, const bf16_t* QN, const bf16_t* KN, const bf16_t* VB, bf16_t* MIX, const float* subg, float lam) {
    int tid = mk_tid(lds); asm volatile("" : "+v"(tid));
    const int lane = tid & 63, r32 = lane & 31, hi = lane >> 5; const int wid = __builtin_amdgcn_readfirstlane(tid >> 6);
    const size_t rowbase = (size_t)b * SEQ; const int q0 = qb * 256;
    const char* Kg = (const char*)(KN + rowbase * 1024); const char* Vg = (const char*)(VB + rowbase * 1024); const char* Qg = (const char*)(QN + (rowbase + q0 + wid * 32) * 1024);
    __syncthreads();
#pragma unroll
    for (int i = 0; i < 8; ++i) { const int L = (i & 3) * 1024 + lane * 16; DGLDS(Qg + hk_src(L, h * 128 + (i >> 2) * 64), L_Q + wid * 8192 + i * 1024); }
    int ab[4];
#pragma unroll
    for (int d = 0; d < 4; ++d) ab[d] = r32 * 128 + ((d * 32 + hi * 16) ^ (((r32 >> 1) & 7) << 4));
    LAS float* sc = (LAS float*)(lds + L_SC) + wid * 64;
    f32x16 o[4]; float l = 0.f;
#pragma unroll
    for (int d = 0; d < 4; ++d) o[d] = f32x16{};
    attn_pass<0>(lds, Kg, Vg, o, l, wid, lane, h, ab);
    { auto rr = __builtin_amdgcn_permlane32_swap(__float_as_uint(l), __float_as_uint(l), false, false); l = __uint_as_float(rr[0]) + __uint_as_float(rr[1]); }
    if (hi == 0) sc[r32] = 1.f / l;
    asm volatile("s_waitcnt lgkmcnt(0)" ::: "memory");
    LAS unsigned* park0 = (LAS unsigned*)(lds + L_Q + wid * 8192) + lane;
    LAS unsigned* park1 = (LAS unsigned*)(lds + 135680 + wid * 3072) + lane;
    unsigned keep[4];
#pragma unroll
    for (int r = 0; r < 16; r += 2) { const float i0 = sc[crow(r, hi)], i1 = sc[crow(r + 1, hi)];
#pragma unroll
        for (int d = 0; d < 4; ++d) { const unsigned w = cvt_pk_bf16(o[d][r] * i0, o[d][r + 1] * i1); const int j = d * 8 + (r >> 1); if (j < 16) park0[64 * j] = w; else if (j < 28) park1[64 * (j - 16)] = w; else keep[j - 28] = w; } }
#pragma unroll
    for (int d = 0; d < 4; ++d) o[d] = f32x16{};
    l = 0.f;
    attn_pass<1>(lds, Kg, Vg, o, l, wid, lane, h, ab);
    { auto rr = __builtin_amdgcn_permlane32_swap(__float_as_uint(l), __float_as_uint(l), false, false); l = __uint_as_float(rr[0]) + __uint_as_float(rr[1]); }
    if (hi == 0) sc[32 + r32] = lam / l;
    asm volatile("s_waitcnt lgkmcnt(0)" ::: "memory");
    float ss[16];
#pragma unroll
    for (int r = 0; r < 16; ++r) { const float i2 = sc[32 + crow(r, hi)]; float s = 0.f;
#pragma unroll
        for (int d = 0; d < 4; ++d) { const int j = d * 8 + (r >> 1); const unsigned w = j < 16 ? park0[64 * j] : (j < 28 ? park1[64 * (j - 16)] : keep[j - 28]); const float o1n = (r & 1) ? bf2f(w >> 16) : bf2f(w & 0xffffu); const float v = o1n - o[d][r] * i2; o[d][r] = v; s += v * v; }
        ss[r] = s; }
#pragma unroll
    for (int r = 0; r < 16; ++r) { float s = ss[r]; s += __shfl_xor(s, 1); s += __shfl_xor(s, 2); s += __shfl_xor(s, 4); s += __shfl_xor(s, 8); s += __shfl_xor(s, 16); ss[r] = rsqrtf(s * (1.f / 128.f) + EPS) * 0.8f; }
    asm volatile("s_waitcnt lgkmcnt(0)" ::: "memory");
    LAS bf16_t* stg = (LAS bf16_t*)(lds + L_Q + wid * 8192);
#pragma unroll
    for (int d = 0; d < 4; ++d) { const float g = subg[d * 32 + r32];
#pragma unroll
        for (int r = 0; r < 16; ++r) stg[crow(r, hi) * 128 + d * 32 + r32] = (bf16_t)f2bf(o[d][r] * ss[r] * g); }
    asm volatile("s_waitcnt lgkmcnt(0)" ::: "memory");
    bf16_t* Ow = MIX + (rowbase + q0 + wid * 32) * DM + 1024 + h * 128;
#pragma unroll
    for (int i = 0; i < 8; ++i) { const int row = i * 4 + (lane >> 4), ch = lane & 15; const u32x4 v = *(const LAS u32x4*)(stg + row * 128 + ch * 8); *(u32x4*)(Ow + (size_t)row * DM + ch * 8) = v; }
    asm volatile("s_waitcnt lgkmcnt(0)" ::: "memory");
}

__device__ __forceinline__ int v_st(int k, int c) { const int kk = (k & ~0xC) | ((k & 4) << 1) | ((k & 8) >> 1); return ((kk >> 3) * 4 + (c >> 5)) * 512 + ((kk & 7) * 32 + (c & 31)) * 2; }
__device__ __forceinline__ void gmlp_pair(LAS unsigned char* lds, int pair, const bf16_t* U, const bf16_t* VG, const bf16_t* WsB, const float* lng, const float* lnb, const float* gbs, bf16_t* MIX) {
    int tid = mk_tid(lds); asm volatile("" : "+v"(tid));
    const int lane = tid & 63, r32 = lane & 31, hi = lane >> 5; const int wid = __builtin_amdgcn_readfirstlane(tid >> 6);
    const int it = pair * 2 + (wid >> 2), ib = wid & 3;
    const int h = it & 7, c = (it >> 3) & 31, b = it >> 8, t0 = b * SEQ + c * 128;
    const int img = (wid >> 2) * 32768;
    __syncthreads();
    {
        const int t = tid & 255, sr = t >> 4, sc = (t & 15) * 8;
        f32x4 g0 = *(const f32x4*)(lng + h * 128 + sc), g1 = *(const f32x4*)(lng + h * 128 + sc + 4), b0 = *(const f32x4*)(lnb + h * 128 + sc), b1 = *(const f32x4*)(lnb + h * 128 + sc + 4);
        uint4 vq[8];
#pragma unroll
        for (int k = 0; k < 8; ++k) vq[k] = *(const uint4*)(VG + (size_t)(t0 + sr + 16 * k) * 1024 + h * 128 + sc);
#pragma unroll
        for (int k = 0; k < 8; ++k) { const int row = sr + 16 * k; float f[8]; unpack8(vq[k], f);
            float s = 0.f;
#pragma unroll
            for (int i = 0; i < 8; ++i) s += f[i];
            s += __shfl_xor(s, 1); s += __shfl_xor(s, 2); s += __shfl_xor(s, 4); s += __shfl_xor(s, 8);
            const float mu = s * (1.f / 128.f); float q = 0.f;
#pragma unroll
            for (int i = 0; i < 8; ++i) { f[i] -= mu; q += f[i] * f[i]; }
            q += __shfl_xor(q, 1); q += __shfl_xor(q, 2); q += __shfl_xor(q, 4); q += __shfl_xor(q, 8);
            const float rs = rsqrtf(q * (1.f / 128.f) + EPS);
            u32x4 w; w.x = cvt_pk_bf16(f[0] * rs * g0[0] + b0[0], f[1] * rs * g0[1] + b0[1]); w.y = cvt_pk_bf16(f[2] * rs * g0[2] + b0[2], f[3] * rs * g0[3] + b0[3]);
            w.z = cvt_pk_bf16(f[4] * rs * g1[0] + b1[0], f[5] * rs * g1[1] + b1[1]); w.w = cvt_pk_bf16(f[6] * rs * g1[2] + b1[2], f[7] * rs * g1[3] + b1[3]);
            *(LAS u32x4*)(lds + img + (row >> 6) * 16384 + v_st(row & 63, sc)) = w; }
    }
    uint4 uq[8];
#pragma unroll
    for (int i = 0; i < 8; ++i) { const int row = i * 4 + (lane >> 4), ch = lane & 15; uq[i] = *(const uint4*)(U + (size_t)(t0 + ib * 32 + row) * 1024 + h * 128 + ch * 8); }
    bf16x8 pa[2][4];
#pragma unroll
    for (int tl = 0; tl < 2; ++tl)
#pragma unroll
        for (int ks = 0; ks < 4; ++ks) pa[tl][ks] = *(const bf16x8*)(WsB + (size_t)h * 16384 + (size_t)(ib * 32 + r32) * 128 + tl * 64 + ks * 16 + hi * 8);
    asm volatile("s_waitcnt lgkmcnt(0)" ::: "memory"); __syncthreads();
    f32x16 o[4];
#pragma unroll
    for (int d = 0; d < 4; ++d) o[d] = f32x16{};
    const int vb = (int)(uintptr_t)(lds + img) + v_rd_base(lane);
#pragma unroll
    for (int tl = 0; tl < 2; ++tl) { const int vbt = vb + tl * 16384;
        pv1<0>(o[0], vbt, pa[tl][0], pa[tl][1], pa[tl][2], pa[tl][3]); pv1<1>(o[1], vbt, pa[tl][0], pa[tl][1], pa[tl][2], pa[tl][3]);
        pv1<2>(o[2], vbt, pa[tl][0], pa[tl][1], pa[tl][2], pa[tl][3]); pv1<3>(o[3], vbt, pa[tl][0], pa[tl][1], pa[tl][2], pa[tl][3]); }
    LAS bf16_t* stg = (LAS bf16_t*)(lds + 65536 + wid * 8192);
#pragma unroll
    for (int r = 0; r < 16; ++r) { const float bsv = gbs[h * 128 + ib * 32 + crow(r, hi)];
#pragma unroll
        for (int d = 0; d < 4; ++d) stg[crow(r, hi) * 128 + d * 32 + r32] = (bf16_t)f2bf(o[d][r] + bsv); }
    asm volatile("s_waitcnt lgkmcnt(0)" ::: "memory");
#pragma unroll
    for (int i = 0; i < 8; ++i) { const int row = i * 4 + (lane >> 4), ch = lane & 15; const size_t trow = (size_t)(t0 + ib * 32 + row);
        float sv[8], uv[8]; { const u32x4 q_ = *(const LAS u32x4*)(stg + row * 128 + ch * 8); uint4 q2_; q2_.x = q_[0]; q2_.y = q_[1]; q2_.z = q_[2]; q2_.w = q_[3]; unpack8(q2_, sv); } unpack8(uq[i], uv);
#pragma unroll
        for (int e = 0; e < 8; ++e) sv[e] *= uv[e];
        *(uint4*)(MIX + trow * DM + h * 128 + ch * 8) = pack8(sv); }
    asm volatile("s_waitcnt lgkmcnt(0)" ::: "memory");
}
#undef DGLDS
#undef SBAR
}

struct MkArgs { const float* in[23]; float* out; unsigned char* ws; int ph_lo, ph_hi; };
typedef const __attribute__((address_space(4))) MkArgs* kargp_t;
constexpr int RTAB_OFF = EXTRA_OFF;
constexpr int CNTL_OFF = EXTRA_OFF + 2048;
constexpr int MISC_OFF = EXTRA_OFF + 4096;

#define XB_TMO      128
#define XB_XCNT(j)  (256  + 64 * (j))
#define XB_XSUB(j)  (1280 + 64 * (j))
#define XB_XGEN(j)  (2304 + 64 * (j))
#define XB_TOP      3328
#define XB_TOPGEN   3392
#define XCD_BAR_WORDS 3456
#define XB_SPIN_CAP (1u << 18)
#ifndef MK_SETTLE2_MASK
#define MK_SETTLE2_MASK 0x6F
#endif
#define MK_REL_DELAY_DEFAULT 1
constexpr int CW_BAR = 4096;
__device__ __forceinline__ unsigned xb_ld(unsigned* p)              { return __hip_atomic_load(p, __ATOMIC_RELAXED, __HIP_MEMORY_SCOPE_AGENT); }
__device__ __forceinline__ unsigned xb_add(unsigned* p, unsigned v) { return __hip_atomic_fetch_add(p, v, __ATOMIC_RELAXED, __HIP_MEMORY_SCOPE_AGENT); }
__device__ __forceinline__ unsigned xb_xcc_id() { return (unsigned)__builtin_amdgcn_s_getreg((3 << 11) | 20) & 0xFu; }
#define XB_SPIN(cond, bar) do { unsigned _sp = 0; while (cond) { __builtin_amdgcn_s_sleep(1); \
    if ((++_sp & 255u) == 0u) { if (xb_ld(&(bar)[XB_TMO])) break; if (_sp > XB_SPIN_CAP) { atomicAdd(&(bar)[XB_TMO], 1u); break; } } } } while (0)
__device__ __forceinline__ void xcd_barrier_complete(unsigned* bar, unsigned x, unsigned& nloc, unsigned& nx) {
    const unsigned G = gridDim.x * gridDim.y * gridDim.z;
    unsigned sum, cnt, mine, sp = 0u;
    for (;;) {
        sum = 0u; cnt = 0u; mine = 0u;
#pragma unroll
        for (unsigned j = 0; j < 16; ++j) { const unsigned c = xb_ld(&bar[XB_XCNT(j)]); sum += c; cnt += (c > 0u) ? 1u : 0u; mine = (j == x) ? c : mine; }
        if (sum == G) break;
        __builtin_amdgcn_s_sleep(1);
        if ((++sp & 255u) == 0u) { if (xb_ld(&bar[XB_TMO])) break; if (sp > XB_SPIN_CAP) { atomicAdd(&bar[XB_TMO], 1u); break; } }
    }
    nloc = mine > 0u ? mine : 1u; nx = cnt > 0u ? cnt : 1u;
}
#ifndef MK_BAR_STRONG
#define MK_BAR_STRONG 0
#endif
__device__ __forceinline__ void xcd_barrier(unsigned* bar, volatile LAS unsigned* st, bool leader  , int settle = MK_REL_DELAY_DEFAULT) {
    if (MK_BAR_STRONG) __builtin_amdgcn_fence(__ATOMIC_RELEASE, "agent");
    asm volatile("s_waitcnt vmcnt(0)" ::: "memory");
    __syncthreads();
    if (leader) {
        __builtin_amdgcn_s_waitcnt(0);
#ifndef MK_EARLY_WB
#define MK_EARLY_WB 0
#endif
        if (MK_EARLY_WB) asm volatile("buffer_wbl2 sc1" ::: "memory");
        const unsigned x = xb_xcc_id();
        unsigned nloc = st[0], nx = st[1];
        if (nloc == 0u) { xcd_barrier_complete(bar, x, nloc, nx); st[0] = nloc; st[1] = nx; }
        const unsigned old = xb_add(&bar[XB_XSUB(x)], 1u);
        const unsigned gen = old / nloc;
        if (old + 1u == (gen + 1u) * nloc) {
#ifndef MK_SYS_ACQ
#define MK_SYS_ACQ 0
#endif
#ifndef MK_SYS_REL
#define MK_SYS_REL 1
#endif
            if (MK_SYS_REL) __builtin_amdgcn_fence(__ATOMIC_RELEASE, ""); else __builtin_amdgcn_fence(__ATOMIC_RELEASE, "agent");
            asm volatile("s_waitcnt vmcnt(0)" ::: "memory");
#ifndef MK_REL_DELAY
#define MK_REL_DELAY 0
#endif
            if (settle > 0) {
#pragma unroll 1
                for (int i_ = 0; i_ < settle; ++i_) __builtin_amdgcn_s_sleep(127); }
            if (MK_REL_DELAY == -1) { asm volatile("buffer_wbl2 sc1\n\ts_waitcnt vmcnt(0)" ::: "memory"); }
            if (MK_REL_DELAY == -2) __builtin_amdgcn_s_sleep(32);
            const unsigned og = xb_add(&bar[XB_TOP], 1u);
            const unsigned tg = og / nx;
            if (og + 1u == (tg + 1u) * nx) xb_add(&bar[XB_TOPGEN], 1u);
            else XB_SPIN((int)(xb_ld(&bar[XB_TOPGEN]) - (tg + 1u)) < 0, bar);
            if (MK_SYS_ACQ) __builtin_amdgcn_fence(__ATOMIC_ACQUIRE, ""); else __builtin_amdgcn_fence(__ATOMIC_ACQUIRE, "agent");
            xb_add(&bar[XB_XGEN(x)], 1u);
            asm volatile("s_waitcnt vmcnt(0)" ::: "memory");
        } else {
            XB_SPIN((int)(xb_ld(&bar[XB_XGEN(x)]) - (gen + 1u)) < 0, bar);
            if (MK_SYS_ACQ) __builtin_amdgcn_fence(__ATOMIC_ACQUIRE, ""); else __builtin_amdgcn_fence(__ATOMIC_ACQUIRE, "agent");
            asm volatile("s_waitcnt vmcnt(0)" ::: "memory");
        }
    }
    __syncthreads();
    if (MK_BAR_STRONG) { __builtin_amdgcn_fence(__ATOMIC_ACQUIRE, "agent"); asm volatile("s_waitcnt vmcnt(0)" ::: "memory"); }
}

#ifndef MK_P0_B8
#define MK_P0_B8 1
#endif
#ifndef MK_P0_W64
#define MK_P0_W64 1
#endif
constexpr int P0_SCR = MK_P0_W64 ? 16640 : 16384;
struct P0Item { const float* W; bf16_t* WT; const float* gk; int K, N, mode, k0, n0; float f8s; };
template <bool WIDE> __device__ __forceinline__ void p0_load(const P0Item& d, int lane, f32x4 (&v)[16]) {
    if constexpr (WIDE) { const int c = lane & 15, rr = lane >> 4;
#pragma unroll
        for (int i = 0; i < 16; ++i) v[i] = __builtin_nontemporal_load((const f32x4*)(d.W + (size_t)(d.k0 + (MK_P0_B8 ? 16 * (i >> 2) + 4 * rr + (i & 3) : rr + 4 * i)) * d.N + d.n0 + 4 * c));
    } else {
    const int c = lane & 7, rr = lane >> 3;
#pragma unroll
#ifndef MK_P0_NT
#define MK_P0_NT 1
#endif
    for (int i = 0; i < 8; ++i) { const f32x4* q_ = (const f32x4*)(d.W + (size_t)(d.k0 + rr + 8 * i) * d.N + d.n0 + 4 * c); v[i] = MK_P0_NT ? __builtin_nontemporal_load(q_) : *q_; }
    }
}
template <bool WIDE> __device__ __forceinline__ void p0_process(const P0Item& d, int lane, const f32x4 (&v)[16], LAS float* scr) {
    if constexpr (WIDE && MK_P0_B8) {
        const int c = lane & 15, rr = lane >> 4; LAS unsigned* t8 = (LAS unsigned*)scr;
#pragma unroll
        for (int g = 0; g < 4; ++g) { f32x4 sc = d.gk ? *(const f32x4*)(d.gk + d.k0 + 16 * g + 4 * rr) : (f32x4){1.f, 1.f, 1.f, 1.f}; sc = sc * d.f8s;
#pragma unroll
            for (int j = 0; j < 4; ++j) t8[(4 * c + j) * 17 + 4 * g + rr] = pk4_fp8(v[4 * g + 0][j] * sc[0], v[4 * g + 1][j] * sc[1], v[4 * g + 2][j] * sc[2], v[4 * g + 3][j] * sc[3]); }
        LDS_WAIT(); asm volatile("" ::: "memory");
        const int c4 = lane >> 4, nl = lane & 15;
#pragma unroll
        for (int j = 0; j < 4; ++j) { const int n = nl + 16 * j; const LAS unsigned* s8 = t8 + n * 17 + 4 * c4; u32x4 o; o.x = s8[0]; o.y = s8[1]; o.z = s8[2]; o.w = s8[3];
            *(u32x4*)((unsigned char*)d.WT + (size_t)map_row(d.mode, d.n0 + n) * d.K + d.k0 + 16 * c4) = o; }
        LDS_WAIT(); asm volatile("" ::: "memory");
    } else if constexpr (WIDE) {
        { const int c = lane & 15, rr = lane >> 4;
#pragma unroll
          for (int i = 0; i < 16; ++i) { LAS float* q = scr + (rr + 4 * i) * 65 + 4 * c; q[0] = v[i][0]; q[1] = v[i][1]; q[2] = v[i][2]; q[3] = v[i][3]; } }
        LDS_WAIT(); asm volatile("" ::: "memory");
        const int c4 = lane & 3, nl = lane >> 2; f32x4 g[4];
#pragma unroll
        for (int q = 0; q < 4; ++q) { g[q] = d.gk ? *(const f32x4*)(d.gk + d.k0 + 16 * c4 + 4 * q) : (f32x4){1.f, 1.f, 1.f, 1.f}; g[q] = g[q] * d.f8s; }
#pragma unroll
        for (int j = 0; j < 4; ++j) { const int n = nl + 16 * j; const LAS float* s = scr + (16 * c4) * 65 + n; u32x4 o;
            o.x = pk4_fp8(s[0 * 65] * g[0][0], s[1 * 65] * g[0][1], s[2 * 65] * g[0][2], s[3 * 65] * g[0][3]); o.y = pk4_fp8(s[4 * 65] * g[1][0], s[5 * 65] * g[1][1], s[6 * 65] * g[1][2], s[7 * 65] * g[1][3]);
            o.z = pk4_fp8(s[8 * 65] * g[2][0], s[9 * 65] * g[2][1], s[10 * 65] * g[2][2], s[11 * 65] * g[2][3]); o.w = pk4_fp8(s[12 * 65] * g[3][0], s[13 * 65] * g[3][1], s[14 * 65] * g[3][2], s[15 * 65] * g[3][3]);
            *(u32x4*)((unsigned char*)d.WT + (size_t)map_row(d.mode, d.n0 + n) * d.K + d.k0 + 16 * c4) = o; }
        LDS_WAIT(); asm volatile("" ::: "memory");
    } else {
    const int c = lane & 7, rr = lane >> 3;
#pragma unroll
    for (int i = 0; i < 8; ++i) { LAS float* q = scr + (rr + 8 * i) * 33 + 4 * c; q[0] = v[i][0]; q[1] = v[i][1]; q[2] = v[i][2]; q[3] = v[i][3]; }
    LDS_WAIT(); asm volatile("" ::: "memory");
    if (d.f8s != 0.f) {
        const int c4 = lane & 3, nl = lane >> 2; f32x4 g[4];
#pragma unroll
        for (int q = 0; q < 4; ++q) { g[q] = d.gk ? *(const f32x4*)(d.gk + d.k0 + 16 * c4 + 4 * q) : (f32x4){1.f, 1.f, 1.f, 1.f}; g[q] = g[q] * d.f8s; }
#pragma unroll
        for (int j = 0; j < 2; ++j) { const int n = nl + 16 * j; const LAS float* s = scr + (16 * c4) * 33 + n; u32x4 o;
            o.x = pk4_fp8(s[0 * 33] * g[0][0], s[1 * 33] * g[0][1], s[2 * 33] * g[0][2], s[3 * 33] * g[0][3]); o.y = pk4_fp8(s[4 * 33] * g[1][0], s[5 * 33] * g[1][1], s[6 * 33] * g[1][2], s[7 * 33] * g[1][3]);
            o.z = pk4_fp8(s[8 * 33] * g[2][0], s[9 * 33] * g[2][1], s[10 * 33] * g[2][2], s[11 * 33] * g[2][3]); o.w = pk4_fp8(s[12 * 33] * g[3][0], s[13 * 33] * g[3][1], s[14 * 33] * g[3][2], s[15 * 33] * g[3][3]);
            *(u32x4*)((unsigned char*)d.WT + (size_t)map_row(d.mode, d.n0 + n) * d.K + d.k0 + 16 * c4) = o;
#if MK_ST2
            asm volatile("" ::: "memory"); __builtin_nontemporal_store(o, (u32x4*)((unsigned char*)d.WT + (size_t)map_row(d.mode, d.n0 + n) * d.K + d.k0 + 16 * c4));
#endif
            }
    } else {
        f32x4 g0 = {1.f, 1.f, 1.f, 1.f}, g1 = g0;
        if (d.gk) { g0 = *(const f32x4*)(d.gk + d.k0 + 8 * c); g1 = *(const f32x4*)(d.gk + d.k0 + 8 * c + 4); }
#pragma unroll
        for (int j = 0; j < 4; ++j) { const int n = rr + 8 * j; const LAS float* s = scr + (8 * c) * 33 + n;
            u32x4 o; o.x = pk2(s[0 * 33] * g0[0], s[1 * 33] * g0[1]); o.y = pk2(s[2 * 33] * g0[2], s[3 * 33] * g0[3]); o.z = pk2(s[4 * 33] * g1[0], s[5 * 33] * g1[1]); o.w = pk2(s[6 * 33] * g1[2], s[7 * 33] * g1[3]);
            *(u32x4*)(d.WT + (size_t)map_row(d.mode, d.n0 + n) * d.K + d.k0 + 8 * c) = o; }
    }
    LDS_WAIT(); asm volatile("" ::: "memory");
    }
}

constexpr int P0_I_IN = (DM / 64) * (INW / 32), P0_I_OUT = (DM / 64) * (DM / 32), P0_XW = (MK_F8 && MK_P0_W64) ? 64 : 32, P0_I_G = (DM / 64) * (DE / P0_XW), P0_I_D = (DE / 64) * (DM / P0_XW);
constexpr int P0_DENSE = P0_I_IN + P0_I_OUT, P0_EXPERT = NE * (2 * P0_I_G + P0_I_D), P0_NITEMS = P0_DENSE + P0_EXPERT;
struct P0Dec {
    const float *w_in, *attn_g, *w_out, *ffn_g, *wgate, *wup, *wdown; unsigned char* ws;
    __device__ __forceinline__ void operator()(int it, P0Item& d) const {
        int r = it; int item; bf16_t* Wgu = (bf16_t*)(ws + WS_WGU); bf16_t* Wd = (bf16_t*)(ws + WS_WD);
        d.f8s = 0.f;
        if (r < P0_I_IN) { d.W = w_in; d.WT = (bf16_t*)(ws + WS_WIN); d.gk = attn_g; d.K = DM; d.N = INW; d.mode = 1; item = r; if (MK_F8_P1) d.f8s = F8_SWI; }
        else if ((r -= P0_I_IN) < P0_I_OUT) { d.W = w_out; d.WT = (bf16_t*)(ws + WS_WOUT); d.gk = nullptr; d.K = DM; d.N = DM; d.mode = 0; item = r; }
        else { r -= P0_I_OUT; const int e = r / (2 * P0_I_G + P0_I_D); r -= e * (2 * P0_I_G + P0_I_D);
            const size_t egu = MK_F8 ? (size_t)e * 2048 * 2048 / 2 : (size_t)e * 2048 * 2048, ed = MK_F8 ? (size_t)e * 2048 * 1024 / 2 : (size_t)e * 2048 * 1024;
            if (r < P0_I_G) { d.W = wgate + (size_t)e * DM * DE; d.WT = Wgu + egu; d.gk = ffn_g; d.K = DM; d.N = DE; d.mode = 2; item = r; if (MK_F8) d.f8s = F8_SW; }
            else if ((r -= P0_I_G) < P0_I_G) { d.W = wup + (size_t)e * DM * DE; d.WT = Wgu + egu; d.gk = ffn_g; d.K = DM; d.N = DE; d.mode = 3; item = r; if (MK_F8) d.f8s = F8_SW; }
            else { r -= P0_I_G; d.W = wdown + (size_t)e * DE * DM; d.WT = Wd + ed; d.gk = nullptr; d.K = DE; d.N = DM; d.mode = 0; item = r; if (MK_F8) d.f8s = F8_SD; } }
        const int wn = (MK_P0_W64 && d.f8s != 0.f) ? 64 : 32, nblk = d.N / wn; d.k0 = 64 * (item / nblk); d.n0 = wn * (item % nblk);
    }
};
#ifndef MK_ST2
#define MK_ST2 0
#endif
#ifndef MK_P0_AHEAD
#define MK_P0_AHEAD 2
#endif
template <bool WIDE> __device__ __forceinline__ void p0_run(const P0Dec& decode, int it0, int stride, int itEnd, int lane, LAS float* scr) {
#if MK_P0_AHEAD == 4
    f32x4 v0[16], v1[16], v2[16], v3[16], v4[16];
    int it = it0;
#define P0_LD(OFF, VN) { if (it + (OFF) * stride < itEnd) { P0Item dl; decode(it + (OFF) * stride, dl); p0_load<WIDE>(dl, lane, VN); } }
    P0_LD(0, v0) P0_LD(1, v1) P0_LD(2, v2) P0_LD(3, v3)
#define P0_STEP(VN, VC) { P0_LD(4, VN) { P0Item dp; decode(it, dp); p0_process<WIDE>(dp, lane, VC, scr); } it += stride; if (it >= itEnd) break; }
    while (it < itEnd) {
        P0_STEP(v4, v0) P0_STEP(v0, v1) P0_STEP(v1, v2) P0_STEP(v2, v3) P0_STEP(v3, v4)
    }
#undef P0_STEP
#undef P0_LD
#else
    f32x4 v0[16], v1[16];
    int it = it0;
#define P0_LD(OFF, VN) { if (it + (OFF) * stride < itEnd) { P0Item dl; decode(it + (OFF) * stride, dl); p0_load<WIDE>(dl, lane, VN); } }
    P0_LD(0, v0)
#define P0_STEP(VN, VC) { P0_LD(1, VN) { P0Item dp; decode(it, dp); p0_process<WIDE>(dp, lane, VC, scr); } it += stride; if (it >= itEnd) break; }
    while (it < itEnd) {
        P0_STEP(v1, v0) P0_STEP(v0, v1)
    }
#undef P0_STEP
#undef P0_LD
#endif
}
#ifndef MK_XROW
#define MK_XROW 0
#endif
constexpr int XS_PER_E = 64 + 64 + 64, XS_TOTAL = NE * XS_PER_E;
struct XSItem { const float* W; unsigned char* WT; const float* gk; int K, N, mode, k0, n0; float f8s; };
struct XSDec {
    const float *ffn_g, *wgate, *wup, *wdown; unsigned char* ws;
    __device__ __forceinline__ void operator()(int si, XSItem& d) const {
        const int e = si / XS_PER_E; int r = si - e * XS_PER_E;
        unsigned char* Wgu = ws + WS_WGU + (size_t)e * 2048 * 2048; unsigned char* Wd = ws + WS_WD + (size_t)e * 2048 * 1024;
        if (r < 64) { d.W = wgate + (size_t)e * DM * DE; d.WT = Wgu; d.gk = ffn_g; d.K = DM; d.N = DE; d.mode = 2; d.f8s = F8_SW; d.n0 = (r >> 4) * 256; d.k0 = (r & 15) * 128; }
        else if (r < 128) { r -= 64; d.W = wup + (size_t)e * DM * DE; d.WT = Wgu; d.gk = ffn_g; d.K = DM; d.N = DE; d.mode = 3; d.f8s = F8_SW; d.n0 = (r >> 4) * 256; d.k0 = (r & 15) * 128; }
        else { r -= 128; d.W = wdown + (size_t)e * DE * DM; d.WT = Wd; d.gk = nullptr; d.K = DE; d.N = DM; d.mode = 0; d.f8s = F8_SD; d.n0 = (r >> 3) * 256; d.k0 = (r & 7) * 128; }
    }
};
__device__ __forceinline__ void xs_load(const XSItem& d, int j, int lane, f32x4 (&v)[16]) {
    const f32x4* src = (const f32x4*)(d.W + (size_t)(d.k0 + 16 * j) * d.N + d.n0) + lane;
#pragma unroll
    for (int i = 0; i < 16; ++i) v[i] = __builtin_nontemporal_load(src + (size_t)i * (d.N / 4));
}
__device__ __forceinline__ void xs_process(const XSItem& d, int j, int lane, const f32x4 (&v)[16], LAS float* scr) {
#pragma unroll
    for (int i = 0; i < 16; ++i) *(LAS f32x4*)(scr + i * 256 + 4 * lane) = v[i];
    LDS_WAIT(); asm volatile("" ::: "memory");
    const int k = d.k0 + 16 * j; float g[16];
#pragma unroll
    for (int i = 0; i < 16; ++i) g[i] = d.gk ? d.gk[k + i] * d.f8s : d.f8s;
#pragma unroll
    for (int q = 0; q < 4; ++q) { const int n = lane + 64 * q; const LAS float* s = scr + n; u32x4 o;
        o.x = pk4_fp8(s[0 * 256] * g[0], s[1 * 256] * g[1], s[2 * 256] * g[2], s[3 * 256] * g[3]); o.y = pk4_fp8(s[4 * 256] * g[4], s[5 * 256] * g[5], s[6 * 256] * g[6], s[7 * 256] * g[7]);
        o.z = pk4_fp8(s[8 * 256] * g[8], s[9 * 256] * g[9], s[10 * 256] * g[10], s[11 * 256] * g[11]); o.w = pk4_fp8(s[12 * 256] * g[12], s[13 * 256] * g[13], s[14 * 256] * g[14], s[15 * 256] * g[15]);
        *(u32x4*)(d.WT + (size_t)map_row(d.mode, d.n0 + n) * d.K + k) = o; }
    LDS_WAIT(); asm volatile("" ::: "memory");
}
__device__ __forceinline__ void xs_run(const XSDec& decode, int it0, int stride, int itEnd, int lane, LAS float* scr) {
    const int nsup = it0 < itEnd ? (itEnd - 1 - it0) / stride + 1 : 0, nf = nsup * 8;
    XSItem d, dn; f32x4 va[16], vb[16];
    if (nf > 0) { decode(it0, d); xs_load(d, 0, lane, va); }
#pragma unroll 1
    for (int f = 0; f < nf; f += 2) {
        xs_load(d, (f + 1) & 7, lane, vb);
        xs_process(d, f & 7, lane, va, scr);
        dn = d;
        if (f + 2 < nf) { if (((f + 2) & 7) == 0) decode(it0 + ((f + 2) >> 3) * stride, dn); xs_load(dn, (f + 2) & 7, lane, va); }
        xs_process(d, (f + 1) & 7, lane, vb, scr);
        d = dn;
    }
}
#ifndef MK_XCONV
#define MK_XCONV 1
#endif

#ifndef MK_POISON_CHECK
#define MK_POISON_CHECK 0
#endif
#ifndef MK_P4_PAD
#define MK_P4_PAD 0
#endif
#ifndef MK_XCLS
#define MK_XCLS 5
#endif
#ifndef MK_XN_FIRST
#define MK_XN_FIRST 1
#endif
#ifndef MK_XN16
#define MK_XN16 0
#endif
#ifndef MK_DETSLOT
#define MK_DETSLOT 0
#endif
#ifndef MK_REP
#define MK_REP -1
#endif
#define REPS(k) ((MK_REP == (k)) ? 2 : 1)
#ifndef MK_PROBE
#define MK_PROBE -1
#endif
#ifndef MK_USE_CG
#define MK_USE_CG 0
#endif
#define PHASE_VARS() kargp_t ap = (kargp_t)__builtin_amdgcn_kernarg_segment_ptr(); asm volatile("" : "+s"(ap)); \
    int tid = mk_tid(lds); asm volatile("" : "+v"(tid)); const int lane = tid & 63, wave = __builtin_amdgcn_readfirstlane(tid >> 6); \
    const int G = gridDim.x, vcu = (blockIdx.x % 8) * (G / 8) + blockIdx.x / 8; unsigned char* ws = ap->ws; (void)lane; (void)wave; (void)vcu; (void)ws

__global__ void __launch_bounds__(NTHR, 2) mk_fwd(MkArgs args) {
    extern __shared__ __attribute__((aligned(16))) unsigned char lds_raw[];
    LAS unsigned char* const lds = (LAS unsigned char*)lds_raw;
    const int lo = args.ph_lo, hi = args.ph_hi;
    {
        const int t0_ = threadIdx.x; if (t0_ < 32) ((LAS unsigned*)(lds + MISC_OFF))[t0_] = 0u;
        if ((t0_ & 63) == 0) ((volatile LAS unsigned char*)(lds + WTAB_OFF))[mk_hwslot()] = (unsigned char)(t0_ >> 6);
        __syncthreads(); }
    if (hi - lo > 1 && mk_tid(lds) == 0) (void)xb_add((unsigned*)(args.ws + WS_CTL) + CW_BAR + XB_XCNT(xb_xcc_id()), 1u);
#define IN(k) (lo <= (k) && (k) < hi)
#define STAMP(i) do { if (MK_PROBE >= 0 && blockIdx.x == 0 && mk_tid(lds) == 0) __hip_atomic_store((unsigned long long*)(args.ws + WS_LAM + 1024) + (i), __builtin_amdgcn_s_memrealtime(), __ATOMIC_RELAXED, __HIP_MEMORY_SCOPE_AGENT); } while (0)
    STAMP(0);
#ifndef MK_GAP_SEAM
#define MK_GAP_SEAM -1
#endif
#ifndef MK_GAP_POS
#define MK_GAP_POS 1
#endif
#define MK_GAP() do { _Pragma("unroll 1") for (int g_ = 0; g_ < 80; ++g_) __builtin_amdgcn_s_sleep(127); } while (0)
#define SEAM_XCD(k) do { if (IN(k) && IN((k) + 1)) { kargp_t ap_ = (kargp_t)__builtin_amdgcn_kernarg_segment_ptr(); asm volatile("" : "+s"(ap_)); if ((k) == MK_GAP_SEAM && MK_GAP_POS == 0) MK_GAP(); \
        for (int sr_ = 0; sr_ < REPS(9); ++sr_) xcd_barrier((unsigned*)(ap_->ws + WS_CTL) + CW_BAR, (volatile LAS unsigned*)(lds + MISC_OFF) + 8, mk_tid(lds) == 0, MK_REL_DELAY * (((MK_SETTLE2_MASK >> (k)) & 1) ? 2 : 1)); if ((k) == MK_GAP_SEAM && MK_GAP_POS == 1) MK_GAP(); } } while (0)

    if (IN(0)) for (int rep_ = 0; rep_ < REPS(0); ++rep_) {
        PHASE_VARS();
        const int gw = vcu * NWAVES + wave, NGW = G * NWAVES, gtid = blockIdx.x * NTHR + tid, NGT = G * NTHR;
        const float* ffn_g = ap->in[15];
        LAS float* scr = (LAS float*)(lds + wave * P0_SCR);
        const P0Dec dec{ap->in[2], ap->in[1], ap->in[14], ffn_g, ap->in[20], ap->in[21], ap->in[22], ws};
        static_assert(!(MK_P0_W64 && MK_F8) || MK_XCONV, "wide fp8 items need the expert conversion outside the prologue");
        if (!MK_XN_FIRST) p0_run<false>(dec, gw, NGW, (MK_XCONV || (MK_XROW && MK_F8)) ? P0_DENSE : P0_NITEMS, lane, scr);
        if (MK_XROW && MK_F8 && !MK_XCONV) { const XSDec xdec{ffn_g, ap->in[20], ap->in[21], ap->in[22], ws}; xs_run(xdec, gw, NGW, XS_TOTAL, lane, scr); }
        float2* rope = (float2*)(ws + WS_ROPE); bf16_t* WsB = (bf16_t*)(ws + WS_WSB);
        for (int i = gtid; i < 4096 * 8; i += NGT) { const int pos = i >> 3, f = i & 7; const float inv = 1.0f / powf(500000.0f, (float)(2 * f) / 16.0f); const float ang = (float)pos * inv; rope[i] = make_float2(cosf(ang), sinf(ang)); }
        { const float* wgrp = ap->in[16]; const float* wrt = ap->in[18]; bf16_t* WrH = (bf16_t*)(ws + WS_WRH); bf16_t* WrL = WrH + 48 * 2048;
          for (int i = gtid; i < 48 * 2048; i += NGT) { const int c = i / 2048, k = i % 2048; float w = 0.f; if (c < 36) w = (c < 4 ? wgrp[k * 4 + c] : wrt[k * 32 + (c - 4)]) * ffn_g[k];
              const unsigned hb = f2bf(w); WrH[i] = (bf16_t)hb; WrL[i] = (bf16_t)f2bf(w - bf2f(hb)); } }
        { const float* gws = ap->in[5]; for (int i = gtid; i < 8 * 128 * 128; i += NGT) WsB[i] = (bf16_t)f2bf(gws[i]); }
        if (gtid == 0) { float a = 0.f, b = 0.f; for (int i = 0; i < 64; ++i) { a += ap->in[9][i] * ap->in[10][i]; b += ap->in[11][i] * ap->in[12][i]; } ((float*)(ws + WS_LAM))[0] = expf(a) - expf(b) + 0.2f; }
        const float* x = ap->in[0]; bf16_t* XN = (bf16_t*)(ws + WS_XN);
        for (int m = gw; m < T; m += NGW) {
#if MK_XN16
            const f32x4* xr = (const f32x4*)(x + (size_t)m * DM) + 2 * lane; f32x4 v[8]; float s = 0.f;
#pragma unroll
            for (int j = 0; j < 4; ++j) { v[2 * j] = xr[128 * j]; v[2 * j + 1] = xr[128 * j + 1]; }
#pragma unroll
            for (int j = 0; j < 8; ++j) s += (v[j][0] * v[j][0] + v[j][1] * v[j][1]) + (v[j][2] * v[j][2] + v[j][3] * v[j][3]);
            const float rs = rsqrtf(wave_sum(s) * (1.f / DM) + EPS);
            if (MK_F8_P1) { u32x2* o4 = (u32x2*)((unsigned char*)XN + (size_t)m * DM) + lane; const float r8 = rs * F8_SXN;
#pragma unroll
                for (int j = 0; j < 4; ++j) { u32x2 w; w.x = pk4_fp8(v[2 * j][0] * r8, v[2 * j][1] * r8, v[2 * j][2] * r8, v[2 * j][3] * r8); w.y = pk4_fp8(v[2 * j + 1][0] * r8, v[2 * j + 1][1] * r8, v[2 * j + 1][2] * r8, v[2 * j + 1][3] * r8); o4[64 * j] = w; }
            } else {
            u32x4* o16 = (u32x4*)(XN + (size_t)m * DM) + lane;
#pragma unroll
            for (int j = 0; j < 4; ++j) { u32x4 w; w.x = pk2(v[2 * j][0] * rs, v[2 * j][1] * rs); w.y = pk2(v[2 * j][2] * rs, v[2 * j][3] * rs); w.z = pk2(v[2 * j + 1][0] * rs, v[2 * j + 1][1] * rs); w.w = pk2(v[2 * j + 1][2] * rs, v[2 * j + 1][3] * rs); o16[64 * j] = w; } }
#else
            const f32x4* xr = (const f32x4*)(x + (size_t)m * DM) + lane; f32x4 v[8]; float s = 0.f;
#pragma unroll
            for (int j = 0; j < 8; ++j) { v[j] = xr[64 * j]; s += (v[j][0] * v[j][0] + v[j][1] * v[j][1]) + (v[j][2] * v[j][2] + v[j][3] * v[j][3]); }
            const float rs = rsqrtf(wave_sum(s) * (1.f / DM) + EPS);
            u32x2* o8 = (u32x2*)(XN + (size_t)m * DM) + lane;
#pragma unroll
            for (int j = 0; j < 8; ++j) { u32x2 w; w.x = pk2(v[j][0] * rs, v[j][1] * rs); w.y = pk2(v[j][2] * rs, v[j][3] * rs); o8[64 * j] = w; }
#endif
        }
        if (MK_XN_FIRST) p0_run<false>(dec, gw, NGW, (MK_XCONV || (MK_XROW && MK_F8)) ? P0_DENSE : P0_NITEMS, lane, scr);
    }
#if MK_USE_CG
    if (IN(0) && IN(1)) cg::this_grid().sync();
#else
    SEAM_XCD(0);
#endif
    STAMP(1);
    if (IN(1)) {
        PHASE_VARS();
        pg8::StaticOrder S; S.init(ws + WS_XN, ws + WS_WIN, T, INW, DM, G, (int)blockIdx.x, MK_F8_P1 ? 1 : 2);
        pg8::EpiG1 E{(bf16_t*)(ws + WS_U), ap->in[7], ap->in[8], (const float2*)(ws + WS_ROPE)};
        for (int rep_ = 0; rep_ < REPS(1); ++rep_) pg8::gemm_phase<pg8::EpiG1, pg8::StaticOrder, true, MK_F8_P1 != 0>(lds, (LAS unsigned*)(lds + RTAB_OFF), DM, S, E);
    }
    SEAM_XCD(1);
    STAMP(2);
    if (IN(2)) {
        PHASE_VARS();
        bf16_t* U = (bf16_t*)(ws + WS_U); bf16_t* VG = U + (size_t)T * 1024; bf16_t* QN = VG + (size_t)T * 1024; bf16_t* KN = QN + (size_t)T * 1024; bf16_t* VB = KN + (size_t)T * 1024;
        bf16_t* MIX = (bf16_t*)(ws + WS_MIX);
        if (MK_XCLS == 5) {
            const bf16_t* WsB = (const bf16_t*)(ws + WS_WSB);
            for (int pr = blockIdx.x; pr < (NB * 32 * 8 / 2) * REPS(20); pr += G) dattn::gmlp_pair(lds, pr & (NB * 32 * 8 / 2 - 1), U, VG, WsB, ap->in[3], ap->in[4], ap->in[6], MIX);
        }
        {
            const float* subg = ap->in[13]; const float lamv = ((const float*)(ws + WS_LAM))[0];
            const P0Dec dec{ap->in[2], ap->in[1], ap->in[14], ap->in[15], ap->in[20], ap->in[21], ap->in[22], ws};
            const int gw = vcu * NWAVES + wave, NGW = G * NWAVES, cls = vcu & 1; LAS float* scr = (LAS float*)(lds + wave * P0_SCR);
            constexpr int PER_WAVE = (P0_EXPERT + 2047) / 2048, HALFW = (PER_WAVE + 1) / 2;
#define XS_CHUNK(r) do { kargp_t aq = (kargp_t)__builtin_amdgcn_kernarg_segment_ptr(); asm volatile("" : "+s"(aq)); const XSDec xdec{aq->in[15], aq->in[20], aq->in[21], aq->in[22], aq->ws}; \
                const int t_ = mk_tid(lds), gw_ = ((blockIdx.x % 8) * (gridDim.x / 8) + blockIdx.x / 8) * NWAVES + (t_ >> 6), ngw_ = gridDim.x * NWAVES, xper = (XS_TOTAL + ngw_ - 1) / ngw_, xh = (xper + 1) / 2; \
                const int x0 = gw_ + ((r) == 0 ? 0 : xh) * ngw_, x1 = (r) == 0 ? (xh * ngw_ < XS_TOTAL ? xh * ngw_ : XS_TOTAL) : XS_TOTAL; \
                xs_run(xdec, x0, ngw_, x1, t_ & 63, (LAS float*)(lds + (t_ >> 6) * P0_SCR)); } while (0)
#define P0_CHUNK(r) do { kargp_t aq = (kargp_t)__builtin_amdgcn_kernarg_segment_ptr(); asm volatile("" : "+s"(aq)); const P0Dec dq{aq->in[2], aq->in[1], aq->in[14], aq->in[15], aq->in[20], aq->in[21], aq->in[22], aq->ws}; \
                const int t_ = mk_tid(lds), gw_ = ((blockIdx.x % 8) * (gridDim.x / 8) + blockIdx.x / 8) * NWAVES + (t_ >> 6), ngw_ = gridDim.x * NWAVES; \
                const int c0_ = P0_DENSE + gw_ + ((r) * HALFW) * ngw_, c1_ = P0_DENSE + gw_ + (((r) + 1) * HALFW < PER_WAVE ? ((r) + 1) * HALFW : PER_WAVE) * ngw_; \
                p0_run<(MK_P0_W64 && MK_F8)>(dq, c0_, ngw_, c1_ < P0_NITEMS ? c1_ : P0_NITEMS, t_ & 63, (LAS float*)(lds + (t_ >> 6) * P0_SCR)); } while (0)
#define P0_ALL() do { kargp_t aq = (kargp_t)__builtin_amdgcn_kernarg_segment_ptr(); asm volatile("" : "+s"(aq)); const P0Dec dq{aq->in[2], aq->in[1], aq->in[14], aq->in[15], aq->in[20], aq->in[21], aq->in[22], aq->ws}; \
                const int t_ = mk_tid(lds), gw_ = ((blockIdx.x % 8) * (gridDim.x / 8) + blockIdx.x / 8) * NWAVES + (t_ >> 6), ngw_ = gridDim.x * NWAVES; \
                p0_run<(MK_P0_W64 && MK_F8)>(dq, P0_DENSE + gw_, ngw_, P0_NITEMS, t_ & 63, (LAS float*)(lds + (t_ >> 6) * P0_SCR)); } while (0)
            __syncthreads();
            int rnd = 0;
            if (MK_XCLS == 3 || MK_XCLS == 5) {
                const int cls3 = vcu % (MK_XCLS == 5 ? 2 : 3); bool conv_done = !MK_XCONV;
                for (int rep_ = 0; rep_ < REPS(21); ++rep_) for (int un = vcu; un < NB * 8 * 16; un += G, ++rnd) { const int bh = un >> 4, qb = un & 15;
                    if (!conv_done && cls3 == rnd) { __syncthreads(); for (int rc_ = 0; rc_ < REPS(22); ++rc_) P0_ALL(); __syncthreads(); conv_done = true; }
                    dattn::attn_unit(lds, bh >> 3, bh & 7, qb, QN, KN, VB, MIX, subg, lamv);
                }
                if (!conv_done) { __syncthreads(); for (int rc_ = 0; rc_ < REPS(22); ++rc_) P0_ALL(); __syncthreads(); }
            } else {
            for (int rep_ = 0; rep_ < REPS(21); ++rep_) for (int un = vcu; un < NB * 8 * 16; un += G, ++rnd) { const int bh = un >> 4, qb = un & 15;
                const int c0 = P0_DENSE + gw + (rnd * HALFW) * NGW, c1 = P0_DENSE + gw + ((rnd + 1) * HALFW < PER_WAVE ? (rnd + 1) * HALFW : PER_WAVE) * NGW;
                if (MK_XCONV && cls == 0 && rnd < 2 && rep_ == 0) { __syncthreads(); if (MK_XROW && MK_F8) XS_CHUNK(rnd); else { for (int rc_ = 0; rc_ < REPS(22); ++rc_) P0_CHUNK(rnd); } __syncthreads(); }
                dattn::attn_unit(lds, bh >> 3, bh & 7, qb, QN, KN, VB, MIX, subg, lamv);
                if (MK_XCONV && cls == 1 && rnd < 2 && rep_ == 0) { __syncthreads(); if (MK_XROW && MK_F8) XS_CHUNK(rnd); else { for (int rc_ = 0; rc_ < REPS(22); ++rc_) P0_CHUNK(rnd); } __syncthreads(); }
            }
            }
        }
        if (MK_XCLS != 5) {
            kargp_t ag = (kargp_t)__builtin_amdgcn_kernarg_segment_ptr(); asm volatile("" : "+s"(ag));
            const bf16_t* WsB = (const bf16_t*)(ag->ws + WS_WSB); bf16_t* U2 = (bf16_t*)(ag->ws + WS_U); bf16_t* VG2 = U2 + (size_t)T * 1024; bf16_t* MIX2 = (bf16_t*)(ag->ws + WS_MIX);
            __syncthreads();
            for (int pr = blockIdx.x; pr < (NB * 32 * 8 / 2) * REPS(20); pr += gridDim.x) dattn::gmlp_pair(lds, pr & (NB * 32 * 8 / 2 - 1), U2, VG2, WsB, ag->in[3], ag->in[4], ag->in[6], MIX2);
        }
    }
    SEAM_XCD(2);
    STAMP(3);
    if (IN(3)) {
        PHASE_VARS();
        pg8::StaticOrder S; S.init(ws + WS_MIX, ws + WS_WOUT, T, DM, DM, G, (int)blockIdx.x);
        pg8::EpiG2 E{ap->in[0], ap->out, (bf16_t*)(ws + WS_XN), 0};
#ifndef MK_REPNS
#define MK_REPNS 0
#endif
        for (int rep_ = 0; rep_ < REPS(3); ++rep_) { if (MK_REPNS) { int sk = rep_ * MK_REPNS; asm volatile("" : "+s"(sk)); E.skip = sk; } pg8::gemm_phase<pg8::EpiG2, pg8::StaticOrder, true>(lds, (LAS unsigned*)(lds + RTAB_OFF), DM, S, E); }
    }
#ifndef MK_DELAY3
#define MK_DELAY3 0
#endif
    if (MK_DELAY3) {
#pragma unroll 1
        for (int i_ = 0; i_ < MK_DELAY3; ++i_) __builtin_amdgcn_s_sleep(127); }
    SEAM_XCD(3);
    STAMP(4);
    if (IN(4)) {
        PHASE_VARS();
        const float* out = ap->out; const bf16_t* WrH = (const bf16_t*)(ws + WS_WRH); const bf16_t* WrL = WrH + 48 * 2048; const float* bgrp = ap->in[17]; const float* brt = ap->in[19];
        unsigned* cnt = (unsigned*)(ws + WS_CTL); int2* list = (int2*)(ws + MK_WS_LIST); int4* rec = (int4*)(ws + WS_REC);
        LAS float* part = (LAS float*)lds;
        const int mt = wave & 3, kh = wave >> 2, row = lane & 15, kq = lane >> 4;
        for (int rp_ = 0; rp_ < REPS(4); ++rp_) for (int un = blockIdx.x; un < T / 64; un += G) {
            const int t0 = un * 64 + mt * 16;
            const float* xr = out + (size_t)(t0 + row) * DM + kh * 1024 + kq * 8;
            const bf16_t* wh = WrH + (size_t)row * 2048 + kh * 1024 + kq * 8; const bf16_t* wl = WrL + (size_t)row * 2048 + kh * 1024 + kq * 8;
            f32x4 acc[3]; float ss = 0.f;
#pragma unroll
            for (int n = 0; n < 3; ++n) acc[n] = (f32x4){0.f, 0.f, 0.f, 0.f};
            bf16x8 bhA[2][3], blA[2][3], bhB[2][3], blB[2][3]; f32x4 xA[2][2], xB[2][2];
#define P4_LOAD(BH, BL, X, KS) do { _Pragma("unroll") for (int u = 0; u < 2; ++u) { _Pragma("unroll") for (int n = 0; n < 3; ++n) { BH[u][n] = *(const bf16x8*)(wh + (size_t)n * 16 * 2048 + ((KS) + u) * 32); BL[u][n] = *(const bf16x8*)(wl + (size_t)n * 16 * 2048 + ((KS) + u) * 32); } \
                    X[u][0] = *(const f32x4*)(xr + ((KS) + u) * 32); X[u][1] = *(const f32x4*)(xr + ((KS) + u) * 32 + 4); } } while (0)
#define P4_COMP(BH, BL, X) do { _Pragma("unroll") for (int u = 0; u < 2; ++u) { const f32x4 x0 = X[u][0], x1 = X[u][1]; \
                    ss += (x0[0] * x0[0] + x0[1] * x0[1]) + (x0[2] * x0[2] + x0[3] * x0[3]) + (x1[0] * x1[0] + x1[1] * x1[1]) + (x1[2] * x1[2] + x1[3] * x1[3]); \
                    u32x4 hp, lp; \
                    hp.x = cvt_pk_bf16(x0[0], x0[1]); hp.y = cvt_pk_bf16(x0[2], x0[3]); hp.z = cvt_pk_bf16(x1[0], x1[1]); hp.w = cvt_pk_bf16(x1[2], x1[3]); \
                    lp.x = cvt_pk_bf16(x0[0] - bf2f(hp.x & 0xffffu), x0[1] - bf2f(hp.x >> 16)); lp.y = cvt_pk_bf16(x0[2] - bf2f(hp.y & 0xffffu), x0[3] - bf2f(hp.y >> 16)); \
                    lp.z = cvt_pk_bf16(x1[0] - bf2f(hp.z & 0xffffu), x1[1] - bf2f(hp.z >> 16)); lp.w = cvt_pk_bf16(x1[2] - bf2f(hp.w & 0xffffu), x1[3] - bf2f(hp.w >> 16)); \
                    const bf16x8 ah = __builtin_bit_cast(bf16x8, hp), al = __builtin_bit_cast(bf16x8, lp); \
                    if (MK_P4_PAD) { __builtin_amdgcn_sched_barrier(0); asm volatile("s_nop 7" ::: "memory"); __builtin_amdgcn_sched_barrier(0); } \
                    _Pragma("unroll") for (int n = 0; n < 3; ++n) { \
                        acc[n] = __builtin_amdgcn_mfma_f32_16x16x32_bf16(ah, BH[u][n], acc[n], 0, 0, 0); acc[n] = __builtin_amdgcn_mfma_f32_16x16x32_bf16(al, BH[u][n], acc[n], 0, 0, 0); acc[n] = __builtin_amdgcn_mfma_f32_16x16x32_bf16(ah, BL[u][n], acc[n], 0, 0, 0); } \
                    if (MK_P4_PAD) { __builtin_amdgcn_sched_barrier(0); asm volatile("s_nop 15\n\ts_nop 15\n\ts_nop 15" ::: "memory"); __builtin_amdgcn_sched_barrier(0); } } } while (0)
            P4_LOAD(bhA, blA, xA, 0);
#pragma unroll 1
            for (int ks = 0; ks < 32; ks += 4) {
                P4_LOAD(bhB, blB, xB, ks + 2);
                __builtin_amdgcn_sched_barrier(0);
                P4_COMP(bhA, blA, xA);
                __builtin_amdgcn_sched_barrier(0);
                if (ks + 4 < 32) P4_LOAD(bhA, blA, xA, ks + 4);
                __builtin_amdgcn_sched_barrier(0);
                P4_COMP(bhB, blB, xB);
                __builtin_amdgcn_sched_barrier(0);
            }
#undef P4_LOAD
#undef P4_COMP
            ss += __shfl_xor(ss, 16); ss += __shfl_xor(ss, 32);
            __syncthreads();
            LAS float* pb = part + (kh * 4 + mt) * 16 * 52;
#pragma unroll
            for (int n = 0; n < 3; ++n)
#pragma unroll
                for (int r = 0; r < 4; ++r) pb[(kq * 4 + r) * 52 + n * 16 + row] = acc[n][r];
            if (kq == 0) pb[row * 52 + 48] = ss;
            __syncthreads();
            if (kh == 0 && lane < 16 && rp_ == REPS(4) - 1) {
                const LAS float* p0 = part + (mt * 16 + lane) * 52; const LAS float* p1 = p0 + 4 * 16 * 52; const int t = t0 + lane;
#define TOT(c) (p0[c] + p1[c])
                const float rs = rsqrtf(TOT(48) * (1.f / DM) + EPS);
                int gi = 0; float lgm = TOT(0) * rs + bgrp[0];
                for (int g = 1; g < 4; ++g) { const float l = TOT(g) * rs + bgrp[g]; if (l > lgm) { lgm = l; gi = g; } }
                float den = 0.f; for (int g = 0; g < 4; ++g) den += expf(TOT(g) * rs + bgrp[g] - lgm); const float gwt = 1.f / den;
                int e0 = 0, e1 = 0; float l0 = -3.0e38f, l1 = -3.0e38f;
                for (int j = 0; j < 8; ++j) { const float l = TOT(4 + gi * 8 + j) * rs + brt[gi * 8 + j]; if (l > l0) { l1 = l0; e1 = e0; l0 = l; e0 = j; } else if (l > l1) { l1 = l; e1 = j; } }
#undef TOT
                const float w0 = 1.f / (1.f + expf(l1 - l0)), w1 = 1.f - w0;
                const int E0 = gi * 8 + e0, E1 = gi * 8 + e1;
#if MK_DETSLOT
                rec[t] = make_int4(E0 << 16, E1 << 16, __float_as_int(gwt * w0), __float_as_int(gwt * w1)); ((float*)(ws + 596 * MiB))[t] = rs;
                if (MK_DETSLOT == 2) { LAS int* eb = (LAS int*)(lds + 32768); eb[(mt * 16 + lane) * 2] = E0; eb[(mt * 16 + lane) * 2 + 1] = E1; }
#else
                const unsigned q0 = atomicAdd(&cnt[E0], 1u), q1 = atomicAdd(&cnt[E1], 1u);
                if (MK_LIST_SYS) { const unsigned long long ent = ((unsigned long long)(unsigned)__float_as_int(rs) << 32) | (unsigned)t;
                    __hip_atomic_store((unsigned long long*)((char*)list + ((size_t)E0 * T + q0) * LIST_ESZ), ent, __ATOMIC_RELAXED, __HIP_MEMORY_SCOPE_SYSTEM); __hip_atomic_store((unsigned long long*)((char*)list + ((size_t)E1 * T + q1) * LIST_ESZ), ent, __ATOMIC_RELAXED, __HIP_MEMORY_SCOPE_SYSTEM); }
                else if (MK_ST16 || MK_LIST_LINE) { *(int4*)((char*)list + ((size_t)E0 * T + q0) * LIST_ESZ) = make_int4(t, __float_as_int(rs), 0, 0); *(int4*)((char*)list + ((size_t)E1 * T + q1) * LIST_ESZ) = make_int4(t, __float_as_int(rs), 0, 0); }
                else { list[(size_t)E0 * T + q0] = make_int2(t, __float_as_int(rs)); list[(size_t)E1 * T + q1] = make_int2(t, __float_as_int(rs)); }
                rec[t] = make_int4((E0 << 16) | (int)q0, (E1 << 16) | (int)q1, __float_as_int(gwt * w0), __float_as_int(gwt * w1));
#endif
            }
#if MK_DETSLOT == 2
            __syncthreads();
            if (tid < 32 && rp_ == REPS(4) - 1) { const LAS int* eb = (const LAS int*)(lds + 32768); int c = 0; for (int j = 0; j < 64; ++j) c += (eb[2 * j] == tid) + (eb[2 * j + 1] == tid); ((int*)(ws + 597 * MiB))[un * 32 + tid] = c; }
#endif
        }
    }
    SEAM_XCD(4);
#if MK_DETSLOT
    if (IN(4) && IN(5)) {
        PHASE_VARS();
#if MK_DETSLOT == 2
        {
            const int* hist = (const int*)(ws + 597 * MiB); LAS int* sm = (LAS int*)(lds + 32768); LAS int* eb = sm + 2048; const float* rsv = (const float*)(ws + 596 * MiB);
            int* recw = (int*)(ws + WS_REC); char* list = (char*)(ws + MK_WS_LIST);
            const int myun = (int)blockIdx.x, e_ = tid & 31, part = tid >> 5;
            { int sb = 0, st = 0;
#pragma unroll 4
              for (int q = 0; q < 16; ++q) { const int uu = part * 16 + q; const int h = hist[uu * 32 + e_]; st += h; sb += (uu < myun) ? h : 0; }
              sm[part * 32 + e_] = sb; sm[512 + part * 32 + e_] = st; }
            __syncthreads();
            if (tid < 32) { int b = 0, tt = 0; for (int q = 0; q < 16; ++q) { b += sm[q * 32 + tid]; tt += sm[512 + q * 32 + tid]; } sm[1024 + tid] = b; sm[1056 + tid] = tt; }
            if (myun < T / 64 && tid < 64) { const int4 r = ((const int4*)recw)[myun * 64 + tid]; eb[2 * tid] = r.x >> 16; eb[2 * tid + 1] = r.y >> 16; }
            __syncthreads();
            if (myun < T / 64 && tid < 64) { const int t = myun * 64 + tid, E0 = eb[2 * tid], E1 = eb[2 * tid + 1]; int r0 = 0, r1 = 0;
                for (int j = 0; j < tid; ++j) { const int a = eb[2 * j], b = eb[2 * j + 1]; r0 += (a == E0) + (b == E0); r1 += (a == E1) + (b == E1); }
                const int p0 = sm[1024 + E0] + r0, p1 = sm[1024 + E1] + r1; const int rsb = __float_as_int(rsv[t]);
                *(int4*)(list + ((size_t)E0 * T + p0) * LIST_ESZ) = make_int4(t, rsb, 0, 0); *(int4*)(list + ((size_t)E1 * T + p1) * LIST_ESZ) = make_int4(t, rsb, 0, 0);
                recw[4 * t] = (E0 << 16) | p0; recw[4 * t + 1] = (E1 << 16) | p1; }
            if (tid < 32) { volatile LAS int* cntl0 = (volatile LAS int*)(lds + CNTL_OFF); cntl0[tid] = sm[1056 + tid]; }
            __syncthreads();
        }
#else
        if (blockIdx.x == 0) {
            int* recw = (int*)(ws + WS_REC); const float* rsv = (const float*)(ws + 596 * MiB); unsigned* cnt = (unsigned*)(ws + WS_CTL); char* list = (char*)(ws + MK_WS_LIST);
            for (int eb = 0; eb < 4; ++eb) { const int e = wave * 4 + eb; int c = 0;
#pragma unroll 1
                for (int k = 0; k < T / 64; ++k) { const int t = 64 * k + lane; const int rx = __hip_atomic_load(recw + 4 * t, __ATOMIC_RELAXED, __HIP_MEMORY_SCOPE_AGENT), ry = __hip_atomic_load(recw + 4 * t + 1, __ATOMIC_RELAXED, __HIP_MEMORY_SCOPE_AGENT);
                    const bool m0 = (rx >> 16) == e, m1 = (ry >> 16) == e, m = m0 || m1;
                    const unsigned long long bal = __ballot(m); const int pre = (int)__builtin_amdgcn_mbcnt_hi((unsigned)(bal >> 32), __builtin_amdgcn_mbcnt_lo((unsigned)bal, 0u));
                    if (m) { const int pos = c + pre; *(int4*)(list + ((size_t)e * T + pos) * LIST_ESZ) = make_int4(t, __float_as_int(rsv[t]), 0, 0); recw[4 * t + (m0 ? 0 : 1)] = (e << 16) | pos; }
                    c += __popcll(bal); }
                if (lane == 0) __hip_atomic_store(cnt + e, (unsigned)c, __ATOMIC_RELAXED, __HIP_MEMORY_SCOPE_AGENT); }
        }
#endif
        xcd_barrier((unsigned*)(ws + WS_CTL) + CW_BAR, (volatile LAS unsigned*)(lds + MISC_OFF) + 8, tid == 0, MK_REL_DELAY);
    }
#endif
    STAMP(5);
    if (IN(5) || IN(6) || IN(7)) {
        PHASE_VARS();
        volatile LAS int* cntl = (volatile LAS int*)(lds + CNTL_OFF); unsigned* cnt = (unsigned*)(ws + WS_CTL);
        __syncthreads();
        if (MK_DETSLOT != 2 && tid < NE) cntl[tid] = (int)__hip_atomic_load(cnt + tid, __ATOMIC_RELAXED, __HIP_MEMORY_SCOPE_AGENT);
        __syncthreads();
        if (tid == 0) { int s = 0; for (int i = 0; i < NE; ++i) { cntl[32 + i] = s; s += (cntl[i] + 255) & ~255; } }
        __syncthreads();
        if (tid < 160) { const int slot0 = tid * 256; int e = -1, p0 = 0; for (int j = 0; j < NE; ++j) { const int ps = cntl[32 + j], pad = (cntl[j] + 255) & ~255; if (slot0 >= ps && slot0 < ps + pad) { e = j; p0 = slot0 - ps; } } cntl[64 + tid] = e; cntl[224 + tid] = p0; }
        __syncthreads();
    }
    if (IN(5)) {
        PHASE_VARS();
        constexpr int ESZ = MK_F8 ? 1 : 2;
        pg8::MoeOrder<true, DM, ESZ> S{(const volatile LAS int*)(lds + CNTL_OFF), G, vcu, (const char*)(ws + WS_XN), (const char*)(ws + WS_WGU), (const int2*)(ws + MK_WS_LIST)};
        pg8::EpiGLU E{(bf16_t*)(ws + WS_H), (const int2*)(ws + MK_WS_LIST)};
        for (int rep_ = 0; rep_ < REPS(5); ++rep_) pg8::gemm_phase<pg8::EpiGLU, pg8::MoeOrder<true, DM, ESZ>, true, MK_F8 != 0>(lds, (LAS unsigned*)(lds + RTAB_OFF), DM, S, E);
    }
    SEAM_XCD(5);
    STAMP(6);
    if (IN(6)) {
        PHASE_VARS();
        constexpr int ESZ = MK_F8 ? 1 : 2;
        pg8::MoeOrder<false, DE, ESZ> S{(const volatile LAS int*)(lds + CNTL_OFF), G, vcu, (const char*)(ws + WS_H), (const char*)(ws + WS_WD), nullptr};
        pg8::EpiY E{(bf16_t*)(ws + WS_Y), 0};
        for (int rep_ = 0; rep_ < REPS(6); ++rep_) { if (MK_REPNS) { int sk = (rep_ + 1 < REPS(6)) ? 1 : 0; asm volatile("" : "+s"(sk)); E.skip = sk; } pg8::gemm_phase<pg8::EpiY, pg8::MoeOrder<false, DE, ESZ>, true, MK_F8 != 0>(lds, (LAS unsigned*)(lds + RTAB_OFF), DE, S, E); }
    }
    SEAM_XCD(6);
    STAMP(7);
    if (IN(7)) {
        PHASE_VARS();
        const int gw = vcu * NWAVES + wave, NGW = G * NWAVES;
        volatile LAS int* cntl = (volatile LAS int*)(lds + CNTL_OFF); float* out = ap->out; const bf16_t* Y = (const bf16_t*)(ws + WS_Y); const int4* rec = (const int4*)(ws + WS_REC);
        for (int ps_ = 0; ps_ < (MK_REP == 7 ? 3 : 1); ++ps_) {
        const float sg_ = (ps_ == 1) ? -1.f : 1.f; if (ps_) asm volatile("s_waitcnt vmcnt(0)" ::: "memory");
        int4 rn = rec[gw < T ? gw : 0];
        for (int t = gw; t < T; t += NGW) {
            const int4 r = rn; if (t + NGW < T) rn = rec[t + NGW];
            const int s0 = cntl[32 + (r.x >> 16)] + (r.x & 0xffff), s1 = cntl[32 + (r.y >> 16)] + (r.y & 0xffff); const float w0 = __int_as_float(r.z), w1 = __int_as_float(r.w);
            f32x4* o = (f32x4*)(out + (size_t)t * DM) + lane; const u32x2* y0 = (const u32x2*)(Y + (size_t)s0 * 2048) + lane; const u32x2* y1 = (const u32x2*)(Y + (size_t)s1 * 2048) + lane;
            f32x4 v[8]; u32x2 a[8], b[8];
#if MK_Y8
            { const unsigned* z0 = (const unsigned*)((const unsigned char*)Y + (size_t)s0 * 2048) + lane; const unsigned* z1 = (const unsigned*)((const unsigned char*)Y + (size_t)s1 * 2048) + lane; unsigned a8[8], b8[8];
#pragma unroll
              for (int j = 0; j < 8; ++j) { v[j] = o[64 * j]; a8[j] = z0[64 * j]; b8[j] = z1[64 * j]; }
              __builtin_amdgcn_sched_barrier(0);
              const float u0 = w0 * (sg_ / pg8::F8_SY), u1 = w1 * (sg_ / pg8::F8_SY);
#pragma unroll
              for (int j = 0; j < 8; ++j) { const auto al = __builtin_amdgcn_cvt_pk_f32_fp8((int)a8[j], false), ah = __builtin_amdgcn_cvt_pk_f32_fp8((int)a8[j], true), bl = __builtin_amdgcn_cvt_pk_f32_fp8((int)b8[j], false), bh = __builtin_amdgcn_cvt_pk_f32_fp8((int)b8[j], true);
                  v[j][0] += u0 * al[0] + u1 * bl[0]; v[j][1] += u0 * al[1] + u1 * bl[1]; v[j][2] += u0 * ah[0] + u1 * bh[0]; v[j][3] += u0 * ah[1] + u1 * bh[1]; o[64 * j] = v[j]; }
              continue; }
#endif
#pragma unroll
            for (int j = 0; j < 8; ++j) { v[j] = o[64 * j]; a[j] = y0[64 * j]; b[j] = y1[64 * j]; }
            __builtin_amdgcn_sched_barrier(0);
#pragma unroll
            for (int j = 0; j < 8; ++j) {
                v[j][0] += w0 * bf2f(a[j].x & 0xffffu) + w1 * bf2f(b[j].x & 0xffffu); v[j][1] += w0 * bf2f(a[j].x >> 16) + w1 * bf2f(b[j].x >> 16);
                v[j][2] += w0 * bf2f(a[j].y & 0xffffu) + w1 * bf2f(b[j].y & 0xffffu); v[j][3] += w0 * bf2f(a[j].y >> 16) + w1 * bf2f(b[j].y >> 16); o[64 * j] = v[j]; }
        }
        }
    }
#if MK_PROBE >= 0
    { kargp_t ap_ = (kargp_t)__builtin_amdgcn_kernarg_segment_ptr(); asm volatile("" : "+s"(ap_)); xcd_barrier((unsigned*)(ap_->ws + WS_CTL) + CW_BAR, (volatile LAS unsigned*)(lds + MISC_OFF) + 8, mk_tid(lds) == 0); }
    STAMP(8);
    { kargp_t ap_ = (kargp_t)__builtin_amdgcn_kernarg_segment_ptr(); asm volatile("" : "+s"(ap_)); xcd_barrier((unsigned*)(ap_->ws + WS_CTL) + CW_BAR, (volatile LAS unsigned*)(lds + MISC_OFF) + 8, mk_tid(lds) == 0); }
    { PHASE_VARS();
      const unsigned long long* ts = (const unsigned long long*)(ws + WS_LAM + 1024);
      const unsigned long long t0 = __hip_atomic_load(ts + 0, __ATOMIC_RELAXED, __HIP_MEMORY_SCOPE_AGENT), ta = __hip_atomic_load(ts + MK_PROBE, __ATOMIC_RELAXED, __HIP_MEMORY_SCOPE_AGENT), tb = __hip_atomic_load(ts + MK_PROBE + 1, __ATOMIC_RELAXED, __HIP_MEMORY_SCOPE_AGENT), te = __hip_atomic_load(ts + 8, __ATOMIC_RELAXED, __HIP_MEMORY_SCOPE_AGENT);
      const float f = (float)(tb - ta) / (float)(te - t0), sc = 1.f - f;
      f32x4* o = (f32x4*)ap->out; for (size_t i = (size_t)blockIdx.x * NTHR + tid; i < (size_t)T * DM / 4; i += (size_t)G * NTHR) { f32x4 v = o[i]; v = v * sc; o[i] = v; } }
#endif
#undef IN
#undef SEAM_XCD
}

#ifndef MK_PLAN
#define MK_PLAN 0
#endif
extern "C" void kernel_launch(void* const* d_in, const int* in_sizes, int n_in, void* d_out, int out_size, void* d_ws, size_t ws_size, hipStream_t stream) {
    static int ok = 0, grid = 0;
    if (ok == 0) {
        if (n_in != 23 || in_sizes[0] != T * DM || out_size != T * DM || ws_size < WS_END) { fprintf(stderr, "kernel_launch: unexpected shapes (n_in %d, in0 %d, out %d, ws %zu)\n", n_in, n_in > 0 ? in_sizes[0] : -1, out_size, ws_size); ok = -1; return; }
        if (hipFuncSetAttribute((const void*)k_gmlp, hipFuncAttributeMaxDynamicSharedMemorySize, (128 * 129 + 128 * 128) * 4) != hipSuccess) { fprintf(stderr, "kernel_launch: hipFuncSetAttribute failed\n"); ok = -1; return; }
        if (hipFuncSetAttribute((const void*)mk_fwd, hipFuncAttributeMaxDynamicSharedMemorySize, LDS_BYTES) != hipSuccess) { fprintf(stderr, "kernel_launch: hipFuncSetAttribute(mk_fwd) failed\n"); ok = -1; return; }
        int dev = 0, cus = 0, per_cu = 0;
        (void)hipGetDevice(&dev); (void)hipDeviceGetAttribute(&cus, hipDeviceAttributeMultiprocessorCount, dev);
        if (hipOccupancyMaxActiveBlocksPerMultiprocessor(&per_cu, (const void*)mk_fwd, NTHR, LDS_BYTES) != hipSuccess || per_cu < 1) { fprintf(stderr, "kernel_launch: occupancy query says %d blocks per CU\n", per_cu); per_cu = 1; }
        (void)hipGetLastError();
        grid = cus;
        if (grid % 8 != 0 || grid <= 0) { fprintf(stderr, "kernel_launch: unexpected CU count %d\n", cus); ok = -1; return; }
        ok = 1;
    }
    if (ok < 0) return;
    const float* x = (const float*)d_in[0]; const float* attn_g = (const float*)d_in[1]; const float* w_in = (const float*)d_in[2];
    const float* lng = (const float*)d_in[3]; const float* lnb = (const float*)d_in[4]; const float* gws = (const float*)d_in[5]; const float* gbs = (const float*)d_in[6];
    const float* qg = (const float*)d_in[7]; const float* kg = (const float*)d_in[8];
    const float* lq1 = (const float*)d_in[9]; const float* lk1 = (const float*)d_in[10]; const float* lq2 = (const float*)d_in[11]; const float* lk2 = (const float*)d_in[12];
    const float* subg = (const float*)d_in[13]; const float* w_out = (const float*)d_in[14]; const float* ffn_g = (const float*)d_in[15];
    const float* wgrp = (const float*)d_in[16]; const float* bgrp = (const float*)d_in[17]; const float* wrt = (const float*)d_in[18]; const float* brt = (const float*)d_in[19];
    const float* wgate = (const float*)d_in[20]; const float* wup = (const float*)d_in[21]; const float* wdown = (const float*)d_in[22];
    char* ws = (char*)d_ws; float* out = (float*)d_out;
    unsigned* cnt = (unsigned*)(ws + WS_CTL); float2* rope = (float2*)(ws + WS_ROPE); float* WrT = (float*)(ws + WS_WRT); bf16_t* WsB = (bf16_t*)(ws + WS_WSB); float* lam = (float*)(ws + WS_LAM);
    int2* list = (int2*)(ws + WS_LIST); int4* rec = (int4*)(ws + WS_REC);
    bf16_t* Win = (bf16_t*)(ws + WS_WIN); bf16_t* Wout = (bf16_t*)(ws + WS_WOUT); bf16_t* Wgu = (bf16_t*)(ws + WS_WGU); bf16_t* Wd = (bf16_t*)(ws + WS_WD);
    bf16_t* XN = (bf16_t*)(ws + WS_XN); bf16_t* MIX = (bf16_t*)(ws + WS_MIX); bf16_t* Z = (bf16_t*)(ws + WS_Z);
    bf16_t* U = (bf16_t*)(ws + WS_U); bf16_t* VG = U + (size_t)T * 1024; bf16_t* QN = VG + (size_t)T * 1024; bf16_t* KN = QN + (size_t)T * 1024; bf16_t* VB = KN + (size_t)T * 1024;
    bf16_t* H = (bf16_t*)(ws + WS_H); bf16_t* Y = (bf16_t*)(ws + WS_Y); bf16_t* GU = Y;
    (void)Z; (void)GU; (void)H; (void)rec; (void)list; (void)WsB;

    (void)hipMemsetAsync(ws + WS_CTL, 0, 32768, stream);
    MkArgs a{}; for (int i = 0; i < 23; ++i) a.in[i] = (const float*)d_in[i]; a.out = out; a.ws = (unsigned char*)d_ws;
    auto MK = [&](int lo, int hi) { a.ph_lo = lo; a.ph_hi = hi; hipLaunchKernelGGL(mk_fwd, dim3(grid), dim3(NTHR), LDS_BYTES, stream, a); };
#if MK_PLAN == 0
    a.ph_lo = 0; a.ph_hi = 8; void* kargs[] = {&a};
    const hipError_t ce = hipLaunchCooperativeKernel((const void*)mk_fwd, dim3(grid), dim3(NTHR), kargs, LDS_BYTES, stream);
    if (ce != hipSuccess) fprintf(stderr, "kernel_launch: cooperative launch failed: %s (grid %d)\n", hipGetErrorString(ce), grid);
#else
    auto V1_PRO = [&]() {
        k_transpose<<<dim3(INW / 32, DM / 32, 1), 256, 0, stream>>>(w_in, DM, INW, Win, attn_g, 1, 0, 0);
        k_transpose<<<dim3(DM / 32, DM / 32, 1), 256, 0, stream>>>(w_out, DM, DM, Wout, nullptr, 0, 0, 0);
        k_transpose<<<dim3(DE / 32, DM / 32, NE), 256, 0, stream>>>(wgate, DM, DE, Wgu, ffn_g, 2, (size_t)DM * DE, (size_t)2048 * 2048);
        k_transpose<<<dim3(DE / 32, DM / 32, NE), 256, 0, stream>>>(wup, DM, DE, Wgu, ffn_g, 3, (size_t)DM * DE, (size_t)2048 * 2048);
        k_transpose<<<dim3(DM / 32, DE / 32, NE), 256, 0, stream>>>(wdown, DE, DM, Wd, nullptr, 0, (size_t)DE * DM, (size_t)2048 * 1024);
        k_tables<<<256, 256, 0, stream>>>(rope, WrT, WsB, lam, wgrp, wrt, ffn_g, gws, lq1, lk1, lq2, lk2);
        k_xnorm<<<T, 256, 0, stream>>>(x, XN); };
    auto V1_G1 = [&]() { P_G1 p{XN, Win, Z}; k_gemm128<P_G1><<<dim3(INW / 128, T / 128), 256, 16384, stream>>>(p); k_post<<<T, 256, 0, stream>>>(Z, U, VG, QN, KN, VB, qg, kg, rope); };
    auto V1_MIX = [&]() { k_gmlp<<<NB * 32 * 8, 256, (128 * 129 + 128 * 128) * 4, stream>>>(U, VG, lng, lnb, gws, gbs, MIX); k_attn_simple<<<NB * 8 * 256, 256, 0, stream>>>(QN, KN, VB, subg, lam, MIX); };
    auto V1_G2 = [&]() { P_G2 p{MIX, Wout, x, out, XN}; k_gemm128<P_G2><<<dim3(DM / 128, T / 128), 256, 16384, stream>>>(p); };
    auto V1_ROUTE = [&]() { k_route<<<T, 256, 0, stream>>>(out, WrT, bgrp, brt, cnt, list, rec); };
    auto V1_GU = [&]() { P_GU p{XN, Wgu, cnt, list, GU}; k_gemm128<P_GU><<<dim3(2048 / 128, SLOTS / 128), 256, 16384, stream>>>(p); k_glu<<<SLOTS, 256, 0, stream>>>(GU, cnt, list, H); };
    auto V1_DN = [&]() { P_DN p{H, Wd, cnt, Y}; k_gemm128<P_DN><<<dim3(2048 / 128, SLOTS / 128), 256, 16384, stream>>>(p); };
    auto V1_COMB = [&]() { k_combine<<<T, 256, 0, stream>>>(out, Y, cnt, rec); };
    (void)V1_PRO; (void)V1_G1; (void)V1_MIX; (void)V1_G2; (void)V1_ROUTE; (void)V1_GU; (void)V1_DN; (void)V1_COMB;
#if MK_PLAN == 1
    V1_PRO(); MK(1, 2); V1_MIX(); MK(3, 4); V1_ROUTE(); MK(5, 6); MK(6, 7); V1_COMB();
#elif MK_PLAN == 2
    for (int p = 0; p < 8; ++p) MK(p, p + 1);
#endif
#endif
    const hipError_t le = hipPeekAtLastError();
    if (le != hipSuccess) fprintf(stderr, "kernel_launch: launch failed: %s\n", hipGetErrorName(le));
}
```
